# Optimizing an MI355X kernel written in HIP

```python
import jax, jax.numpy as jnp
from jax import lax
import numpy as np

D_MODEL = 1024
BATCH = 32
SEQ = 2048
DEPTH = 1

HEAD_DIM = 64
ROPE_THETA = 10000.0
A_Q_HEADS = 16
A_KV_HEADS = 4
A_GQA = A_Q_HEADS // A_KV_HEADS
A_WINDOW = 128
B_GROUPS = ((128, 1), (512, 4), (2048, 16))
B_HEADS_PER_GROUP = 4
ATTN_BLOCK = 128
A_Q_W = A_Q_HEADS * HEAD_DIM
A_KV_W = A_KV_HEADS * HEAD_DIM
B_OUT_W = B_HEADS_PER_GROUP * HEAD_DIM
B_W = len(B_GROUPS) * B_OUT_W
N_BRANCH = 2
OFF_AQ = 0
OFF_AK = OFF_AQ + A_Q_W
OFF_AV = OFF_AK + A_KV_W
OFF_BQ = OFF_AV + A_KV_W
OFF_BK = OFF_BQ + B_W
OFF_BV = OFF_BK + B_W
OFF_G = OFF_BV + B_W
IN_W = OFF_G + N_BRANCH * D_MODEL
N_EXPERTS = 32
TOP_K = 4
D_EXPERT = D_MODEL
SWIGLU_LIMIT = 7.0
SWIGLU_ALPHA = 1.702
MOE_BLOCK = 512
LN_EPS = 1e-5
DEEPNORM_ALPHA = (2 * DEPTH) ** 0.25
DEEPNORM_BETA = (8 * DEPTH) ** -0.25

kernel_name = 'hybrid_swa_sink_dilated_moe_deepnorm'


def layer_norm(x, g, b):
    xf = x.astype(jnp.float32)
    mu = jnp.mean(xf, axis=-1, keepdims=True)
    var = jnp.mean(jnp.square(xf - mu), axis=-1, keepdims=True)
    y = (xf - mu) * lax.rsqrt(var + LN_EPS)
    return (y * g.astype(jnp.float32) + b.astype(jnp.float32)).astype(x.dtype)


def rope(x, pos):
    half = x.shape[-1] // 2
    inv_freq = ROPE_THETA ** (-jnp.arange(0, x.shape[-1], 2, dtype=jnp.float32) / x.shape[-1])
    ang = pos[:, None] * inv_freq[None, :]
    cos = jnp.cos(ang)[None, :, None, :]
    sin = jnp.sin(ang)[None, :, None, :]
    xf = x.astype(jnp.float32)
    x1, x2 = xf[..., :half], xf[..., half:]
    return jnp.concatenate([x1 * cos - x2 * sin, x2 * cos + x1 * sin], axis=-1).astype(x.dtype)


def banded_attention(q, k, v, n_back, sink):
    n, L, hk, g, hd = q.shape
    blk = ATTN_BLOCK
    nb = -(-L // blk)
    pad = nb * blk - L
    if pad:
        q = jnp.pad(q, ((0, 0), (0, pad), (0, 0), (0, 0), (0, 0)))
        k = jnp.pad(k, ((0, 0), (0, pad), (0, 0), (0, 0)))
        v = jnp.pad(v, ((0, 0), (0, pad), (0, 0), (0, 0)))
    qb = q.reshape(n, nb, blk, hk, g, hd)

    def with_prev(t):
        tb = t.reshape(n, nb, blk, hk, hd)
        prev = jnp.pad(tb, ((0, 0), (1, 0), (0, 0), (0, 0), (0, 0)))[:, :-1]
        return jnp.concatenate([prev, tb], axis=2)

    kk, vv = with_prev(k), with_prev(v)
    s = jnp.einsum('nbqhgd,nbkhd->nbhgqk', qb, kk,
                   preferred_element_type=jnp.float32) * (hd ** -0.5)
    qi = jnp.arange(blk)[:, None] + blk
    kj = jnp.arange(2 * blk)[None, :]
    dist = qi - kj
    band = (dist >= 0) & (dist <= n_back)
    key_pos = jnp.arange(nb)[:, None, None] * blk + kj[None] - blk
    valid = band[None] & (key_pos >= 0)
    s = jnp.where(valid[None, :, None, None], s, -jnp.inf)
    m = jnp.max(s, axis=-1)
    if sink is not None:
        sk = sink.astype(jnp.float32)[:, :, None]
        m = jnp.maximum(m, sk)
    p = jnp.exp(s - m[..., None])
    l = jnp.sum(p, axis=-1)
    if sink is not None:
        l = l + jnp.exp(sk - m)
    o = jnp.einsum('nbhgqk,nbkhd->nbqhgd', p.astype(v.dtype), vv,
                   preferred_element_type=jnp.float32)
    l_t = jnp.moveaxis(l, -1, 2)
    o = o / l_t[..., None]
    lse = jnp.moveaxis(m, -1, 2) + jnp.log(l_t)
    o = o.reshape(n, nb * blk, hk, g, hd)[:, :L]
    lse = lse.reshape(n, nb * blk, hk, g)[:, :L]
    return o.astype(q.dtype), lse


def to_class(t, d):
    b, s = t.shape[:2]
    t = t.reshape(b, s // d, d, *t.shape[2:])
    t = jnp.moveaxis(t, 2, 1)
    return t.reshape(b * d, s // d, *t.shape[3:])


def from_class(t, d, b):
    t = t.reshape(b, d, t.shape[1], *t.shape[2:])
    t = jnp.moveaxis(t, 1, 2)
    return t.reshape(b, -1, *t.shape[3:])


def hybrid_mixer(x, w_in, sinks, w_branch_a, w_branch_b, w_out):
    b, s, _ = x.shape
    pos = jnp.arange(s, dtype=jnp.float32)
    proj = jnp.einsum('bsd,de->bse', x, w_in)

    def heads(lo, w):
        return proj[..., lo:lo + w].reshape(b, s, w // HEAD_DIM, HEAD_DIM)

    qa = rope(heads(OFF_AQ, A_Q_W), pos).reshape(b, s, A_KV_HEADS, A_GQA, HEAD_DIM)
    ka = rope(heads(OFF_AK, A_KV_W), pos)
    va = heads(OFF_AV, A_KV_W)
    oa, _ = banded_attention(qa, ka, va, A_WINDOW - 1, sinks.reshape(A_KV_HEADS, A_GQA))
    oa = oa.reshape(b, s, A_Q_W)

    qb = rope(heads(OFF_BQ, B_W), pos)
    kb = rope(heads(OFF_BK, B_W), pos)
    vb = heads(OFF_BV, B_W)
    outs, lses = [], []
    for gi, (window, dil) in enumerate(B_GROUPS):
        sl = slice(gi * B_HEADS_PER_GROUP, (gi + 1) * B_HEADS_PER_GROUP)
        qc = to_class(qb[:, :, sl], dil)[:, :, :, None]
        kc = to_class(kb[:, :, sl], dil)
        vc = to_class(vb[:, :, sl], dil)
        o, lse = banded_attention(qc, kc, vc, window // dil, None)
        outs.append(from_class(o[:, :, :, 0], dil, b))
        lses.append(from_class(lse[:, :, :, 0], dil, b))
    wts = jax.nn.softmax(jnp.stack(lses, axis=0), axis=0)
    ob = jnp.sum(wts[..., None] * jnp.stack(outs, axis=0).astype(jnp.float32), axis=0)
    ob = ob.astype(x.dtype).reshape(b, s, B_OUT_W)

    gates = jax.nn.sigmoid(proj[..., OFF_G:].reshape(b, s, N_BRANCH, D_MODEL)
                           .astype(jnp.float32)).astype(x.dtype)
    ya = jnp.einsum('bsi,id->bsd', oa, w_branch_a)
    yb = jnp.einsum('bsi,id->bsd', ob, w_branch_b)
    merged = gates[:, :, 0] * ya + gates[:, :, 1] * yb
    return jnp.einsum('bsd,de->bse', merged, w_out)


def moe_ffn(x, w_router, b_router, w_gate_up, b_gate_up, w_down, b_down):
    b, s, d = x.shape
    t = b * s
    xt = x.reshape(t, d)
    logits = jnp.einsum('td,de->te', xt, w_router,
                        preferred_element_type=jnp.float32) + b_router.astype(jnp.float32)
    top_v, top_e = lax.top_k(logits, TOP_K)
    gate_w = jax.nn.softmax(top_v, axis=-1)
    n = t * TOP_K
    flat_e = top_e.reshape(n)
    flat_w = gate_w.reshape(n)
    order = jnp.argsort(flat_e)
    sorted_e = flat_e[order]
    sorted_tok = (order // TOP_K).astype(jnp.int32)
    sorted_w = flat_w[order]
    counts = jnp.bincount(flat_e, length=N_EXPERTS)
    padded = (counts + MOE_BLOCK - 1) // MOE_BLOCK * MOE_BLOCK
    pad_end = jnp.cumsum(padded)
    pad_start = pad_end - padded
    start = jnp.cumsum(counts) - counts
    dest = pad_start[sorted_e] + (jnp.arange(n) - start[sorted_e])
    nblk = -(-(n + N_EXPERTS * (MOE_BLOCK - 1)) // MOE_BLOCK)
    rows = nblk * MOE_BLOCK
    buf_tok = jnp.full((rows,), t, jnp.int32).at[dest].set(sorted_tok)
    buf_w = jnp.zeros((rows,), jnp.float32).at[dest].set(sorted_w)
    blk_e = jnp.minimum(jnp.searchsorted(pad_end, jnp.arange(nblk) * MOE_BLOCK, side='right'),
                        N_EXPERTS - 1)
    x_pad = jnp.concatenate([xt, jnp.zeros((1, d), xt.dtype)], axis=0)

    def expert_block(args):
        tok, w, e = args
        xb = x_pad[tok]
        gu = xb @ w_gate_up[e] + b_gate_up[e]
        gate = jnp.minimum(gu[:, :D_EXPERT], SWIGLU_LIMIT)
        up = jnp.clip(gu[:, D_EXPERT:], -SWIGLU_LIMIT, SWIGLU_LIMIT)
        h = (up + 1.0) * gate * jax.nn.sigmoid(SWIGLU_ALPHA * gate)
        y = h @ w_down[e] + b_down[e]
        return y * w[:, None].astype(y.dtype)

    y = lax.map(expert_block, (buf_tok.reshape(nblk, MOE_BLOCK),
                               buf_w.reshape(nblk, MOE_BLOCK), blk_e))
    out = jnp.zeros((t + 1, d), y.dtype).at[buf_tok].add(y.reshape(rows, d))[:t]
    return out.reshape(b, s, d)


def setup_inputs(seed: int = 0) -> dict:
    key = jax.random.key(seed)
    ks = jax.random.split(key, 16)
    f32 = jnp.float32

    def nrm(k, shape):
        return jax.random.normal(k, shape, f32)

    col_scale = jnp.concatenate([
        jnp.ones((A_Q_W + A_KV_W,), f32), jnp.full((A_KV_W,), DEEPNORM_BETA, f32),
        jnp.ones((2 * B_W,), f32), jnp.full((B_W,), DEEPNORM_BETA, f32),
        jnp.ones((N_BRANCH * D_MODEL,), f32)])
    return {
        'x': nrm(ks[0], (BATCH, SEQ, D_MODEL)),
        'w_in': nrm(ks[1], (DEPTH, D_MODEL, IN_W)) * (D_MODEL ** -0.5) * col_scale,
        'attn_sinks': 0.5 * nrm(ks[2], (DEPTH, A_Q_HEADS)),
        'w_branch_a': nrm(ks[3], (DEPTH, A_Q_W, D_MODEL)) * (A_Q_W ** -0.5),
        'w_branch_b': nrm(ks[4], (DEPTH, B_OUT_W, D_MODEL)) * (B_OUT_W ** -0.5),
        'w_out': nrm(ks[5], (DEPTH, D_MODEL, D_MODEL)) * (D_MODEL ** -0.5) * DEEPNORM_BETA,
        'ln1_g': 1.0 + 0.02 * nrm(ks[6], (DEPTH, D_MODEL)),
        'ln1_b': 0.02 * nrm(ks[7], (DEPTH, D_MODEL)),
        'w_router': nrm(ks[8], (DEPTH, D_MODEL, N_EXPERTS)) * (D_MODEL ** -0.5),
        'b_router': 0.01 * nrm(ks[9], (DEPTH, N_EXPERTS)),
        'w_gate_up': nrm(ks[10], (DEPTH, N_EXPERTS, D_MODEL, 2 * D_EXPERT)) * (D_MODEL ** -0.5),
        'b_gate_up': 0.02 * nrm(ks[11], (DEPTH, N_EXPERTS, 2 * D_EXPERT)),
        'w_down': nrm(ks[12], (DEPTH, N_EXPERTS, D_EXPERT, D_MODEL)) * (D_EXPERT ** -0.5) * DEEPNORM_BETA,
        'b_down': 0.02 * nrm(ks[13], (DEPTH, N_EXPERTS, D_MODEL)),
        'ln2_g': 1.0 + 0.02 * nrm(ks[14], (DEPTH, D_MODEL)),
        'ln2_b': 0.02 * nrm(ks[15], (DEPTH, D_MODEL)),
    }


def reference(x, w_in, attn_sinks, w_branch_a, w_branch_b, w_out, ln1_g, ln1_b,
              w_router, b_router, w_gate_up, b_gate_up, w_down, b_down, ln2_g, ln2_b):
    h = x
    for l in range(DEPTH):
        mix = hybrid_mixer(h, w_in[l], attn_sinks[l], w_branch_a[l], w_branch_b[l], w_out[l])
        h = layer_norm(DEEPNORM_ALPHA * h + mix, ln1_g[l], ln1_b[l])
        ffn = moe_ffn(h, w_router[l], b_router[l], w_gate_up[l], b_gate_up[l], w_down[l], b_down[l])
        h = layer_norm(DEEPNORM_ALPHA * h + ffn, ln2_g[l], ln2_b[l])
    return h
```

```cpp
#include <hip/hip_runtime.h>
#include <cstdio>
#include <cstdint>

#ifndef MK_ONE_LAUNCH
#define MK_ONE_LAUNCH 1
#endif

#define LAS __attribute__((address_space(3)))
#define GAS __attribute__((address_space(1)))
typedef unsigned short bf16_t;
typedef short bf16x8 __attribute__((ext_vector_type(8)));
typedef short s16x4 __attribute__((ext_vector_type(4)));
typedef float f32x4 __attribute__((ext_vector_type(4)));
typedef float f32x2 __attribute__((ext_vector_type(2)));
typedef float f32x16 __attribute__((ext_vector_type(16)));
typedef unsigned u32x4 __attribute__((ext_vector_type(4)));
typedef unsigned u32x2 __attribute__((ext_vector_type(2)));
typedef __bf16 bf16x2_t __attribute__((ext_vector_type(2)));

constexpr int SEQ = 2048, NB = 32, T = NB * SEQ, D = 1024, INW = 5888, NE = 32, TOPK = 4;
constexpr float LN_EPS = 1e-5f;
constexpr float ALPHA = 1.189207115002721f;
constexpr float LOG2E = 1.4426950408889634f;
constexpr float QSCALE = 0.125f * LOG2E;
constexpr int HALF_T = T / 2;
constexpr int HROWS = HALF_T * TOPK + NE * 256;
constexpr int HTILES = HROWS / 256;

constexpr size_t MiB = 1u << 20;
constexpr size_t WS_CTL = 0, CTL_ZERO_BYTES = 1 * MiB;
constexpr size_t WS_COS = 1 * MiB, WS_SIN = WS_COS + 256 * 1024;
constexpr size_t WS_WIN = 2 * MiB;
constexpr size_t WS_WAB = 14 * MiB;
constexpr size_t WS_WOUT = 17 * MiB;
constexpr size_t WS_TOPE = 19 * MiB, WS_TOPW = 20 * MiB, WS_HIST = 21 * MiB;
constexpr size_t WS_ROWTOK = 22 * MiB, WS_ROWDST = 24 * MiB, WS_TILEE = 26 * MiB;
constexpr size_t WS_WGU = 32 * MiB;
constexpr size_t WS_WDN = 160 * MiB;
constexpr size_t WS_OAB = 224 * MiB;
constexpr size_t WS_XB = 224 * MiB;
constexpr size_t WS_H1 = 224 * MiB;
constexpr size_t WS_G = 384 * MiB;
constexpr size_t WS_KB = 640 * MiB;
constexpr size_t WS_VAT = 736 * MiB;
constexpr size_t WS_VBT = 768 * MiB;
constexpr size_t WS_OG = 864 * MiB;
constexpr size_t WS_LSE = 960 * MiB;
constexpr size_t WS_MERGED = 640 * MiB;
constexpr size_t WS_H = 352 * MiB;
constexpr size_t WS_Y = 624 * MiB;
constexpr size_t WS_END = 1024 * MiB;
static_assert(WS_H + (size_t)HROWS * 1024 * 2 <= WS_Y && WS_Y + (size_t)HALF_T * 4 * 1024 * 2 <= WS_END, "ws map");
static_assert(WS_LSE + (size_t)T * 12 * 4 <= WS_END && WS_OG + (size_t)T * 768 * 2 <= WS_LSE && WS_VBT + (size_t)T * 768 * 2 <= WS_OG, "ws map");
constexpr size_t DO_QA = 0, DO_QB = 128 * MiB, DO_KA = 224 * MiB;

constexpr int CW_TMO = 0, CW_CODE = 1, CW_BAR = 4096;

constexpr int RING_BYTES = 131072;
constexpr int LDSCTL_OFF = RING_BYTES, MISC_OFF = LDSCTL_OFF + 320, SCR_OFF = LDSCTL_OFF + 1024;
constexpr int LDS_BYTES = 147456;

#define RLX_AGENT __ATOMIC_RELAXED, __HIP_MEMORY_SCOPE_AGENT
#define LDS_WAIT() asm volatile("s_waitcnt lgkmcnt(0)" ::: "memory")
#define VM_WAIT() asm volatile("s_waitcnt vmcnt(0)" ::: "memory")
__device__ __forceinline__ unsigned pk2(float lo, float hi) { f32x2 v = {lo, hi}; bf16x2_t b = __builtin_convertvector(v, bf16x2_t); return __builtin_bit_cast(unsigned, b); }
__device__ __forceinline__ float bflo(unsigned w) { return __uint_as_float(w << 16); }
__device__ __forceinline__ float bfhi(unsigned w) { return __uint_as_float(w & 0xffff0000u); }
__device__ __forceinline__ float fast_sigmoid(float z) { return __builtin_amdgcn_rcpf(1.0f + __builtin_amdgcn_exp2f(-z * LOG2E)); }
__device__ __forceinline__ float wave_sum(float v) {
#pragma unroll
    for (int o = 1; o < 64; o <<= 1) v += __shfl_xor(v, o);
    return v;
}

#define XB_TMO      128
#define XB_XCNT(j)  (256  + 64 * (j))
#define XB_XSUB(j)  (1280 + 64 * (j))
#define XB_XGEN(j)  (2304 + 64 * (j))
#define XB_TOP      3328
#define XB_TOPGEN   3392
#define XCD_BAR_WORDS 3456
#define XB_SPIN_CAP (1u << 18)
__device__ __forceinline__ unsigned xb_ld(unsigned* p)              { return __hip_atomic_load(p, __ATOMIC_RELAXED, __HIP_MEMORY_SCOPE_AGENT); }
__device__ __forceinline__ unsigned xb_add(unsigned* p, unsigned v) { return __hip_atomic_fetch_add(p, v, __ATOMIC_RELAXED, __HIP_MEMORY_SCOPE_AGENT); }
__device__ __forceinline__ unsigned xb_xcc_id() { return (unsigned)__builtin_amdgcn_s_getreg((3 << 11) | 20) & 0xFu; }
#define XB_SPIN(cond, bar) do { unsigned _sp = 0; while (cond) { __builtin_amdgcn_s_sleep(1); \
    if ((++_sp & 255u) == 0u) { if (xb_ld(&(bar)[XB_TMO])) break; if (_sp > XB_SPIN_CAP) { atomicAdd(&(bar)[XB_TMO], 1u); break; } } } } while (0)
struct XcdBarrier { unsigned* bar; unsigned x; volatile LAS unsigned* st; };
__device__ __forceinline__ XcdBarrier xcd_barrier_post(unsigned* bar, volatile LAS unsigned* st) {
    XcdBarrier b; b.bar = bar; b.x = xb_xcc_id(); b.st = st;
    if (threadIdx.x == 0) (void)xb_add(&bar[XB_XCNT(b.x)], 1u);
    return b;
}
__device__ __forceinline__ void xcd_barrier_complete(unsigned* bar, unsigned x, unsigned& nloc, unsigned& nx) {
    const unsigned G = gridDim.x * gridDim.y * gridDim.z;
    unsigned sum, cnt, mine, sp = 0u;
    for (;;) {
        sum = 0u; cnt = 0u; mine = 0u;
#pragma unroll
        for (unsigned j = 0; j < 16; ++j) { const unsigned c = xb_ld(&bar[XB_XCNT(j)]); sum += c; cnt += (c > 0u) ? 1u : 0u; mine = (j == x) ? c : mine; }
        if (sum == G) break;
        __builtin_amdgcn_s_sleep(1);
        if ((++sp & 255u) == 0u) { if (xb_ld(&bar[XB_TMO])) break; if (sp > XB_SPIN_CAP) { atomicAdd(&bar[XB_TMO], 1u); break; } }
    }
    nloc = mine > 0u ? mine : 1u; nx = cnt > 0u ? cnt : 1u;
}
__device__ __forceinline__ void xcd_barrier(const XcdBarrier& b) {
    asm volatile("s_waitcnt vmcnt(0)" ::: "memory");
    __syncthreads();
    if (threadIdx.x == 0) {
        unsigned* bar = b.bar;
        __builtin_amdgcn_s_waitcnt(0);
        unsigned nloc = b.st[0], nx = b.st[1];
        if (nloc == 0u) { xcd_barrier_complete(bar, b.x, nloc, nx); b.st[0] = nloc; b.st[1] = nx; }
        const unsigned old = xb_add(&bar[XB_XSUB(b.x)], 1u);
        const unsigned gen = old / nloc;
        if (old + 1u == (gen + 1u) * nloc) {
            __builtin_amdgcn_fence(__ATOMIC_RELEASE, "agent");
            asm volatile("s_waitcnt vmcnt(0)" ::: "memory");
            const unsigned og = xb_add(&bar[XB_TOP], 1u);
            const unsigned tg = og / nx;
            if (og + 1u == (tg + 1u) * nx) xb_add(&bar[XB_TOPGEN], 1u);
            else XB_SPIN(xb_ld(&bar[XB_TOPGEN]) == tg, bar);
            __builtin_amdgcn_fence(__ATOMIC_ACQUIRE, "agent");
            xb_add(&bar[XB_XGEN(b.x)], 1u);
            asm volatile("s_waitcnt vmcnt(0)" ::: "memory");
        } else {
            XB_SPIN(xb_ld(&bar[XB_XGEN(b.x)]) == gen, bar);
            __builtin_amdgcn_fence(__ATOMIC_ACQUIRE, "agent");
            asm volatile("s_waitcnt vmcnt(0)" ::: "memory");
        }
    }
    __syncthreads();
}

namespace pg8 {
constexpr int BM = 256, BK = 64, HALF = 128, HTB = HALF * BK * 2, STAGE_BYTES = 8 * HTB, NXCD = 8, WGM = 8;
__host__ __device__ __forceinline__ int lds_byte(int r, int c) { const int st = (r >> 4) * 2 + (c >> 5), rr = r & 15, cc = c & 31, ob = rr * 64 + cc * 2; return st * 1024 + (ob ^ (((ob >> 9) & 1) << 5)); }
__host__ __device__ __forceinline__ void stage_rc(int b, int& R, int& C) { const int st = b / 1024, sb = b % 1024, swz = sb ^ (((sb >> 9) & 1) << 5); R = (st >> 1) * 16 + swz / 64; C = (st & 1) * 32 + (swz % 64) / 2; }
__host__ __device__ __forceinline__ int perm32(int rho) { const int n = rho >> 4, i = rho & 15; return 8 * (i >> 2) + 4 * n + (i & 3); }

struct Unit { int pm, pn; };

struct StaticOrder {
    int nM, nN, nwg, G, c;
    __device__ void init(int M, int N, int G_, int c_) { nM = M / BM; nN = N / BM; nwg = nM * nN; G = G_; c = c_; }
    __device__ bool next(int i, Unit& u) const {
        const long L = (long)i * G + c; if (L >= nwg) return false;
        int wgid = (int)L; { const int q = nwg / NXCD, r = nwg % NXCD, xcd = wgid % NXCD, off = wgid / NXCD; wgid = (xcd < r ? xcd * (q + 1) : r * (q + 1) + (xcd - r) * q) + off; }
        const int nig = WGM * nN, gid = wgid / nig, fm = gid * WGM, gsz = (nM - fm) < WGM ? (nM - fm) : WGM;
        u.pm = fm + ((wgid % nig) % gsz); u.pn = (wgid % nig) / gsz; return true;
    }
};
struct MoeOrder {
    const int* tile_e; int NJ, W, r, t0, t1;
    __device__ void init(const int* te, int NT, int NJ_, int G, int c) {
        tile_e = te; NJ = NJ_;
        if (G % 8 == 0) { const int x = c % 8; r = c / 8; W = G / 8; t0 = (int)((long)NT * x / 8); t1 = (int)((long)NT * (x + 1) / 8); }
        else { r = c; W = G; t0 = 0; t1 = NT; }
    }
    __device__ bool next(int i, Unit& u) const {
        const int idx = i * W + r, ntl = t1 - t0; if (idx >= ntl * NJ) return false;
        const int GT = 32 / NJ, per = GT * NJ, grp = idx / per, rem = idx - grp * per, gsz = (ntl - grp * GT) < GT ? (ntl - grp * GT) : GT;
        const int tile = t0 + grp * GT + rem % gsz, j = rem / gsz;
        u.pm = tile; u.pn = tile_e[tile] * NJ + j; return true;
    }
};
struct ADense {
    __device__ __forceinline__ void offs(const Unit& u, int K, const int (&R)[2], const int (&C)[2], unsigned (&vo)[2][2]) const {
#pragma unroll
        for (int h = 0; h < 2; ++h)
#pragma unroll
            for (int i = 0; i < 2; ++i) vo[h][i] = (unsigned)((u.pm * BM + h * HALF + R[i]) * K + C[i]) * 2u;
    }
};
struct AGather {
    const int* tok;
    __device__ __forceinline__ void offs(const Unit& u, int K, const int (&R)[2], const int (&C)[2], unsigned (&vo)[2][2]) const {
#pragma unroll
        for (int h = 0; h < 2; ++h)
#pragma unroll
            for (int i = 0; i < 2; ++i) vo[h][i] = (unsigned)(tok[u.pm * BM + h * HALF + R[i]] * K + C[i]) * 2u;
    }
};
struct NoHook { static constexpr int T = -1; __device__ __forceinline__ void operator()(f32x4 (&)[2][2][4][2], const Unit&, int, int, int, int) const {} };

template <class Epi, class Sched, class AMap, class Hook>
__device__ __forceinline__ void gemm_phase(LAS unsigned char* lds, const bf16_t* A, const bf16_t* Bt, const int K, const Sched& S, const AMap& AM, const Epi& E, const Hook& HK) {
    const int tid = threadIdx.x, wid = __builtin_amdgcn_readfirstlane(tid >> 6), lane = tid & 63, wr = wid >> 2, wc = wid & 3, fr = lane & 15, fq = lane >> 4;
    const int nt = K / BK;
    int Rr[2], Cc[2]; unsigned voffB[2];
#pragma unroll
    for (int i = 0; i < 2; ++i) { stage_rc(tid * 16 + i * 8192, Rr[i], Cc[i]); const int Rb = Epi::PERM ? ((Rr[i] & ~31) + perm32(Rr[i] & 31)) : Rr[i]; voffB[i] = (unsigned)(Rb * K + Cc[i]) * 2u; }
    const size_t kstep = (size_t)(BK * 2);
    const size_t hstep = (size_t)HALF * K * 2;
    const size_t tstep = 2 * hstep;
    const unsigned ldsw = (unsigned)wid * 1024u;
    const int aoff = lds_byte(wr * 64 + fr, fq * 8), boff = lds_byte(wc * 32 + fr, fq * 8);
#define PG8_SA(b, h) (((b) * 2 + (h)) * HTB)
#define PG8_SB(b, h) ((4 + (b) * 2 + (h)) * HTB)
#define PG8_STAGE(bufoff, gbase, voff) do { _Pragma("unroll") for (int _i = 0; _i < 2; ++_i) \
        __builtin_amdgcn_global_load_lds((const unsigned*)((const char*)(gbase) + (voff)[_i]), (LAS unsigned*)(lds + (bufoff) + ldsw + _i * 8192), 16, 0, 0); } while (0)
#define PG8_LDA(dst, b, h) do { _Pragma("unroll") for (int m = 0; m < 4; ++m) _Pragma("unroll") for (int k = 0; k < 2; ++k) dst[m][k] = *(const LAS bf16x8*)(lds + PG8_SA(b, h) + aoff + m * 2048 + k * 1024); } while (0)
#define PG8_LDB(dst, b, h) do { _Pragma("unroll") for (int n = 0; n < 2; ++n) _Pragma("unroll") for (int k = 0; k < 2; ++k) dst[n][k] = *(const LAS bf16x8*)(lds + PG8_SB(b, h) + boff + n * 2048 + k * 1024); } while (0)
#define PG8_MMA(ai, bj, At, Bt_) do { __builtin_amdgcn_s_setprio(1); _Pragma("unroll") for (int m = 0; m < 4; ++m) _Pragma("unroll") for (int n = 0; n < 2; ++n) _Pragma("unroll") for (int k = 0; k < 2; ++k) \
        acc[ai][bj][m][n] = __builtin_amdgcn_mfma_f32_16x16x32_bf16(Bt_[n][k], At[m][k], acc[ai][bj][m][n], 0, 0, 0); __builtin_amdgcn_s_setprio(0); } while (0)
#define PG8_WAIT_V(n) asm volatile("s_waitcnt vmcnt(" #n ")" ::: "memory")
#define PG8_WAIT_L(n) asm volatile("s_waitcnt lgkmcnt(" #n ")" ::: "memory")
#define PG8_BAR __builtin_amdgcn_s_barrier()
#define PG8_SCHED __builtin_amdgcn_sched_barrier(0)
    Unit cur, nxt; int ui = 0;
    if (!S.next(0, cur)) return;
    f32x4 acc[2][2][4][2];
#pragma unroll
    for (int a = 0; a < 2; ++a)
#pragma unroll
        for (int b = 0; b < 2; ++b)
#pragma unroll
            for (int m = 0; m < 4; ++m)
#pragma unroll
                for (int n = 0; n < 2; ++n) acc[a][b][m][n] = (f32x4){0.f, 0.f, 0.f, 0.f};
    bf16x8 At[4][2], B0[2][2], B1[2][2];
    unsigned vC[2][2], vN[2][2];
    AM.offs(cur, K, Rr, Cc, vC);
    const char* const Ab = (const char*)A;
    const char* cB = (const char*)Bt + (size_t)cur.pn * tstep;
    PG8_STAGE(PG8_SB(0, 0), cB, voffB); PG8_STAGE(PG8_SB(0, 1), cB + hstep, voffB); PG8_STAGE(PG8_SA(0, 0), Ab, vC[0]); PG8_STAGE(PG8_SA(0, 1), Ab, vC[1]);
    if (wr == 1) PG8_BAR;
    PG8_WAIT_V(2); PG8_BAR;
    PG8_STAGE(PG8_SB(1, 0), cB + kstep, voffB); PG8_STAGE(PG8_SA(1, 0), Ab + kstep, vC[0]); PG8_STAGE(PG8_SB(1, 1), cB + hstep + kstep, voffB);
    PG8_WAIT_V(6); PG8_BAR;
    for (;;) {
        const bool has_next = S.next(ui + 1, nxt);
        const char* nB = has_next ? (const char*)Bt + (size_t)nxt.pn * tstep : cB;
        if (has_next) AM.offs(nxt, K, Rr, Cc, vN);
        else {
#pragma unroll
            for (int h = 0; h < 2; ++h)
#pragma unroll
                for (int i = 0; i < 2; ++i) vN[h][i] = vC[h][i];
        }
        for (int t = 0; t < nt; t += 2) {
            const bool last = (t == nt - 2);
            if (Hook::T >= 0) { if (t == Hook::T) HK(acc, cur, wr, wc, fr, fq); }
            const char* a1 = Ab + (size_t)(t + 1) * kstep;
            const char* a2 = last ? Ab : Ab + (size_t)(t + 2) * kstep; const char* b2 = last ? nB : cB + (size_t)(t + 2) * kstep;
            const char* a3 = a2 + kstep; const char* b3 = b2 + kstep;
            PG8_LDB(B0, 0, 0); PG8_LDB(B1, 0, 1); PG8_SCHED; PG8_LDA(At, 0, 0); PG8_STAGE(PG8_SA(1, 1), a1, vC[1]);
            if (last) {
#pragma unroll
                for (int h = 0; h < 2; ++h)
#pragma unroll
                    for (int i = 0; i < 2; ++i) vC[h][i] = vN[h][i];
            }
            PG8_WAIT_V(8); PG8_WAIT_L(0); PG8_BAR; PG8_MMA(0, 0, At, B0); PG8_MMA(0, 1, At, B1); PG8_BAR; PG8_SCHED;
            PG8_LDA(At, 0, 1); PG8_STAGE(PG8_SB(0, 0), b2, voffB); PG8_STAGE(PG8_SB(0, 1), b2 + hstep, voffB); PG8_STAGE(PG8_SA(0, 0), a2, vC[0]);
            PG8_WAIT_V(8); PG8_WAIT_L(0); PG8_BAR; PG8_MMA(1, 0, At, B0); PG8_MMA(1, 1, At, B1); PG8_BAR; PG8_SCHED;
            PG8_LDB(B0, 1, 0); PG8_LDB(B1, 1, 1); PG8_SCHED; PG8_LDA(At, 1, 0); PG8_STAGE(PG8_SA(0, 1), a2, vC[1]);
            PG8_WAIT_V(8); PG8_WAIT_L(0); PG8_BAR; PG8_MMA(0, 0, At, B0); PG8_MMA(0, 1, At, B1); PG8_BAR; PG8_SCHED;
            PG8_LDA(At, 1, 1); PG8_STAGE(PG8_SB(1, 0), b3, voffB); PG8_STAGE(PG8_SB(1, 1), b3 + hstep, voffB); PG8_STAGE(PG8_SA(1, 0), a3, vC[0]);
            PG8_WAIT_V(8); PG8_WAIT_L(0); PG8_BAR; PG8_MMA(1, 0, At, B0); PG8_MMA(1, 1, At, B1); PG8_BAR; PG8_SCHED;
        }
        if (wr == 0) PG8_BAR;
        E(acc, cur, wr, wc, fr, fq);
        if (!has_next) break;
#pragma unroll
        for (int a = 0; a < 2; ++a)
#pragma unroll
            for (int b = 0; b < 2; ++b)
#pragma unroll
                for (int m = 0; m < 4; ++m)
#pragma unroll
                    for (int n = 0; n < 2; ++n) acc[a][b][m][n] = (f32x4){0.f, 0.f, 0.f, 0.f};
        cur = nxt; cB = nB; ++ui;
        if (wr == 1) PG8_BAR;
    }
    PG8_WAIT_V(0);
    PG8_BAR;
#undef PG8_SA
#undef PG8_SB
#undef PG8_STAGE
#undef PG8_LDA
#undef PG8_LDB
#undef PG8_MMA
#undef PG8_WAIT_V
#undef PG8_WAIT_L
#undef PG8_BAR
#undef PG8_SCHED
}
}
using pg8::Unit;

struct EpiInProj {
    static constexpr bool PERM = true;
    bf16_t *QA, *KA, *VAT, *QB, *KB, *VBT, *G; const float* cosT; const float* sinT;
    __device__ __forceinline__ void operator()(const f32x4 (&acc)[2][2][4][2], const Unit& u, int wr, int wc, int fr, int fq) const {
        const int pn = u.pn, row0 = u.pm * 256 + wr * 64 + fr;
        if (pn < 5 || (pn >= 6 && pn < 12)) {
            bf16_t* base; int ld, colt; float sc;
            if (pn < 4) { base = QA; ld = 1024; colt = pn * 256; sc = QSCALE; }
            else if (pn == 4) { base = KA; ld = 256; colt = 0; sc = 1.f; }
            else if (pn < 9) { base = QB; ld = 768; colt = (pn - 6) * 256; sc = QSCALE; }
            else { base = KB; ld = 768; colt = (pn - 9) * 256; sc = 1.f; }
            const int col = colt + 64 * wc + 8 * fq;
#pragma unroll
            for (int ai = 0; ai < 2; ++ai)
#pragma unroll
                for (int m = 0; m < 4; ++m) {
                    const int row = row0 + ai * 128 + m * 16, pos = row & (SEQ - 1);
                    const f32x4 c0 = *(const f32x4*)(cosT + pos * 32 + 8 * fq), c1 = *(const f32x4*)(cosT + pos * 32 + 8 * fq + 4);
                    const f32x4 s0 = *(const f32x4*)(sinT + pos * 32 + 8 * fq), s1 = *(const f32x4*)(sinT + pos * 32 + 8 * fq + 4);
                    const f32x4 x10 = acc[ai][0][m][0], x11 = acc[ai][0][m][1], x20 = acc[ai][1][m][0], x21 = acc[ai][1][m][1];
                    const f32x4 o10 = (x10 * c0 - x20 * s0) * sc, o11 = (x11 * c1 - x21 * s1) * sc;
                    const f32x4 o20 = (x20 * c0 + x10 * s0) * sc, o21 = (x21 * c1 + x11 * s1) * sc;
                    u32x4 w1, w2;
                    w1.x = pk2(o10[0], o10[1]); w1.y = pk2(o10[2], o10[3]); w1.z = pk2(o11[0], o11[1]); w1.w = pk2(o11[2], o11[3]);
                    w2.x = pk2(o20[0], o20[1]); w2.y = pk2(o20[2], o20[3]); w2.z = pk2(o21[0], o21[1]); w2.w = pk2(o21[2], o21[3]);
                    bf16_t* rp = base + (size_t)row * ld + col;
                    *(u32x4*)rp = w1; *(u32x4*)(rp + 32) = w2;
                }
        } else if (pn == 5 || (pn >= 12 && pn < 15)) {
            bf16_t* base; int H, hoff, sh;
            if (pn == 5) { base = VAT; H = 4; hoff = 0; sh = 0; } else { base = VBT; H = 12; hoff = 4 * (pn - 12); sh = 2 * (pn - 12); }
            const int dmask = (1 << sh) - 1;
#pragma unroll
            for (int ai = 0; ai < 2; ++ai)
#pragma unroll
                for (int m = 0; m < 4; ++m) {
                    const int row = row0 + ai * 128 + m * 16, b = row >> 11, pos = row & (SEQ - 1);
                    const int idx = ((pos & dmask) << (11 - sh)) | (pos >> sh);
#pragma unroll
                    for (int bj = 0; bj < 2; ++bj) {
                        const int head = hoff + 2 * bj + (wc >> 1), d0 = 32 * (wc & 1) + 8 * fq;
                        bf16_t* p = base + ((size_t)((b * H + head) * 64 + d0) << 11) + idx;
#pragma unroll
                        for (int n = 0; n < 2; ++n) { const f32x4 v = acc[ai][bj][m][n];
                            const unsigned w0 = pk2(v[0], v[1]), w1 = pk2(v[2], v[3]);
                            p[(size_t)(4 * n + 0) << 11] = (bf16_t)(w0 & 0xffffu); p[(size_t)(4 * n + 1) << 11] = (bf16_t)(w0 >> 16);
                            p[(size_t)(4 * n + 2) << 11] = (bf16_t)(w1 & 0xffffu); p[(size_t)(4 * n + 3) << 11] = (bf16_t)(w1 >> 16); }
                    }
                }
        } else {
            const int col = (pn - 15) * 256 + wc * 32 + 8 * fq;
#pragma unroll
            for (int ai = 0; ai < 2; ++ai)
#pragma unroll
                for (int m = 0; m < 4; ++m) {
                    bf16_t* rp = G + (size_t)(row0 + ai * 128 + m * 16) * 2048 + col;
#pragma unroll
                    for (int bj = 0; bj < 2; ++bj) { const f32x4 v0 = acc[ai][bj][m][0], v1 = acc[ai][bj][m][1]; u32x4 w;
                        w.x = pk2(fast_sigmoid(v0[0]), fast_sigmoid(v0[1])); w.y = pk2(fast_sigmoid(v0[2]), fast_sigmoid(v0[3]));
                        w.z = pk2(fast_sigmoid(v1[0]), fast_sigmoid(v1[1])); w.w = pk2(fast_sigmoid(v1[2]), fast_sigmoid(v1[3]));
                        *(u32x4*)(rp + bj * 128) = w; }
                }
        }
    }
};
struct HookGateRatio {
    static constexpr int T = 16;
    const bf16_t* G;
    __device__ __forceinline__ void operator()(f32x4 (&acc)[2][2][4][2], const Unit& u, int wr, int wc, int fr, int fq) const {
        unsigned loff = (unsigned)((wr * 64 + fr) * 2048 + wc * 32 + 8 * fq) * 2u;
        asm volatile("" : "+v"(loff));
        const char* gbase = (const char*)G + ((size_t)u.pm * 256 * 2048 + (size_t)u.pn * 256) * 2;
#pragma unroll
        for (int ai = 0; ai < 2; ++ai)
#pragma unroll
            for (int m = 0; m < 4; ++m) {
                const bf16_t* rp = (const bf16_t*)(gbase + (size_t)(ai * 128 + m * 16) * 4096 + loff);
#pragma unroll
                for (int bj = 0; bj < 2; ++bj) {
                    const u32x4 ga = *(const u32x4*)(rp + bj * 128), gb = *(const u32x4*)(rp + 1024 + bj * 128);
                    f32x4 r0, r1;
                    r0[0] = bflo(ga.x) * __builtin_amdgcn_rcpf(bflo(gb.x)); r0[1] = bfhi(ga.x) * __builtin_amdgcn_rcpf(bfhi(gb.x));
                    r0[2] = bflo(ga.y) * __builtin_amdgcn_rcpf(bflo(gb.y)); r0[3] = bfhi(ga.y) * __builtin_amdgcn_rcpf(bfhi(gb.y));
                    r1[0] = bflo(ga.z) * __builtin_amdgcn_rcpf(bflo(gb.z)); r1[1] = bfhi(ga.z) * __builtin_amdgcn_rcpf(bfhi(gb.z));
                    r1[2] = bflo(ga.w) * __builtin_amdgcn_rcpf(bflo(gb.w)); r1[3] = bfhi(ga.w) * __builtin_amdgcn_rcpf(bfhi(gb.w));
                    acc[ai][bj][m][0] *= r0; acc[ai][bj][m][1] *= r1;
                }
                asm volatile("" ::: "memory");
            }
    }
};
struct EpiMerged {
    static constexpr bool PERM = true;
    const bf16_t* G; bf16_t* O;
    __device__ __forceinline__ void operator()(const f32x4 (&acc)[2][2][4][2], const Unit& u, int wr, int wc, int fr, int fq) const {
        const int row0 = u.pm * 256 + wr * 64 + fr, col = u.pn * 256 + wc * 32 + 8 * fq;
#pragma unroll
        for (int ai = 0; ai < 2; ++ai)
#pragma unroll
            for (int m = 0; m < 4; ++m) {
                const size_t r = (size_t)(row0 + ai * 128 + m * 16);
#pragma unroll
                for (int bj = 0; bj < 2; ++bj) {
                    const u32x4 gb = *(const u32x4*)(G + r * 2048 + 1024 + col + bj * 128);
                    const f32x4 v0 = acc[ai][bj][m][0], v1 = acc[ai][bj][m][1]; u32x4 w;
                    w.x = pk2(v0[0] * bflo(gb.x), v0[1] * bfhi(gb.x)); w.y = pk2(v0[2] * bflo(gb.y), v0[3] * bfhi(gb.y));
                    w.z = pk2(v1[0] * bflo(gb.z), v1[1] * bfhi(gb.z)); w.w = pk2(v1[2] * bflo(gb.w), v1[3] * bfhi(gb.w));
                    *(u32x4*)(O + r * 1024 + col + bj * 128) = w;
                }
                if (m & 1) asm volatile("" ::: "memory");
            }
    }
};
struct EpiPre {
    static constexpr bool PERM = false;
    const float* X; float* O;
    __device__ __forceinline__ void operator()(const f32x4 (&acc)[2][2][4][2], const Unit& u, int wr, int wc, int fr, int fq) const {
        const int row0 = u.pm * 256 + wr * 64 + fr, col = u.pn * 256 + wc * 32 + 4 * fq;
#pragma unroll
        for (int ai = 0; ai < 2; ++ai)
#pragma unroll
            for (int m = 0; m < 4; ++m) {
                const size_t off = (size_t)(row0 + ai * 128 + m * 16) * 1024 + col;
#pragma unroll
                for (int bj = 0; bj < 2; ++bj)
#pragma unroll
                    for (int n = 0; n < 2; ++n) { const f32x4 xv = *(const f32x4*)(X + off + bj * 128 + n * 16); *(f32x4*)(O + off + bj * 128 + n * 16) = xv * ALPHA + acc[ai][bj][m][n]; }
            }
    }
};
struct EpiSwiglu {
    static constexpr bool PERM = true;
    const float* bgu; bf16_t* Hh;
    __device__ __forceinline__ void operator()(const f32x4 (&acc)[2][2][4][2], const Unit& u, int wr, int wc, int fr, int fq) const {
        const int e = u.pn >> 3, j = u.pn & 7, row0 = u.pm * 256 + wr * 64 + fr, col = j * 128 + wc * 32 + 8 * fq;
        const float* bp = bgu + (size_t)e * 2048 + col;
        const f32x4 bg0 = *(const f32x4*)bp, bg1 = *(const f32x4*)(bp + 4), bu0 = *(const f32x4*)(bp + 1024), bu1 = *(const f32x4*)(bp + 1028);
#pragma unroll
        for (int ai = 0; ai < 2; ++ai)
#pragma unroll
            for (int m = 0; m < 4; ++m) {
                f32x4 g0 = acc[ai][0][m][0] + bg0, g1 = acc[ai][0][m][1] + bg1, u0 = acc[ai][1][m][0] + bu0, u1 = acc[ai][1][m][1] + bu1;
                float o[8];
#pragma unroll
                for (int q = 0; q < 4; ++q) {
                    float g = __builtin_fminf(g0[q], 7.f), up = __builtin_fminf(__builtin_fmaxf(u0[q], -7.f), 7.f); o[q] = (up + 1.f) * g * fast_sigmoid(1.702f * g);
                    g = __builtin_fminf(g1[q], 7.f); up = __builtin_fminf(__builtin_fmaxf(u1[q], -7.f), 7.f); o[4 + q] = (up + 1.f) * g * fast_sigmoid(1.702f * g);
                }
                u32x4 w; w.x = pk2(o[0], o[1]); w.y = pk2(o[2], o[3]); w.z = pk2(o[4], o[5]); w.w = pk2(o[6], o[7]);
                *(u32x4*)(Hh + (size_t)(row0 + ai * 128 + m * 16) * 1024 + col) = w;
            }
    }
};
struct EpiDown {
    static constexpr bool PERM = true;
    const float* bd; const int* dst; bf16_t* Y;
    __device__ __forceinline__ void operator()(const f32x4 (&acc)[2][2][4][2], const Unit& u, int wr, int wc, int fr, int fq) const {
        const int e = u.pn >> 2, j = u.pn & 3, row0 = u.pm * 256 + wr * 64 + fr, col = j * 256 + wc * 32 + 8 * fq;
        const float* bp = bd + (size_t)e * 1024 + col;
        f32x4 bv[2][2];
#pragma unroll
        for (int bj = 0; bj < 2; ++bj) { bv[bj][0] = *(const f32x4*)(bp + bj * 128); bv[bj][1] = *(const f32x4*)(bp + bj * 128 + 4); }
#pragma unroll
        for (int ai = 0; ai < 2; ++ai)
#pragma unroll
            for (int m = 0; m < 4; ++m) {
                const int d = dst[row0 + ai * 128 + m * 16];
                if (d >= 0) {
                    bf16_t* rp = Y + (size_t)d * 1024 + col;
#pragma unroll
                    for (int bj = 0; bj < 2; ++bj) { const f32x4 v0 = acc[ai][bj][m][0] + bv[bj][0], v1 = acc[ai][bj][m][1] + bv[bj][1]; u32x4 w;
                        w.x = pk2(v0[0], v0[1]); w.y = pk2(v0[2], v0[3]); w.z = pk2(v1[0], v1[1]); w.w = pk2(v1[2], v1[3]);
                        *(u32x4*)(rp + bj * 128) = w; }
                }
            }
    }
};

__device__ __forceinline__ int crow(int r, int hi) { return (r & 3) + 8 * (r >> 2) + 4 * hi; }
__device__ __forceinline__ void attn_task(const bf16_t* __restrict__ q, int qld, const bf16_t* __restrict__ k, int kld, const bf16_t* __restrict__ vt, bf16_t* o, int old,
                                          float* lse, int lseld, int dil, int qt, int nback, bool has_sink, float sink2, int lane) {
    const int r = lane & 31, hi = lane >> 5, c0 = 32 * qt;
    bf16x8 qf[4];
    { const bf16_t* qp = q + (size_t)(c0 + r) * dil * qld + 8 * hi;
#pragma unroll
      for (int ds = 0; ds < 4; ++ds) qf[ds] = *(const bf16x8*)(qp + 16 * ds); }
    float m = has_sink ? sink2 : -1e30f, l = (has_sink && hi == 0) ? 1.f : 0.f;
    f32x16 O0 = {}, O1 = {};
    const int kt0 = qt > 4 ? qt - 4 : 0;
    const int qpos = c0 + r;
    for (int kt = kt0; kt <= qt; ++kt) {
        bf16x8 kf[4];
        { const bf16_t* kp = k + (size_t)(32 * kt + r) * dil * kld + 8 * hi;
#pragma unroll
          for (int ds = 0; ds < 4; ++ds) kf[ds] = *(const bf16x8*)(kp + 16 * ds); }
        s16x4 va[2][2][2];
#pragma unroll
        for (int dt = 0; dt < 2; ++dt)
#pragma unroll
            for (int s = 0; s < 2; ++s) { const bf16_t* vp = vt + ((size_t)(32 * dt + r) << 11) + 32 * kt + 16 * s + 4 * hi; va[dt][s][0] = *(const s16x4*)vp; va[dt][s][1] = *(const s16x4*)(vp + 8); }
        f32x16 x = {};
#pragma unroll
        for (int ds = 0; ds < 4; ++ds) x = __builtin_amdgcn_mfma_f32_32x32x16_bf16(kf[ds], qf[ds], x, 0, 0, 0);
        if (kt == qt || kt == qt - 4) {
            const int kb = 32 * kt;
#pragma unroll
            for (int i = 0; i < 16; ++i) { const int dist = qpos - (kb + crow(i, hi)); if (dist < 0 || dist > nback) x[i] = -INFINITY; }
        }
        float mx = x[0];
#pragma unroll
        for (int i = 1; i < 16; ++i) mx = __builtin_fmaxf(mx, x[i]);
        mx = __builtin_fmaxf(mx, __shfl_xor(mx, 32));
        const float mnew = __builtin_fmaxf(m, mx), alpha = __builtin_amdgcn_exp2f(m - mnew);
        m = mnew;
        float ls = 0.f;
#pragma unroll
        for (int i = 0; i < 16; ++i) { x[i] = __builtin_amdgcn_exp2f(x[i] - mnew); ls += x[i]; }
        l = l * alpha + ls;
#pragma unroll
        for (int i = 0; i < 16; ++i) { O0[i] *= alpha; O1[i] *= alpha; }
        bf16x8 pf[2];
#pragma unroll
        for (int s = 0; s < 2; ++s) { u32x4 p; p.x = pk2(x[8 * s], x[8 * s + 1]); p.y = pk2(x[8 * s + 2], x[8 * s + 3]); p.z = pk2(x[8 * s + 4], x[8 * s + 5]); p.w = pk2(x[8 * s + 6], x[8 * s + 7]); pf[s] = __builtin_bit_cast(bf16x8, p); }
#pragma unroll
        for (int s = 0; s < 2; ++s) {
            const bf16x8 v0 = __builtin_shufflevector(va[0][s][0], va[0][s][1], 0, 1, 2, 3, 4, 5, 6, 7), v1 = __builtin_shufflevector(va[1][s][0], va[1][s][1], 0, 1, 2, 3, 4, 5, 6, 7);
            O0 = __builtin_amdgcn_mfma_f32_32x32x16_bf16(v0, pf[s], O0, 0, 0, 0);
            O1 = __builtin_amdgcn_mfma_f32_32x32x16_bf16(v1, pf[s], O1, 0, 0, 0);
        }
    }
    l += __shfl_xor(l, 32);
    const float inv = 1.0f / l;
    bf16_t* op = o + (size_t)(c0 + r) * dil * old + 4 * hi;
#pragma unroll
    for (int g = 0; g < 4; ++g) {
        u32x2 w0, w1;
        w0.x = pk2(O0[4 * g] * inv, O0[4 * g + 1] * inv); w0.y = pk2(O0[4 * g + 2] * inv, O0[4 * g + 3] * inv);
        w1.x = pk2(O1[4 * g] * inv, O1[4 * g + 1] * inv); w1.y = pk2(O1[4 * g + 2] * inv, O1[4 * g + 3] * inv);
        *(u32x2*)(op + 8 * g) = w0; *(u32x2*)(op + 32 + 8 * g) = w1;
    }
    if (lse && hi == 0) lse[(size_t)(c0 + r) * dil * lseld] = m + __builtin_amdgcn_logf(l);
}

struct Args { const float* in[16]; float* out; unsigned char* ws; int ph_lo, ph_hi; };
constexpr int NPHASE = 12;

__device__ __forceinline__ void p0_transpose_item(const float* W, int N, int k0, int n0, bf16_t* WT, size_t ldo, size_t orow0, size_t ocol0, LAS float* scr, int lane) {
#pragma unroll 8
    for (int i = 0; i < 32; ++i) { const int kk = 2 * i + (lane >> 5); scr[kk * 33 + (lane & 31)] = W[(size_t)(k0 + kk) * N + n0 + (lane & 31)]; }
    LDS_WAIT(); asm volatile("" ::: "memory");
    const int c = lane & 7;
#pragma unroll
    for (int j = 0; j < 4; ++j) { const int n = (lane >> 3) + 8 * j; const LAS float* s = scr + (8 * c) * 33 + n;
        u32x4 o; o.x = pk2(s[0 * 33], s[1 * 33]); o.y = pk2(s[2 * 33], s[3 * 33]); o.z = pk2(s[4 * 33], s[5 * 33]); o.w = pk2(s[6 * 33], s[7 * 33]);
        *(u32x4*)(WT + (orow0 + n) * ldo + ocol0 + 8 * c) = o; }
    LDS_WAIT(); asm volatile("" ::: "memory");
}

__global__ void __launch_bounds__(512, 2) mk_fwd(Args args) {
    extern __shared__ __attribute__((aligned(16))) unsigned char lds_raw[];
    LAS unsigned char* lds = (LAS unsigned char*)lds_raw;
    volatile LAS unsigned* MISC = (volatile LAS unsigned*)(lds + MISC_OFF);
    const int tid = threadIdx.x, lane = tid & 63, wave = __builtin_amdgcn_readfirstlane(tid >> 6);
    const int G = gridDim.x, bx = blockIdx.x;
    const int gw = bx * 8 + wave, NGW = G * 8;
    unsigned char* const ws = args.ws;
    unsigned* const ctl = (unsigned*)(ws + WS_CTL);
#define X_IN     (args.in[0])
#define w_in     (args.in[1])
#define sinks    (args.in[2])
#define w_ba     (args.in[3])
#define w_bb     (args.in[4])
#define w_out    (args.in[5])
#define ln1g     (args.in[6])
#define ln1b     (args.in[7])
#define w_router (args.in[8])
#define b_router (args.in[9])
#define w_gu     (args.in[10])
#define b_gu     (args.in[11])
#define w_dn     (args.in[12])
#define b_dn     (args.in[13])
#define ln2g     (args.in[14])
#define ln2b     (args.in[15])
#define OUTP     (args.out)
#define cosT   ((float*)(ws + WS_COS))
#define sinT   ((float*)(ws + WS_SIN))
#define WIN    ((bf16_t*)(ws + WS_WIN))
#define WAB    ((bf16_t*)(ws + WS_WAB))
#define WOUT   ((bf16_t*)(ws + WS_WOUT))
#define WGU    ((bf16_t*)(ws + WS_WGU))
#define WDN    ((bf16_t*)(ws + WS_WDN))
#define TOPE   ((int*)(ws + WS_TOPE))
#define TOPW   ((float*)(ws + WS_TOPW))
#define HIST   ((int*)(ws + WS_HIST))
#define ROWTOK ((int*)(ws + WS_ROWTOK))
#define ROWDST ((int*)(ws + WS_ROWDST))
#define TILEE  ((int*)(ws + WS_TILEE))
#define OAB    ((bf16_t*)(ws + WS_OAB))
#define XB     ((bf16_t*)(ws + WS_XB))
#define H1     ((bf16_t*)(ws + WS_H1))
#define Gt     ((bf16_t*)(ws + WS_G))
#define KB     ((bf16_t*)(ws + WS_KB))
#define VAT    ((bf16_t*)(ws + WS_VAT))
#define VBT    ((bf16_t*)(ws + WS_VBT))
#define OG     ((bf16_t*)(ws + WS_OG))
#define LSE    ((float*)(ws + WS_LSE))
#define MERGED ((bf16_t*)(ws + WS_MERGED))
#define Hh     ((bf16_t*)(ws + WS_H))
#define Y      ((bf16_t*)(ws + WS_Y))
#define QA     ((bf16_t*)((unsigned char*)args.out + DO_QA))
#define QB     ((bf16_t*)((unsigned char*)args.out + DO_QB))
#define KA     ((bf16_t*)((unsigned char*)args.out + DO_KA))

    for (int u = tid; u < (LDS_BYTES - LDSCTL_OFF) / 4; u += 512) ((LAS unsigned*)(lds + LDSCTL_OFF))[u] = 0u;
    __syncthreads();
    XcdBarrier bar; bar.bar = ctl + CW_BAR; bar.x = 0; bar.st = nullptr;
    if (MK_ONE_LAUNCH) bar = xcd_barrier_post(ctl + CW_BAR, MISC + 8);
    const int lo = args.ph_lo, hi = args.ph_hi;
#ifndef PH_MASK
#define PH_MASK 0xFFFF
#endif
#define IN(k) (((PH_MASK >> (k)) & 1) && lo <= (k) && (k) < hi)
#define SEAM(k) do { if (IN(k) && IN((k) + 1)) xcd_barrier(bar); } while (0)

    if (IN(0)) {
        LAS float* scr = (LAS float*)(lds + wave * 16384);
        constexpr int I_IN = 16 * 184, I_BA = 16 * 32, I_BB = 4 * 32, I_OUT = 16 * 32, I_GU = 32 * 16 * 64, I_DN = 32 * 16 * 32;
        constexpr int NITEMS = I_IN + I_BA + I_BB + I_OUT + I_GU + I_DN;
        for (int it = gw; it < NITEMS; it += NGW) {
            int r = it;
            if (r < I_IN) { const int kb = r / 184, nb = r % 184, n0 = 32 * nb, tile = n0 >> 8, within = n0 & 255;
                const bool rope = tile < 5 || (tile >= 6 && tile < 12);
                const int orow = rope ? tile * 256 + 128 * ((within & 63) >> 5) + 32 * (within >> 6) : n0;
                p0_transpose_item(w_in, INW, 64 * kb, n0, WIN, 1024, orow, 64 * kb, scr, lane); continue; } r -= I_IN;
            if (r < I_BA) { const int kb = r / 32, nb = r % 32; p0_transpose_item(w_ba, 1024, 64 * kb, 32 * nb, WAB, 1280, 32 * nb, 64 * kb, scr, lane); continue; } r -= I_BA;
            if (r < I_BB) { const int kb = r / 32, nb = r % 32; p0_transpose_item(w_bb, 1024, 64 * kb, 32 * nb, WAB, 1280, 32 * nb, 1024 + 64 * kb, scr, lane); continue; } r -= I_BB;
            if (r < I_OUT) { const int kb = r / 32, nb = r % 32; p0_transpose_item(w_out, 1024, 64 * kb, 32 * nb, WOUT, 1024, 32 * nb, 64 * kb, scr, lane); continue; } r -= I_OUT;
            if (r < I_GU) { const int e = r / 1024, q = r % 1024, kb = q / 64, nb = q % 64, n0 = 32 * nb, np = n0 & 1023;
                const int orow = e * 2048 + (np >> 7) * 256 + (n0 >= 1024 ? 128 : 0) + (np & 127);
                p0_transpose_item(w_gu + (size_t)e * 1024 * 2048, 2048, 64 * kb, n0, WGU, 1024, orow, 64 * kb, scr, lane); continue; } r -= I_GU;
            { const int e = r / 512, q = r % 512, kb = q / 32, nb = q % 32;
                p0_transpose_item(w_dn + (size_t)e * 1024 * 1024, 1024, 64 * kb, 32 * nb, WDN, 1024, e * 1024 + 32 * nb, 64 * kb, scr, lane); }
        }
        for (size_t i = (size_t)bx * 512 + tid; i < (size_t)T * D / 8; i += (size_t)G * 512) {
            const f32x4 a = *(const f32x4*)(X_IN + i * 8), b = *(const f32x4*)(X_IN + i * 8 + 4);
            u32x4 w; w.x = pk2(a[0], a[1]); w.y = pk2(a[2], a[3]); w.z = pk2(b[0], b[1]); w.w = pk2(b[2], b[3]);
            *(u32x4*)(XB + i * 8) = w;
        }
        for (int i = bx * 512 + tid; i < SEQ * 32; i += G * 512) {
            const int pos = i >> 5, f = i & 31;
            const double invf = exp2(-(double)f * (13.287712379549449 / 32.0));
            const double ang = (double)pos * invf;
            cosT[i] = (float)cos(ang); sinT[i] = (float)sin(ang);
        }
    }
    SEAM(0);

    if (IN(1)) {
        pg8::StaticOrder S; S.init(T, INW, G, bx);
        EpiInProj E{QA, KA, VAT, QB, KB, VBT, Gt, cosT, sinT};
        pg8::gemm_phase(lds, XB, WIN, 1024, S, pg8::ADense{}, E, pg8::NoHook{});
    }
    SEAM(1);

    if (IN(2)) {
        for (int ui = bx; ui < 1024; ui += G) {
            if (ui < 512) {
                const int kvh = ui & 3, blk = (ui >> 2) & 3, b = ui >> 4;
                for (int i = 0; i < 8; ++i) {
                    const int t = wave + 8 * i, qtl = t >> 2, hq = t & 3, head = kvh * 4 + hq;
                    attn_task(QA + (size_t)b * SEQ * 1024 + head * 64, 1024, KA + (size_t)b * SEQ * 256 + kvh * 64, 256, VAT + ((size_t)(b * 4 + kvh) * 64 << 11),
                              OAB + (size_t)b * SEQ * 1280 + head * 64, 1280, nullptr, 0, 1, blk * 16 + qtl, 127, true, sinks[head] * LOG2E, lane);
                }
            } else {
                const int id = ui - 512, hh = id & 3, blk = (id >> 2) & 3, b = id >> 4;
                for (int i = 0; i < 6; ++i) {
                    const int t = wave + 8 * i, g = t >> 4, tt = t & 15;
                    int res, qt, dil, L;
                    if (g == 0) { res = 0; qt = blk * 16 + tt; dil = 1; L = 2048; }
                    else if (g == 1) { res = tt >> 2; qt = blk * 4 + (tt & 3); dil = 4; L = 512; }
                    else { res = tt; qt = blk; dil = 16; L = 128; }
                    const int h12 = 4 * g + hh; const size_t trow = (size_t)b * SEQ + res;
                    attn_task(QB + trow * 768 + h12 * 64, 768, KB + trow * 768 + h12 * 64, 768, VBT + ((size_t)(b * 12 + h12) * 64 << 11) + res * L,
                              OG + trow * 768 + h12 * 64, 768, LSE + trow * 12 + h12, 12, dil, qt, 128, false, 0.f, lane);
                }
                VM_WAIT(); __syncthreads();
                for (int it = 0; it < 8; ++it) {
                    const int tokl = it * 64 + (tid >> 3), ch = tid & 7; const size_t tok = (size_t)b * SEQ + blk * 512 + tokl;
                    const float l0 = LSE[tok * 12 + hh], l1 = LSE[tok * 12 + 4 + hh], l2 = LSE[tok * 12 + 8 + hh];
                    const float mx = __builtin_fmaxf(l0, __builtin_fmaxf(l1, l2));
                    float w0 = __builtin_amdgcn_exp2f(l0 - mx), w1 = __builtin_amdgcn_exp2f(l1 - mx), w2 = __builtin_amdgcn_exp2f(l2 - mx);
                    const float inv = 1.0f / (w0 + w1 + w2); w0 *= inv; w1 *= inv; w2 *= inv;
                    const u32x4 a = *(const u32x4*)(OG + tok * 768 + hh * 64 + ch * 8), c = *(const u32x4*)(OG + tok * 768 + (4 + hh) * 64 + ch * 8), d = *(const u32x4*)(OG + tok * 768 + (8 + hh) * 64 + ch * 8);
                    u32x4 w;
                    w.x = pk2(w0 * bflo(a.x) + w1 * bflo(c.x) + w2 * bflo(d.x), w0 * bfhi(a.x) + w1 * bfhi(c.x) + w2 * bfhi(d.x));
                    w.y = pk2(w0 * bflo(a.y) + w1 * bflo(c.y) + w2 * bflo(d.y), w0 * bfhi(a.y) + w1 * bfhi(c.y) + w2 * bfhi(d.y));
                    w.z = pk2(w0 * bflo(a.z) + w1 * bflo(c.z) + w2 * bflo(d.z), w0 * bfhi(a.z) + w1 * bfhi(c.z) + w2 * bfhi(d.z));
                    w.w = pk2(w0 * bflo(a.w) + w1 * bflo(c.w) + w2 * bflo(d.w), w0 * bfhi(a.w) + w1 * bfhi(c.w) + w2 * bfhi(d.w));
                    *(u32x4*)(OAB + tok * 1280 + 1024 + hh * 64 + ch * 8) = w;
                }
                __syncthreads();
            }
        }
    }
    SEAM(2);

    if (IN(3)) {
        pg8::StaticOrder S; S.init(T, 1024, G, bx);
        EpiMerged E{Gt, MERGED}; HookGateRatio HK{Gt};
        pg8::gemm_phase(lds, OAB, WAB, 1280, S, pg8::ADense{}, E, HK);
    }
    SEAM(3);

    if (IN(4)) {
        pg8::StaticOrder S; S.init(T, 1024, G, bx);
        EpiPre E{X_IN, OUTP};
        pg8::gemm_phase(lds, MERGED, WOUT, 1024, S, pg8::ADense{}, E, pg8::NoHook{});
    }
    SEAM(4);

    if (IN(5)) {
        LAS float* Wt = (LAS float*)lds;
        LAS int* histL = (LAS int*)(lds + SCR_OFF);
        for (int idx = tid; idx < 32 * 1024; idx += 512) { const int e = idx >> 10, d = idx & 1023; Wt[idx] = w_router[d * 32 + e]; }
        f32x4 gg[4], bb[4];
#pragma unroll
        for (int j = 0; j < 4; ++j) { gg[j] = *(const f32x4*)(ln1g + 4 * lane + 256 * j); bb[j] = *(const f32x4*)(ln1b + 4 * lane + 256 * j); }
        const int e_lane = (((lane >> 5) & 1) << 4) | (((lane >> 4) & 1) << 3) | (((lane >> 3) & 1) << 2) | (((lane >> 2) & 1) << 1) | ((lane >> 1) & 1);
        const float brl = b_router[e_lane];
        for (int vw = bx; vw < 256; vw += G) {
            if (tid < 32) histL[tid] = 0;
            __syncthreads();
            for (int pr = 0; pr < 16; ++pr) {
                const int row0 = vw * 256 + wave * 32 + 2 * pr;
                f32x4 hn[2][4];
#pragma unroll
                for (int rr = 0; rr < 2; ++rr) {
                    const float* pp = OUTP + (size_t)(row0 + rr) * 1024 + 4 * lane;
                    float s = 0.f;
#pragma unroll
                    for (int j = 0; j < 4; ++j) { hn[rr][j] = *(const f32x4*)(pp + 256 * j); s += (hn[rr][j][0] + hn[rr][j][1]) + (hn[rr][j][2] + hn[rr][j][3]); }
                    const float mean = wave_sum(s) * (1.f / 1024.f); float s2 = 0.f;
#pragma unroll
                    for (int j = 0; j < 4; ++j) { hn[rr][j] = hn[rr][j] - mean; s2 += (hn[rr][j][0] * hn[rr][j][0] + hn[rr][j][1] * hn[rr][j][1]) + (hn[rr][j][2] * hn[rr][j][2] + hn[rr][j][3] * hn[rr][j][3]); }
                    const float rstd = 1.0f / sqrtf(wave_sum(s2) * (1.f / 1024.f) + LN_EPS);
                    bf16_t* hp = H1 + (size_t)(row0 + rr) * 1024 + 4 * lane;
#pragma unroll
                    for (int j = 0; j < 4; ++j) { hn[rr][j] = hn[rr][j] * rstd * gg[j] + bb[j]; u32x2 w; w.x = pk2(hn[rr][j][0], hn[rr][j][1]); w.y = pk2(hn[rr][j][2], hn[rr][j][3]); *(u32x2*)(hp + 256 * j) = w; }
                }
                float p0[32], p1[32];
#pragma unroll
                for (int e = 0; e < 32; ++e) {
                    float a0 = 0.f, a1 = 0.f;
#pragma unroll
                    for (int j = 0; j < 4; ++j) { const f32x4 w = *(const LAS f32x4*)(Wt + e * 1024 + 256 * j + 4 * lane);
                        a0 += hn[0][j][0] * w[0] + hn[0][j][1] * w[1] + hn[0][j][2] * w[2] + hn[0][j][3] * w[3];
                        a1 += hn[1][j][0] * w[0] + hn[1][j][1] * w[1] + hn[1][j][2] * w[2] + hn[1][j][3] * w[3]; }
                    p0[e] = a0; p1[e] = a1;
                }
#define TRSTEP(off, n) do { const bool up_ = (lane & (off)) != 0; _Pragma("unroll") for (int i_ = 0; i_ < (n); ++i_) { \
                    const float s0_ = up_ ? p0[i_] : p0[i_ + (n)], k0_ = up_ ? p0[i_ + (n)] : p0[i_]; p0[i_] = k0_ + __shfl_xor(s0_, (off)); \
                    const float s1_ = up_ ? p1[i_] : p1[i_ + (n)], k1_ = up_ ? p1[i_ + (n)] : p1[i_]; p1[i_] = k1_ + __shfl_xor(s1_, (off)); } } while (0)
                TRSTEP(32, 16); TRSTEP(16, 8); TRSTEP(8, 4); TRSTEP(4, 2); TRSTEP(2, 1);
#undef TRSTEP
                float lg[2]; lg[0] = p0[0] + __shfl_xor(p0[0], 1) + brl; lg[1] = p1[0] + __shfl_xor(p1[0], 1) + brl;
#pragma unroll
                for (int rr = 0; rr < 2; ++rr) {
                    float val = lg[rr]; float tv[4]; int te[4];
#pragma unroll
                    for (int kk = 0; kk < 4; ++kk) {
                        float bv = val; int bi = e_lane;
#pragma unroll
                        for (int o = 1; o < 64; o <<= 1) { const float ov = __shfl_xor(bv, o); const int oi = __shfl_xor(bi, o); if (ov > bv || (ov == bv && oi < bi)) { bv = ov; bi = oi; } }
                        tv[kk] = bv; te[kk] = bi; if (e_lane == bi) val = -INFINITY;
                    }
                    const float e1 = __expf(tv[1] - tv[0]), e2 = __expf(tv[2] - tv[0]), e3 = __expf(tv[3] - tv[0]); const float inv = 1.0f / (1.0f + e1 + e2 + e3);
                    if (lane == 0) { const size_t tk = (size_t)(row0 + rr) * 4;
                        *(int4*)(TOPE + tk) = make_int4(te[0], te[1], te[2], te[3]); *(f32x4*)(TOPW + tk) = (f32x4){inv, e1 * inv, e2 * inv, e3 * inv}; }
                    if (lane < 4) { const int ee = lane == 0 ? te[0] : lane == 1 ? te[1] : lane == 2 ? te[2] : te[3]; atomicAdd((int*)(histL + ee), 1); }
                }
            }
            __syncthreads();
            if (tid < 32) HIST[vw * 32 + tid] = histL[tid];
            __syncthreads();
        }
    }
    SEAM(5);

    if (IN(6)) {
        LAS int* part = (LAS int*)(lds + SCR_OFF);
        LAS int* cntL = part + 512; LAS int* befL = cntL + 32; LAS int* tstL = befL + 32; LAS int* baseL = tstL + 40; LAS int* curL = baseL + 32;
        for (int vw = bx; vw < 256; vw += G) {
            const int hf = vw >> 7, wl = vw & 127;
            { const int e = tid & 31, p = tid >> 5; int s = 0;
              for (int i = 0; i < 8; ++i) s += HIST[(128 * hf + 8 * p + i) * 32 + e];
              part[p * 32 + e] = s; }
            __syncthreads();
            if (tid < 32) { int tot = 0, bef = 0; const int pw = wl >> 3, iw = wl & 7;
                for (int p = 0; p < 16; ++p) { const int v = part[p * 32 + tid]; tot += v; if (p < pw) bef += v; }
                for (int i = 0; i < iw; ++i) bef += HIST[(128 * hf + 8 * pw + i) * 32 + tid];
                cntL[tid] = tot; befL[tid] = bef; curL[tid] = 0; }
            __syncthreads();
            if (tid == 0) { int run = 0; for (int e = 0; e < 32; ++e) { tstL[e] = run; run += (cntL[e] + 255) >> 8; } tstL[32] = run; }
            __syncthreads();
            if (tid < 32) baseL[tid] = tstL[tid] * 256 + befL[tid];
            __syncthreads();
            int* rt = ROWTOK + (size_t)hf * HROWS; int* rd = ROWDST + (size_t)hf * HROWS;
            for (int idx = tid; idx < 1024; idx += 512) {
                const int tok = vw * 256 + (idx >> 2), kk = idx & 3, e = TOPE[(size_t)tok * 4 + kk];
                const int pos = baseL[e] + atomicAdd((int*)(curL + e), 1);
                rt[pos] = tok; rd[pos] = (tok - hf * HALF_T) * 4 + kk;
            }
            if (wl < 32) { const int e = wl, r0 = tstL[e] * 256 + cntL[e], r1 = tstL[e + 1] * 256;
                for (int r = r0 + tid; r < r1; r += 512) { rt[r] = hf * HALF_T; rd[r] = -1; } }
            if (wl == 32) { int* te = TILEE + hf * 1024; const int nt = tstL[32];
                for (int t = tid; t < nt; t += 512) { int e = 0; for (int q = 1; q < 32; ++q) if (t >= tstL[q]) e = q; te[t] = e; }
                if (tid == 0) te[1000] = nt; }
            __syncthreads();
        }
    }
    SEAM(6);

#pragma unroll
    for (int hf = 0; hf < 2; ++hf) {
        const int p_gu = 7 + 2 * hf, p_dn = 8 + 2 * hf, p_cb = 9 + 2 * hf;
        const int* te = TILEE + hf * 1024; const int* rt = ROWTOK + (size_t)hf * HROWS; const int* rd = ROWDST + (size_t)hf * HROWS;
        if (IN(p_gu)) {
            const int NT = te[1000];
            pg8::MoeOrder S; S.init(te, NT, 8, G, bx);
            EpiSwiglu E{b_gu, Hh};
            pg8::gemm_phase(lds, H1, WGU, 1024, S, pg8::AGather{rt}, E, pg8::NoHook{});
        }
        SEAM(p_gu);
        if (IN(p_dn)) {
            const int NT = te[1000];
            pg8::MoeOrder S; S.init(te, NT, 4, G, bx);
            EpiDown E{b_dn, rd, Y};
            pg8::gemm_phase(lds, Hh, WDN, 1024, S, pg8::ADense{}, E, pg8::NoHook{});
        }
        SEAM(p_dn);
        if (IN(p_cb)) {
            f32x4 g2[4], b2[4];
#pragma unroll
            for (int j = 0; j < 2; ++j) { g2[2 * j] = *(const f32x4*)(ln2g + 8 * lane + 512 * j); g2[2 * j + 1] = *(const f32x4*)(ln2g + 8 * lane + 512 * j + 4);
                b2[2 * j] = *(const f32x4*)(ln2b + 8 * lane + 512 * j); b2[2 * j + 1] = *(const f32x4*)(ln2b + 8 * lane + 512 * j + 4); }
            for (int tl = gw; tl < HALF_T; tl += NGW) {
                const int tok = hf * HALF_T + tl;
                const f32x4 wv = *(const f32x4*)(TOPW + (size_t)tok * 4);
                f32x4 v[4]; float s = 0.f;
#pragma unroll
                for (int j = 0; j < 2; ++j) {
                    const int c = 8 * lane + 512 * j;
                    const u32x4 hh = *(const u32x4*)(H1 + (size_t)tok * 1024 + c);
                    f32x4 a = (f32x4){bflo(hh.x), bfhi(hh.x), bflo(hh.y), bfhi(hh.y)} * ALPHA, b = (f32x4){bflo(hh.z), bfhi(hh.z), bflo(hh.w), bfhi(hh.w)} * ALPHA;
#pragma unroll
                    for (int kk = 0; kk < 4; ++kk) { const u32x4 yy = *(const u32x4*)(Y + ((size_t)tl * 4 + kk) * 1024 + c); const float w = wv[kk];
                        a += (f32x4){bflo(yy.x), bfhi(yy.x), bflo(yy.y), bfhi(yy.y)} * w; b += (f32x4){bflo(yy.z), bfhi(yy.z), bflo(yy.w), bfhi(yy.w)} * w; }
                    v[2 * j] = a; v[2 * j + 1] = b; s += (a[0] + a[1]) + (a[2] + a[3]) + (b[0] + b[1]) + (b[2] + b[3]);
                }
                const float mean = wave_sum(s) * (1.f / 1024.f); float s2 = 0.f;
#pragma unroll
                for (int j = 0; j < 4; ++j) { v[j] = v[j] - mean; s2 += (v[j][0] * v[j][0] + v[j][1] * v[j][1]) + (v[j][2] * v[j][2] + v[j][3] * v[j][3]); }
                const float rstd = 1.0f / sqrtf(wave_sum(s2) * (1.f / 1024.f) + LN_EPS);
                float* op = OUTP + (size_t)tok * 1024 + 8 * lane;
#pragma unroll
                for (int j = 0; j < 2; ++j) { *(f32x4*)(op + 512 * j) = v[2 * j] * rstd * g2[2 * j] + b2[2 * j]; *(f32x4*)(op + 512 * j + 4) = v[2 * j + 1] * rstd * g2[2 * j + 1] + b2[2 * j + 1]; }
            }
        }
        if (hf == 1) {   }
    }
#undef IN
#undef SEAM
}

extern "C" void kernel_launch(void* const* d_in, const int* in_sizes, int n_in, void* d_out, int out_size, void* d_ws, size_t ws_size, hipStream_t stream) {
    static int grid = 0;
    if (grid == 0) {
        if (n_in != 16 || in_sizes[0] != T * D || out_size != T * D || ws_size < WS_END) { fprintf(stderr, "kernel_launch: unexpected shapes / workspace (%d inputs, ws %zu)\n", n_in, ws_size); grid = -1; return; }
        int dev = 0, cus = 0, per_cu = 0;
        if (hipGetDevice(&dev) != hipSuccess || hipDeviceGetAttribute(&cus, hipDeviceAttributeMultiprocessorCount, dev) != hipSuccess) { grid = -1; return; }
        if (hipFuncSetAttribute((const void*)mk_fwd, hipFuncAttributeMaxDynamicSharedMemorySize, LDS_BYTES) != hipSuccess) { fprintf(stderr, "kernel_launch: hipFuncSetAttribute failed\n"); grid = -1; return; }
        if (hipOccupancyMaxActiveBlocksPerMultiprocessor(&per_cu, (const void*)mk_fwd, 512, LDS_BYTES) != hipSuccess || per_cu < 1) { fprintf(stderr, "kernel_launch: occupancy query says %d\n", per_cu); }
        (void)hipGetLastError();
        grid = cus;
    }
    if (grid < 0) return;
    if (hipMemsetAsync((char*)d_ws + WS_CTL, 0, CTL_ZERO_BYTES, stream) != hipSuccess) return;
    Args a{};
    for (int i = 0; i < 16; ++i) a.in[i] = (const float*)d_in[i];
    a.out = (float*)d_out; a.ws = (unsigned char*)d_ws;
#if MK_ONE_LAUNCH
    a.ph_lo = 0; a.ph_hi = NPHASE;
    hipLaunchKernelGGL(mk_fwd, dim3(grid), dim3(512), LDS_BYTES, stream, a);
#else
    for (int p = 0; p < NPHASE; ++p) { a.ph_lo = p; a.ph_hi = p + 1; hipLaunchKernelGGL(mk_fwd, dim3(grid), dim3(512), LDS_BYTES, stream, a); }
#endif
}
```

```cpp
#include <hip/hip_runtime.h>
#include <cstdio>
#include <cstdint>

#ifndef MK_ONE_LAUNCH
#define MK_ONE_LAUNCH 1
#endif

#define LAS __attribute__((address_space(3)))
#define GAS __attribute__((address_space(1)))
typedef unsigned short bf16_t;
typedef short bf16x8 __attribute__((ext_vector_type(8)));
typedef short s16x4 __attribute__((ext_vector_type(4)));
typedef float f32x4 __attribute__((ext_vector_type(4)));
typedef float f32x2 __attribute__((ext_vector_type(2)));
typedef float f32x16 __attribute__((ext_vector_type(16)));
typedef unsigned u32x4 __attribute__((ext_vector_type(4)));
typedef unsigned u32x2 __attribute__((ext_vector_type(2)));
typedef __bf16 bf16x2_t __attribute__((ext_vector_type(2)));

constexpr int SEQ = 2048, NB = 32, T = NB * SEQ, D = 1024, INW = 5888, NE = 32, TOPK = 4;
constexpr float LN_EPS = 1e-5f;
constexpr float ALPHA = 1.189207115002721f;
constexpr float LOG2E = 1.4426950408889634f;
constexpr float QSCALE = 0.125f * LOG2E;
constexpr int HALF_T = T / 2;
constexpr int HROWS = HALF_T * TOPK + NE * 256;
constexpr int HTILES = HROWS / 256;

constexpr size_t MiB = 1u << 20;
constexpr size_t WS_CTL = 0, CTL_ZERO_BYTES = 1 * MiB;
constexpr size_t WS_COS = 1 * MiB, WS_SIN = WS_COS + 256 * 1024;
constexpr size_t WS_WIN = 2 * MiB;
constexpr size_t WS_WAB = 14 * MiB;
constexpr size_t WS_WOUT = 17 * MiB;
constexpr size_t WS_TOPE = 19 * MiB, WS_TOPW = 20 * MiB, WS_HIST = 21 * MiB;
constexpr size_t WS_ROWTOK = 22 * MiB, WS_ROWDST = 24 * MiB, WS_TILEE = 26 * MiB;
constexpr size_t WS_WGU = 32 * MiB;
constexpr size_t WS_WDN = 160 * MiB;
constexpr size_t WS_OAB = 224 * MiB;
constexpr size_t WS_XB = 224 * MiB;
constexpr size_t WS_H1 = 224 * MiB;
constexpr size_t WS_G = 384 * MiB;
constexpr size_t WS_KB = 640 * MiB;
constexpr size_t WS_VAT = 736 * MiB;
constexpr size_t WS_VBT = 768 * MiB;
constexpr size_t WS_OG = 864 * MiB;
constexpr size_t WS_LSE = 960 * MiB;
constexpr size_t WS_MERGED = 640 * MiB;
constexpr size_t WS_H = 352 * MiB;
constexpr size_t WS_Y = 624 * MiB;
constexpr size_t WS_END = 1024 * MiB;
static_assert(WS_H + (size_t)HROWS * 1024 * 2 <= WS_Y && WS_Y + (size_t)HALF_T * 4 * 1024 * 2 <= WS_END, "ws map");
static_assert(WS_LSE + (size_t)T * 12 * 4 <= WS_END && WS_OG + (size_t)T * 768 * 2 <= WS_LSE && WS_VBT + (size_t)T * 768 * 2 <= WS_OG, "ws map");
constexpr size_t DO_QA = 0, DO_QB = 128 * MiB, DO_KA = 224 * MiB;

constexpr int CW_TMO = 0, CW_CODE = 1, CW_BAR = 4096;

constexpr int RING_BYTES = 131072;
constexpr int LDSCTL_OFF = 135168, MISC_OFF = LDSCTL_OFF + 320, SCR_OFF = LDSCTL_OFF + 1024;
constexpr int LDS_BYTES = 151552;

#define RLX_AGENT __ATOMIC_RELAXED, __HIP_MEMORY_SCOPE_AGENT
#define LDS_WAIT() asm volatile("s_waitcnt lgkmcnt(0)" ::: "memory")
#define VM_WAIT() asm volatile("s_waitcnt vmcnt(0)" ::: "memory")
__device__ __forceinline__ unsigned pk2(float lo, float hi) { f32x2 v = {lo, hi}; bf16x2_t b = __builtin_convertvector(v, bf16x2_t); return __builtin_bit_cast(unsigned, b); }
__device__ __forceinline__ float bflo(unsigned w) { return __uint_as_float(w << 16); }
__device__ __forceinline__ float bfhi(unsigned w) { return __uint_as_float(w & 0xffff0000u); }
__device__ __forceinline__ float fast_sigmoid(float z) { return __builtin_amdgcn_rcpf(1.0f + __builtin_amdgcn_exp2f(-z * LOG2E)); }
__device__ __forceinline__ float wave_sum(float v) {
#pragma unroll
    for (int o = 1; o < 64; o <<= 1) v += __shfl_xor(v, o);
    return v;
}

#define XB_TMO      128
#define XB_XCNT(j)  (256  + 64 * (j))
#define XB_XSUB(j)  (1280 + 64 * (j))
#define XB_XGEN(j)  (2304 + 64 * (j))
#define XB_TOP      3328
#define XB_TOPGEN   3392
#define XCD_BAR_WORDS 3456
#define XB_SPIN_CAP (1u << 18)
__device__ __forceinline__ unsigned xb_ld(unsigned* p)              { return __hip_atomic_load(p, __ATOMIC_RELAXED, __HIP_MEMORY_SCOPE_AGENT); }
__device__ __forceinline__ unsigned xb_add(unsigned* p, unsigned v) { return __hip_atomic_fetch_add(p, v, __ATOMIC_RELAXED, __HIP_MEMORY_SCOPE_AGENT); }
__device__ __forceinline__ unsigned xb_xcc_id() { return (unsigned)__builtin_amdgcn_s_getreg((3 << 11) | 20) & 0xFu; }
#define XB_SPIN(cond, bar) do { unsigned _sp = 0; while (cond) { __builtin_amdgcn_s_sleep(1); \
    if ((++_sp & 255u) == 0u) { if (xb_ld(&(bar)[XB_TMO])) break; if (_sp > XB_SPIN_CAP) { atomicAdd(&(bar)[XB_TMO], 1u); break; } } } } while (0)
struct XcdBarrier { unsigned* bar; unsigned x; volatile LAS unsigned* st; };
__device__ __forceinline__ XcdBarrier xcd_barrier_post(unsigned* bar, volatile LAS unsigned* st) {
    XcdBarrier b; b.bar = bar; b.x = xb_xcc_id(); b.st = st;
    if (threadIdx.x == 0) (void)xb_add(&bar[XB_XCNT(b.x)], 1u);
    return b;
}
__device__ __forceinline__ void xcd_barrier_complete(unsigned* bar, unsigned x, unsigned& nloc, unsigned& nx) {
    const unsigned G = gridDim.x * gridDim.y * gridDim.z;
    unsigned sum, cnt, mine, sp = 0u;
    for (;;) {
        sum = 0u; cnt = 0u; mine = 0u;
#pragma unroll
        for (unsigned j = 0; j < 16; ++j) { const unsigned c = xb_ld(&bar[XB_XCNT(j)]); sum += c; cnt += (c > 0u) ? 1u : 0u; mine = (j == x) ? c : mine; }
        if (sum == G) break;
        __builtin_amdgcn_s_sleep(1);
        if ((++sp & 255u) == 0u) { if (xb_ld(&bar[XB_TMO])) break; if (sp > XB_SPIN_CAP) { atomicAdd(&bar[XB_TMO], 1u); break; } }
    }
    nloc = mine > 0u ? mine : 1u; nx = cnt > 0u ? cnt : 1u;
}
__device__ __forceinline__ void xcd_barrier(const XcdBarrier& b) {
    asm volatile("s_waitcnt vmcnt(0)" ::: "memory");
    __syncthreads();
    if (threadIdx.x == 0) {
        unsigned* bar = b.bar;
        __builtin_amdgcn_s_waitcnt(0);
        unsigned nloc = b.st[0], nx = b.st[1];
        if (nloc == 0u) { xcd_barrier_complete(bar, b.x, nloc, nx); b.st[0] = nloc; b.st[1] = nx; }
        const unsigned old = xb_add(&bar[XB_XSUB(b.x)], 1u);
        const unsigned gen = old / nloc;
        if (old + 1u == (gen + 1u) * nloc) {
            __builtin_amdgcn_fence(__ATOMIC_RELEASE, "agent");
            asm volatile("s_waitcnt vmcnt(0)" ::: "memory");
            const unsigned og = xb_add(&bar[XB_TOP], 1u);
            const unsigned tg = og / nx;
            if (og + 1u == (tg + 1u) * nx) xb_add(&bar[XB_TOPGEN], 1u);
            else XB_SPIN(xb_ld(&bar[XB_TOPGEN]) == tg, bar);
            __builtin_amdgcn_fence(__ATOMIC_ACQUIRE, "agent");
            xb_add(&bar[XB_XGEN(b.x)], 1u);
            asm volatile("s_waitcnt vmcnt(0)" ::: "memory");
        } else {
            XB_SPIN(xb_ld(&bar[XB_XGEN(b.x)]) == gen, bar);
            __builtin_amdgcn_fence(__ATOMIC_ACQUIRE, "agent");
            asm volatile("s_waitcnt vmcnt(0)" ::: "memory");
        }
    }
    __syncthreads();
}

namespace pg8 {
constexpr int BM = 256, BK = 64, HALF = 128, HTB = HALF * BK * 2, STAGE_BYTES = 8 * HTB, NXCD = 8, WGM = 8;
__host__ __device__ __forceinline__ int lds_byte(int r, int c) { const int st = (r >> 4) * 2 + (c >> 5), rr = r & 15, cc = c & 31, ob = rr * 64 + cc * 2; return st * 1024 + (ob ^ (((ob >> 9) & 1) << 5)); }
__host__ __device__ __forceinline__ void stage_rc(int b, int& R, int& C) { const int st = b / 1024, sb = b % 1024, swz = sb ^ (((sb >> 9) & 1) << 5); R = (st >> 1) * 16 + swz / 64; C = (st & 1) * 32 + (swz % 64) / 2; }
__host__ __device__ __forceinline__ int perm32(int rho) { const int n = rho >> 4, i = rho & 15; return 8 * (i >> 2) + 4 * n + (i & 3); }

struct Unit { int pm, pn; };

struct StaticOrder {
    int nM, nN, nwg, G, c;
    __device__ void init(int M, int N, int G_, int c_) { nM = M / BM; nN = N / BM; nwg = nM * nN; G = G_; c = c_; }
    __device__ bool next(int i, Unit& u) const {
        const long L = (long)i * G + c; if (L >= nwg) return false;
        int wgid = (int)L; { const int q = nwg / NXCD, r = nwg % NXCD, xcd = wgid % NXCD, off = wgid / NXCD; wgid = (xcd < r ? xcd * (q + 1) : r * (q + 1) + (xcd - r) * q) + off; }
        const int nig = WGM * nN, gid = wgid / nig, fm = gid * WGM, gsz = (nM - fm) < WGM ? (nM - fm) : WGM;
        u.pm = fm + ((wgid % nig) % gsz); u.pn = (wgid % nig) / gsz; return true;
    }
};
struct MoeOrder {
    const int* tile_e; int NJ, W, r, t0, t1;
    __device__ void init(const int* te, int NT, int NJ_, int G, int c) {
        tile_e = te; NJ = NJ_;
        if (G % 8 == 0) { const int x = c % 8; r = c / 8; W = G / 8; t0 = (int)((long)NT * x / 8); t1 = (int)((long)NT * (x + 1) / 8); }
        else { r = c; W = G; t0 = 0; t1 = NT; }
    }
    __device__ bool next(int i, Unit& u) const {
        const int idx = i * W + r, ntl = t1 - t0; if (idx >= ntl * NJ) return false;
        const int GT = 32 / NJ, per = GT * NJ, grp = idx / per, rem = idx - grp * per, gsz = (ntl - grp * GT) < GT ? (ntl - grp * GT) : GT;
        const int tile = t0 + grp * GT + rem % gsz, j = rem / gsz;
        u.pm = tile; u.pn = tile_e[tile] * NJ + j; return true;
    }
};
struct ADense {
    __device__ __forceinline__ void offs(const Unit& u, int K, const int (&R)[2], const int (&C)[2], unsigned (&vo)[2][2]) const {
#pragma unroll
        for (int h = 0; h < 2; ++h)
#pragma unroll
            for (int i = 0; i < 2; ++i) vo[h][i] = (unsigned)((u.pm * BM + h * HALF + R[i]) * K + C[i]) * 2u;
    }
};
struct AGather {
    const int* tok;
    __device__ __forceinline__ void offs(const Unit& u, int K, const int (&R)[2], const int (&C)[2], unsigned (&vo)[2][2]) const {
#pragma unroll
        for (int h = 0; h < 2; ++h)
#pragma unroll
            for (int i = 0; i < 2; ++i) vo[h][i] = (unsigned)(tok[u.pm * BM + h * HALF + R[i]] * K + C[i]) * 2u;
    }
};
struct NoHook { static constexpr int T = -1; __device__ __forceinline__ void operator()(f32x4 (&)[2][2][4][2], const Unit&, int, int, int, int) const {} };

template <class Epi, class Sched, class AMap, class Hook>
__device__ __forceinline__ void gemm_phase(LAS unsigned char* lds, const bf16_t* A, const bf16_t* Bt, const int K, const Sched& S, const AMap& AM, const Epi& E, const Hook& HK) {
    const int tid = threadIdx.x, wid = __builtin_amdgcn_readfirstlane(tid >> 6), lane = tid & 63, wr = wid >> 2, wc = wid & 3, fr = lane & 15, fq = lane >> 4;
    const int nt = K / BK;
    int Rr[2], Cc[2]; unsigned voffB[2];
#pragma unroll
    for (int i = 0; i < 2; ++i) { stage_rc(tid * 16 + i * 8192, Rr[i], Cc[i]); const int Rb = Epi::PERM ? ((Rr[i] & ~31) + perm32(Rr[i] & 31)) : Rr[i]; voffB[i] = (unsigned)(Rb * K + Cc[i]) * 2u; }
    const size_t kstep = (size_t)(BK * 2);
    const size_t hstep = (size_t)HALF * K * 2;
    const size_t tstep = 2 * hstep;
    const unsigned ldsw = (unsigned)wid * 1024u;
    const int aoff = lds_byte(wr * 64 + fr, fq * 8), boff = lds_byte(wc * 32 + fr, fq * 8);
#define PG8_SA(b, h) (((b) * 2 + (h)) * HTB)
#define PG8_SB(b, h) ((4 + (b) * 2 + (h)) * HTB)
#define PG8_STAGE(bufoff, gbase, voff) do { _Pragma("unroll") for (int _i = 0; _i < 2; ++_i) \
        __builtin_amdgcn_global_load_lds((const unsigned*)((const char*)(gbase) + (voff)[_i]), (LAS unsigned*)(lds + (bufoff) + ldsw + _i * 8192), 16, 0, 0); } while (0)
#define PG8_LDA(dst, b, h) do { _Pragma("unroll") for (int m = 0; m < 4; ++m) _Pragma("unroll") for (int k = 0; k < 2; ++k) dst[m][k] = *(const LAS bf16x8*)(lds + PG8_SA(b, h) + aoff + m * 2048 + k * 1024); } while (0)
#define PG8_LDB(dst, b, h) do { _Pragma("unroll") for (int n = 0; n < 2; ++n) _Pragma("unroll") for (int k = 0; k < 2; ++k) dst[n][k] = *(const LAS bf16x8*)(lds + PG8_SB(b, h) + boff + n * 2048 + k * 1024); } while (0)
#define PG8_MMA(ai, bj, At, Bt_) do { __builtin_amdgcn_s_setprio(1); _Pragma("unroll") for (int m = 0; m < 4; ++m) _Pragma("unroll") for (int n = 0; n < 2; ++n) _Pragma("unroll") for (int k = 0; k < 2; ++k) \
        acc[ai][bj][m][n] = __builtin_amdgcn_mfma_f32_16x16x32_bf16(Bt_[n][k], At[m][k], acc[ai][bj][m][n], 0, 0, 0); __builtin_amdgcn_s_setprio(0); } while (0)
#define PG8_WAIT_V(n) asm volatile("s_waitcnt vmcnt(" #n ")" ::: "memory")
#define PG8_WAIT_L(n) asm volatile("s_waitcnt lgkmcnt(" #n ")" ::: "memory")
#define PG8_BAR __builtin_amdgcn_s_barrier()
#define PG8_SCHED __builtin_amdgcn_sched_barrier(0)
    Unit cur, nxt; int ui = 0;
    if (!S.next(0, cur)) return;
    f32x4 acc[2][2][4][2];
#pragma unroll
    for (int a = 0; a < 2; ++a)
#pragma unroll
        for (int b = 0; b < 2; ++b)
#pragma unroll
            for (int m = 0; m < 4; ++m)
#pragma unroll
                for (int n = 0; n < 2; ++n) acc[a][b][m][n] = (f32x4){0.f, 0.f, 0.f, 0.f};
    bf16x8 At[4][2], B0[2][2], B1[2][2];
    unsigned vC[2][2], vN[2][2];
    AM.offs(cur, K, Rr, Cc, vC);
    const char* const Ab = (const char*)A;
    const char* cB = (const char*)Bt + (size_t)cur.pn * tstep;
    PG8_STAGE(PG8_SB(0, 0), cB, voffB); PG8_STAGE(PG8_SB(0, 1), cB + hstep, voffB); PG8_STAGE(PG8_SA(0, 0), Ab, vC[0]); PG8_STAGE(PG8_SA(0, 1), Ab, vC[1]);
    if (wr == 1) PG8_BAR;
    PG8_WAIT_V(2); PG8_BAR;
    PG8_STAGE(PG8_SB(1, 0), cB + kstep, voffB); PG8_STAGE(PG8_SA(1, 0), Ab + kstep, vC[0]); PG8_STAGE(PG8_SB(1, 1), cB + hstep + kstep, voffB);
    PG8_WAIT_V(6); PG8_BAR;
    for (;;) {
        const bool has_next = S.next(ui + 1, nxt);
        const char* nB = has_next ? (const char*)Bt + (size_t)nxt.pn * tstep : cB;
        if (has_next) AM.offs(nxt, K, Rr, Cc, vN);
        else {
#pragma unroll
            for (int h = 0; h < 2; ++h)
#pragma unroll
                for (int i = 0; i < 2; ++i) vN[h][i] = vC[h][i];
        }
        for (int t = 0; t < nt; t += 2) {
            const bool last = (t == nt - 2);
            if (Hook::T >= 0) { if (t == Hook::T) HK(acc, cur, wr, wc, fr, fq); }
            const char* a1 = Ab + (size_t)(t + 1) * kstep;
            const char* a2 = last ? Ab : Ab + (size_t)(t + 2) * kstep; const char* b2 = last ? nB : cB + (size_t)(t + 2) * kstep;
            const char* a3 = a2 + kstep; const char* b3 = b2 + kstep;
            PG8_LDB(B0, 0, 0); PG8_LDB(B1, 0, 1); PG8_SCHED; PG8_LDA(At, 0, 0); PG8_STAGE(PG8_SA(1, 1), a1, vC[1]);
            if (last) {
#pragma unroll
                for (int h = 0; h < 2; ++h)
#pragma unroll
                    for (int i = 0; i < 2; ++i) vC[h][i] = vN[h][i];
            }
            PG8_WAIT_V(8); PG8_WAIT_L(0); PG8_BAR; PG8_MMA(0, 0, At, B0); PG8_MMA(0, 1, At, B1); PG8_BAR; PG8_SCHED;
            PG8_LDA(At, 0, 1); PG8_STAGE(PG8_SB(0, 0), b2, voffB); PG8_STAGE(PG8_SB(0, 1), b2 + hstep, voffB); PG8_STAGE(PG8_SA(0, 0), a2, vC[0]);
            PG8_WAIT_V(8); PG8_WAIT_L(0); PG8_BAR; PG8_MMA(1, 0, At, B0); PG8_MMA(1, 1, At, B1); PG8_BAR; PG8_SCHED;
            PG8_LDB(B0, 1, 0); PG8_LDB(B1, 1, 1); PG8_SCHED; PG8_LDA(At, 1, 0); PG8_STAGE(PG8_SA(0, 1), a2, vC[1]);
            PG8_WAIT_V(8); PG8_WAIT_L(0); PG8_BAR; PG8_MMA(0, 0, At, B0); PG8_MMA(0, 1, At, B1); PG8_BAR; PG8_SCHED;
            PG8_LDA(At, 1, 1); PG8_STAGE(PG8_SB(1, 0), b3, voffB); PG8_STAGE(PG8_SB(1, 1), b3 + hstep, voffB); PG8_STAGE(PG8_SA(1, 0), a3, vC[0]);
            PG8_WAIT_V(8); PG8_WAIT_L(0); PG8_BAR; PG8_MMA(1, 0, At, B0); PG8_MMA(1, 1, At, B1); PG8_BAR; PG8_SCHED;
        }
        if (wr == 0) PG8_BAR;
        E(acc, cur, wr, wc, fr, fq);
        if (!has_next) break;
#pragma unroll
        for (int a = 0; a < 2; ++a)
#pragma unroll
            for (int b = 0; b < 2; ++b)
#pragma unroll
                for (int m = 0; m < 4; ++m)
#pragma unroll
                    for (int n = 0; n < 2; ++n) acc[a][b][m][n] = (f32x4){0.f, 0.f, 0.f, 0.f};
        cur = nxt; cB = nB; ++ui;
        if (wr == 1) PG8_BAR;
    }
    PG8_WAIT_V(0);
    PG8_BAR;
#undef PG8_SA
#undef PG8_SB
#undef PG8_STAGE
#undef PG8_LDA
#undef PG8_LDB
#undef PG8_MMA
#undef PG8_WAIT_V
#undef PG8_WAIT_L
#undef PG8_BAR
#undef PG8_SCHED
}
}
using pg8::Unit;

struct EpiInProj {
    static constexpr bool PERM = true;
    bf16_t *QA, *KA, *VAT, *QB, *KB, *VBT, *G; const float* cosT; const float* sinT;
    __device__ __forceinline__ void operator()(const f32x4 (&acc)[2][2][4][2], const Unit& u, int wr, int wc, int fr, int fq) const {
        const int pn = u.pn, row0 = u.pm * 256 + wr * 64 + fr;
        if (pn < 5 || (pn >= 6 && pn < 12)) {
            bf16_t* base; int ld, colt; float sc;
            if (pn < 4) { base = QA; ld = 1024; colt = pn * 256; sc = QSCALE; }
            else if (pn == 4) { base = KA; ld = 256; colt = 0; sc = 1.f; }
            else if (pn < 9) { base = QB; ld = 768; colt = (pn - 6) * 256; sc = QSCALE; }
            else { base = KB; ld = 768; colt = (pn - 9) * 256; sc = 1.f; }
            const int col = colt + 64 * wc + 8 * fq;
#pragma unroll
            for (int ai = 0; ai < 2; ++ai)
#pragma unroll
                for (int m = 0; m < 4; ++m) {
                    const int row = row0 + ai * 128 + m * 16, pos = row & (SEQ - 1);
                    const f32x4 c0 = *(const f32x4*)(cosT + pos * 32 + 8 * fq), c1 = *(const f32x4*)(cosT + pos * 32 + 8 * fq + 4);
                    const f32x4 s0 = *(const f32x4*)(sinT + pos * 32 + 8 * fq), s1 = *(const f32x4*)(sinT + pos * 32 + 8 * fq + 4);
                    const f32x4 x10 = acc[ai][0][m][0], x11 = acc[ai][0][m][1], x20 = acc[ai][1][m][0], x21 = acc[ai][1][m][1];
                    const f32x4 o10 = (x10 * c0 - x20 * s0) * sc, o11 = (x11 * c1 - x21 * s1) * sc;
                    const f32x4 o20 = (x20 * c0 + x10 * s0) * sc, o21 = (x21 * c1 + x11 * s1) * sc;
                    u32x4 w1, w2;
                    w1.x = pk2(o10[0], o10[1]); w1.y = pk2(o10[2], o10[3]); w1.z = pk2(o11[0], o11[1]); w1.w = pk2(o11[2], o11[3]);
                    w2.x = pk2(o20[0], o20[1]); w2.y = pk2(o20[2], o20[3]); w2.z = pk2(o21[0], o21[1]); w2.w = pk2(o21[2], o21[3]);
                    bf16_t* rp = base + (size_t)row * ld + col;
                    *(u32x4*)rp = w1; *(u32x4*)(rp + 32) = w2;
                }
        } else if (pn == 5 || (pn >= 12 && pn < 15)) {
            bf16_t* base; int H, hoff, sh;
            if (pn == 5) { base = VAT; H = 4; hoff = 0; sh = 0; } else { base = VBT; H = 12; hoff = 4 * (pn - 12); sh = 2 * (pn - 12); }
            const int dmask = (1 << sh) - 1;
#pragma unroll
            for (int ai = 0; ai < 2; ++ai)
#pragma unroll
                for (int m = 0; m < 4; ++m) {
                    const int row = row0 + ai * 128 + m * 16, b = row >> 11, pos = row & (SEQ - 1);
                    const int idx = ((pos & dmask) << (11 - sh)) | (pos >> sh);
#pragma unroll
                    for (int bj = 0; bj < 2; ++bj) {
                        const int head = hoff + 2 * bj + (wc >> 1), d0 = 32 * (wc & 1) + 8 * fq;
                        bf16_t* p = base + ((size_t)((b * H + head) * 64 + d0) << 11) + idx;
#pragma unroll
                        for (int n = 0; n < 2; ++n) { const f32x4 v = acc[ai][bj][m][n];
                            const unsigned w0 = pk2(v[0], v[1]), w1 = pk2(v[2], v[3]);
                            p[(size_t)(4 * n + 0) << 11] = (bf16_t)(w0 & 0xffffu); p[(size_t)(4 * n + 1) << 11] = (bf16_t)(w0 >> 16);
                            p[(size_t)(4 * n + 2) << 11] = (bf16_t)(w1 & 0xffffu); p[(size_t)(4 * n + 3) << 11] = (bf16_t)(w1 >> 16); }
                    }
                }
        } else {
            const int col = (pn - 15) * 256 + wc * 32 + 8 * fq;
#pragma unroll
            for (int ai = 0; ai < 2; ++ai)
#pragma unroll
                for (int m = 0; m < 4; ++m) {
                    bf16_t* rp = G + (size_t)(row0 + ai * 128 + m * 16) * 2048 + col;
#pragma unroll
                    for (int bj = 0; bj < 2; ++bj) { const f32x4 v0 = acc[ai][bj][m][0], v1 = acc[ai][bj][m][1]; u32x4 w;
                        w.x = pk2(fast_sigmoid(v0[0]), fast_sigmoid(v0[1])); w.y = pk2(fast_sigmoid(v0[2]), fast_sigmoid(v0[3]));
                        w.z = pk2(fast_sigmoid(v1[0]), fast_sigmoid(v1[1])); w.w = pk2(fast_sigmoid(v1[2]), fast_sigmoid(v1[3]));
                        *(u32x4*)(rp + bj * 128) = w; }
                }
        }
    }
};
struct HookGateRatio {
    static constexpr int T = 16;
    const bf16_t* G;
    __device__ __forceinline__ void operator()(f32x4 (&acc)[2][2][4][2], const Unit& u, int wr, int wc, int fr, int fq) const {
        unsigned loff = (unsigned)((wr * 64 + fr) * 2048 + wc * 32 + 8 * fq) * 2u;
        asm volatile("" : "+v"(loff));
        const char* gbase = (const char*)G + ((size_t)u.pm * 256 * 2048 + (size_t)u.pn * 256) * 2;
#pragma unroll
        for (int ai = 0; ai < 2; ++ai)
#pragma unroll
            for (int m = 0; m < 4; ++m) {
                const bf16_t* rp = (const bf16_t*)(gbase + (size_t)(ai * 128 + m * 16) * 4096 + loff);
#pragma unroll
                for (int bj = 0; bj < 2; ++bj) {
                    const u32x4 ga = *(const u32x4*)(rp + bj * 128), gb = *(const u32x4*)(rp + 1024 + bj * 128);
                    f32x4 r0, r1;
                    r0[0] = bflo(ga.x) * __builtin_amdgcn_rcpf(bflo(gb.x)); r0[1] = bfhi(ga.x) * __builtin_amdgcn_rcpf(bfhi(gb.x));
                    r0[2] = bflo(ga.y) * __builtin_amdgcn_rcpf(bflo(gb.y)); r0[3] = bfhi(ga.y) * __builtin_amdgcn_rcpf(bfhi(gb.y));
                    r1[0] = bflo(ga.z) * __builtin_amdgcn_rcpf(bflo(gb.z)); r1[1] = bfhi(ga.z) * __builtin_amdgcn_rcpf(bfhi(gb.z));
                    r1[2] = bflo(ga.w) * __builtin_amdgcn_rcpf(bflo(gb.w)); r1[3] = bfhi(ga.w) * __builtin_amdgcn_rcpf(bfhi(gb.w));
                    acc[ai][bj][m][0] *= r0; acc[ai][bj][m][1] *= r1;
                }
                asm volatile("" ::: "memory");
            }
    }
};
struct EpiMerged {
    static constexpr bool PERM = true;
    const bf16_t* G; bf16_t* O;
    __device__ __forceinline__ void operator()(const f32x4 (&acc)[2][2][4][2], const Unit& u, int wr, int wc, int fr, int fq) const {
        const int row0 = u.pm * 256 + wr * 64 + fr, col = u.pn * 256 + wc * 32 + 8 * fq;
#pragma unroll
        for (int ai = 0; ai < 2; ++ai)
#pragma unroll
            for (int m = 0; m < 4; ++m) {
                const size_t r = (size_t)(row0 + ai * 128 + m * 16);
#pragma unroll
                for (int bj = 0; bj < 2; ++bj) {
                    const u32x4 gb = *(const u32x4*)(G + r * 2048 + 1024 + col + bj * 128);
                    const f32x4 v0 = acc[ai][bj][m][0], v1 = acc[ai][bj][m][1]; u32x4 w;
                    w.x = pk2(v0[0] * bflo(gb.x), v0[1] * bfhi(gb.x)); w.y = pk2(v0[2] * bflo(gb.y), v0[3] * bfhi(gb.y));
                    w.z = pk2(v1[0] * bflo(gb.z), v1[1] * bfhi(gb.z)); w.w = pk2(v1[2] * bflo(gb.w), v1[3] * bfhi(gb.w));
                    *(u32x4*)(O + r * 1024 + col + bj * 128) = w;
                }
                if (m & 1) asm volatile("" ::: "memory");
            }
    }
};
struct EpiPre {
    static constexpr bool PERM = false;
    const float* X; float* O;
    __device__ __forceinline__ void operator()(const f32x4 (&acc)[2][2][4][2], const Unit& u, int wr, int wc, int fr, int fq) const {
        const int row0 = u.pm * 256 + wr * 64 + fr, col = u.pn * 256 + wc * 32 + 4 * fq;
#pragma unroll
        for (int ai = 0; ai < 2; ++ai)
#pragma unroll
            for (int m = 0; m < 4; ++m) {
                const size_t off = (size_t)(row0 + ai * 128 + m * 16) * 1024 + col;
#pragma unroll
                for (int bj = 0; bj < 2; ++bj)
#pragma unroll
                    for (int n = 0; n < 2; ++n) { const f32x4 xv = *(const f32x4*)(X + off + bj * 128 + n * 16); *(f32x4*)(O + off + bj * 128 + n * 16) = xv * ALPHA + acc[ai][bj][m][n]; }
            }
    }
};
struct EpiSwiglu {
    static constexpr bool PERM = true;
    const float* bgu; bf16_t* Hh;
    __device__ __forceinline__ void operator()(const f32x4 (&acc)[2][2][4][2], const Unit& u, int wr, int wc, int fr, int fq) const {
        const int e = u.pn >> 3, j = u.pn & 7, row0 = u.pm * 256 + wr * 64 + fr, col = j * 128 + wc * 32 + 8 * fq;
        const float* bp = bgu + (size_t)e * 2048 + col;
        const f32x4 bg0 = *(const f32x4*)bp, bg1 = *(const f32x4*)(bp + 4), bu0 = *(const f32x4*)(bp + 1024), bu1 = *(const f32x4*)(bp + 1028);
#pragma unroll
        for (int ai = 0; ai < 2; ++ai)
#pragma unroll
            for (int m = 0; m < 4; ++m) {
                f32x4 g0 = acc[ai][0][m][0] + bg0, g1 = acc[ai][0][m][1] + bg1, u0 = acc[ai][1][m][0] + bu0, u1 = acc[ai][1][m][1] + bu1;
                float o[8];
#pragma unroll
                for (int q = 0; q < 4; ++q) {
                    float g = __builtin_fminf(g0[q], 7.f), up = __builtin_fminf(__builtin_fmaxf(u0[q], -7.f), 7.f); o[q] = (up + 1.f) * g * fast_sigmoid(1.702f * g);
                    g = __builtin_fminf(g1[q], 7.f); up = __builtin_fminf(__builtin_fmaxf(u1[q], -7.f), 7.f); o[4 + q] = (up + 1.f) * g * fast_sigmoid(1.702f * g);
                }
                u32x4 w; w.x = pk2(o[0], o[1]); w.y = pk2(o[2], o[3]); w.z = pk2(o[4], o[5]); w.w = pk2(o[6], o[7]);
                *(u32x4*)(Hh + (size_t)(row0 + ai * 128 + m * 16) * 1024 + col) = w;
            }
    }
};
struct EpiDown {
    static constexpr bool PERM = true;
    const float* bd; const int* dst; bf16_t* Y;
    __device__ __forceinline__ void operator()(const f32x4 (&acc)[2][2][4][2], const Unit& u, int wr, int wc, int fr, int fq) const {
        const int e = u.pn >> 2, j = u.pn & 3, row0 = u.pm * 256 + wr * 64 + fr, col = j * 256 + wc * 32 + 8 * fq;
        const float* bp = bd + (size_t)e * 1024 + col;
        f32x4 bv[2][2];
#pragma unroll
        for (int bj = 0; bj < 2; ++bj) { bv[bj][0] = *(const f32x4*)(bp + bj * 128); bv[bj][1] = *(const f32x4*)(bp + bj * 128 + 4); }
#pragma unroll
        for (int ai = 0; ai < 2; ++ai)
#pragma unroll
            for (int m = 0; m < 4; ++m) {
                const int d = dst[row0 + ai * 128 + m * 16];
                if (d >= 0) {
                    bf16_t* rp = Y + (size_t)d * 1024 + col;
#pragma unroll
                    for (int bj = 0; bj < 2; ++bj) { const f32x4 v0 = acc[ai][bj][m][0] + bv[bj][0], v1 = acc[ai][bj][m][1] + bv[bj][1]; u32x4 w;
                        w.x = pk2(v0[0], v0[1]); w.y = pk2(v0[2], v0[3]); w.z = pk2(v1[0], v1[1]); w.w = pk2(v1[2], v1[3]);
                        *(u32x4*)(rp + bj * 128) = w; }
                }
            }
    }
};

__device__ __forceinline__ int crow(int r, int hi) { return (r & 3) + 8 * (r >> 2) + 4 * hi; }
__device__ __forceinline__ void attn_task(const bf16_t* __restrict__ q, int qld, const bf16_t* __restrict__ k, int kld, const bf16_t* __restrict__ vt, bf16_t* o, int old,
                                          float* lse, int lseld, int dil, int qt, int nback, bool has_sink, float sink2, int lane) {
    const int r = lane & 31, hi = lane >> 5, c0 = 32 * qt;
    bf16x8 qf[4];
    { const bf16_t* qp = q + (size_t)(c0 + r) * dil * qld + 8 * hi;
#pragma unroll
      for (int ds = 0; ds < 4; ++ds) qf[ds] = *(const bf16x8*)(qp + 16 * ds); }
    float m = has_sink ? sink2 : -1e30f, l = (has_sink && hi == 0) ? 1.f : 0.f;
    f32x16 O0 = {}, O1 = {};
    const int kt0 = qt > 4 ? qt - 4 : 0;
    const int qpos = c0 + r;
    for (int kt = kt0; kt <= qt; ++kt) {
        bf16x8 kf[4];
        { const bf16_t* kp = k + (size_t)(32 * kt + r) * dil * kld + 8 * hi;
#pragma unroll
          for (int ds = 0; ds < 4; ++ds) kf[ds] = *(const bf16x8*)(kp + 16 * ds); }
        s16x4 va[2][2][2];
#pragma unroll
        for (int dt = 0; dt < 2; ++dt)
#pragma unroll
            for (int s = 0; s < 2; ++s) { const bf16_t* vp = vt + ((size_t)(32 * dt + r) << 11) + 32 * kt + 16 * s + 4 * hi; va[dt][s][0] = *(const s16x4*)vp; va[dt][s][1] = *(const s16x4*)(vp + 8); }
        f32x16 x = {};
#pragma unroll
        for (int ds = 0; ds < 4; ++ds) x = __builtin_amdgcn_mfma_f32_32x32x16_bf16(kf[ds], qf[ds], x, 0, 0, 0);
        if (kt == qt || kt == qt - 4) {
            const int kb = 32 * kt;
#pragma unroll
            for (int i = 0; i < 16; ++i) { const int dist = qpos - (kb + crow(i, hi)); if (dist < 0 || dist > nback) x[i] = -INFINITY; }
        }
        float mx = x[0];
#pragma unroll
        for (int i = 1; i < 16; ++i) mx = __builtin_fmaxf(mx, x[i]);
        mx = __builtin_fmaxf(mx, __shfl_xor(mx, 32));
        const float mnew = __builtin_fmaxf(m, mx), alpha = __builtin_amdgcn_exp2f(m - mnew);
        m = mnew;
        float ls = 0.f;
#pragma unroll
        for (int i = 0; i < 16; ++i) { x[i] = __builtin_amdgcn_exp2f(x[i] - mnew); ls += x[i]; }
        l = l * alpha + ls;
#pragma unroll
        for (int i = 0; i < 16; ++i) { O0[i] *= alpha; O1[i] *= alpha; }
        bf16x8 pf[2];
#pragma unroll
        for (int s = 0; s < 2; ++s) { u32x4 p; p.x = pk2(x[8 * s], x[8 * s + 1]); p.y = pk2(x[8 * s + 2], x[8 * s + 3]); p.z = pk2(x[8 * s + 4], x[8 * s + 5]); p.w = pk2(x[8 * s + 6], x[8 * s + 7]); pf[s] = __builtin_bit_cast(bf16x8, p); }
#pragma unroll
        for (int s = 0; s < 2; ++s) {
            const bf16x8 v0 = __builtin_shufflevector(va[0][s][0], va[0][s][1], 0, 1, 2, 3, 4, 5, 6, 7), v1 = __builtin_shufflevector(va[1][s][0], va[1][s][1], 0, 1, 2, 3, 4, 5, 6, 7);
            O0 = __builtin_amdgcn_mfma_f32_32x32x16_bf16(v0, pf[s], O0, 0, 0, 0);
            O1 = __builtin_amdgcn_mfma_f32_32x32x16_bf16(v1, pf[s], O1, 0, 0, 0);
        }
    }
    l += __shfl_xor(l, 32);
    const float inv = 1.0f / l;
    bf16_t* op = o + (size_t)(c0 + r) * dil * old + 4 * hi;
#pragma unroll
    for (int g = 0; g < 4; ++g) {
        u32x2 w0, w1;
        w0.x = pk2(O0[4 * g] * inv, O0[4 * g + 1] * inv); w0.y = pk2(O0[4 * g + 2] * inv, O0[4 * g + 3] * inv);
        w1.x = pk2(O1[4 * g] * inv, O1[4 * g + 1] * inv); w1.y = pk2(O1[4 * g + 2] * inv, O1[4 * g + 3] * inv);
        *(u32x2*)(op + 8 * g) = w0; *(u32x2*)(op + 32 + 8 * g) = w1;
    }
    if (lse && hi == 0) lse[(size_t)(c0 + r) * dil * lseld] = m + __builtin_amdgcn_logf(l);
}

struct Args { const float* in[16]; float* out; unsigned char* ws; int ph_lo, ph_hi; };
constexpr int NPHASE = 12;

__device__ __forceinline__ void p0_transpose_item(const float* W, int N, int k0, int n0, bf16_t* WT, size_t ldo, size_t orow0, size_t ocol0, LAS float* scr, int lane) {
#pragma unroll 8
    for (int i = 0; i < 32; ++i) { const int kk = 2 * i + (lane >> 5); scr[kk * 33 + (lane & 31)] = W[(size_t)(k0 + kk) * N + n0 + (lane & 31)]; }
    LDS_WAIT(); asm volatile("" ::: "memory");
    const int c = lane & 7;
#pragma unroll
    for (int j = 0; j < 4; ++j) { const int n = (lane >> 3) + 8 * j; const LAS float* s = scr + (8 * c) * 33 + n;
        u32x4 o; o.x = pk2(s[0 * 33], s[1 * 33]); o.y = pk2(s[2 * 33], s[3 * 33]); o.z = pk2(s[4 * 33], s[5 * 33]); o.w = pk2(s[6 * 33], s[7 * 33]);
        *(u32x4*)(WT + (orow0 + n) * ldo + ocol0 + 8 * c) = o; }
    LDS_WAIT(); asm volatile("" ::: "memory");
}

__global__ void __launch_bounds__(512, 2) mk_fwd(Args args) {
    extern __shared__ __attribute__((aligned(16))) unsigned char lds_raw[];
    LAS unsigned char* lds = (LAS unsigned char*)lds_raw;
    volatile LAS unsigned* MISC = (volatile LAS unsigned*)(lds + MISC_OFF);
    const int tid = threadIdx.x, lane = tid & 63, wave = __builtin_amdgcn_readfirstlane(tid >> 6);
    const int G = gridDim.x, bx = blockIdx.x;
    const int gw = bx * 8 + wave, NGW = G * 8;
    unsigned char* const ws = args.ws;
    unsigned* const ctl = (unsigned*)(ws + WS_CTL);
#define X_IN     (args.in[0])
#define w_in     (args.in[1])
#define sinks    (args.in[2])
#define w_ba     (args.in[3])
#define w_bb     (args.in[4])
#define w_out    (args.in[5])
#define ln1g     (args.in[6])
#define ln1b     (args.in[7])
#define w_router (args.in[8])
#define b_router (args.in[9])
#define w_gu     (args.in[10])
#define b_gu     (args.in[11])
#define w_dn     (args.in[12])
#define b_dn     (args.in[13])
#define ln2g     (args.in[14])
#define ln2b     (args.in[15])
#define OUTP     (args.out)
#define cosT   ((float*)(ws + WS_COS))
#define sinT   ((float*)(ws + WS_SIN))
#define WIN    ((bf16_t*)(ws + WS_WIN))
#define WAB    ((bf16_t*)(ws + WS_WAB))
#define WOUT   ((bf16_t*)(ws + WS_WOUT))
#define WGU    ((bf16_t*)(ws + WS_WGU))
#define WDN    ((bf16_t*)(ws + WS_WDN))
#define TOPE   ((int*)(ws + WS_TOPE))
#define TOPW   ((float*)(ws + WS_TOPW))
#define HIST   ((int*)(ws + WS_HIST))
#define ROWTOK ((int*)(ws + WS_ROWTOK))
#define ROWDST ((int*)(ws + WS_ROWDST))
#define TILEE  ((int*)(ws + WS_TILEE))
#define OAB    ((bf16_t*)(ws + WS_OAB))
#define XB     ((bf16_t*)(ws + WS_XB))
#define H1     ((bf16_t*)(ws + WS_H1))
#define Gt     ((bf16_t*)(ws + WS_G))
#define KB     ((bf16_t*)(ws + WS_KB))
#define VAT    ((bf16_t*)(ws + WS_VAT))
#define VBT    ((bf16_t*)(ws + WS_VBT))
#define OG     ((bf16_t*)(ws + WS_OG))
#define LSE    ((float*)(ws + WS_LSE))
#define MERGED ((bf16_t*)(ws + WS_MERGED))
#define Hh     ((bf16_t*)(ws + WS_H))
#define Y      ((bf16_t*)(ws + WS_Y))
#define QA     ((bf16_t*)((unsigned char*)args.out + DO_QA))
#define QB     ((bf16_t*)((unsigned char*)args.out + DO_QB))
#define KA     ((bf16_t*)((unsigned char*)args.out + DO_KA))

    for (int u = tid; u < (LDS_BYTES - LDSCTL_OFF) / 4; u += 512) ((LAS unsigned*)(lds + LDSCTL_OFF))[u] = 0u;
    __syncthreads();
    XcdBarrier bar; bar.bar = ctl + CW_BAR; bar.x = 0; bar.st = nullptr;
    if (MK_ONE_LAUNCH) bar = xcd_barrier_post(ctl + CW_BAR, MISC + 8);
    const int lo = args.ph_lo, hi = args.ph_hi;
#ifndef PH_MASK
#define PH_MASK 0xFFFF
#endif
#define IN(k) (((PH_MASK >> (k)) & 1) && lo <= (k) && (k) < hi)
#define SEAM(k) do { if (IN(k) && IN((k) + 1)) xcd_barrier(bar); } while (0)
#ifndef REPEAT_MASK
#define REPEAT_MASK 0
#endif
#define REPN(k) ((((REPEAT_MASK) >> (k)) & 1) ? 2 : 1)
#define REP_LOOP(k) for (int rep_ = 0; rep_ < REPN(k); ++rep_)
#define REP_SYNC() do { if (rep_) xcd_barrier(bar); } while (0)

    if (IN(0)) { REP_LOOP(0) { REP_SYNC();
        LAS float* scr = (LAS float*)(lds + wave * 16384);
        constexpr int I_IN = 16 * 184, I_BA = 16 * 32, I_BB = 4 * 32, I_OUT = 16 * 32, I_GU = 32 * 16 * 64, I_DN = 32 * 16 * 32;
        constexpr int NITEMS = I_IN + I_BA + I_BB + I_OUT + I_GU + I_DN;
        for (int it = gw; it < NITEMS; it += NGW) {
            int r = it;
            if (r < I_IN) { const int kb = r / 184, nb = r % 184, n0 = 32 * nb, tile = n0 >> 8, within = n0 & 255;
                const bool rope = tile < 5 || (tile >= 6 && tile < 12);
                const int orow = rope ? tile * 256 + 128 * ((within & 63) >> 5) + 32 * (within >> 6) : n0;
                p0_transpose_item(w_in, INW, 64 * kb, n0, WIN, 1024, orow, 64 * kb, scr, lane); continue; } r -= I_IN;
            if (r < I_BA) { const int kb = r / 32, nb = r % 32; p0_transpose_item(w_ba, 1024, 64 * kb, 32 * nb, WAB, 1280, 32 * nb, 64 * kb, scr, lane); continue; } r -= I_BA;
            if (r < I_BB) { const int kb = r / 32, nb = r % 32; p0_transpose_item(w_bb, 1024, 64 * kb, 32 * nb, WAB, 1280, 32 * nb, 1024 + 64 * kb, scr, lane); continue; } r -= I_BB;
            if (r < I_OUT) { const int kb = r / 32, nb = r % 32; p0_transpose_item(w_out, 1024, 64 * kb, 32 * nb, WOUT, 1024, 32 * nb, 64 * kb, scr, lane); continue; } r -= I_OUT;
            if (r < I_GU) { const int e = r / 1024, q = r % 1024, kb = q / 64, nb = q % 64, n0 = 32 * nb, np = n0 & 1023;
                const int orow = e * 2048 + (np >> 7) * 256 + (n0 >= 1024 ? 128 : 0) + (np & 127);
                p0_transpose_item(w_gu + (size_t)e * 1024 * 2048, 2048, 64 * kb, n0, WGU, 1024, orow, 64 * kb, scr, lane); continue; } r -= I_GU;
            { const int e = r / 512, q = r % 512, kb = q / 32, nb = q % 32;
                p0_transpose_item(w_dn + (size_t)e * 1024 * 1024, 1024, 64 * kb, 32 * nb, WDN, 1024, e * 1024 + 32 * nb, 64 * kb, scr, lane); }
        }
        for (size_t i = (size_t)bx * 512 + tid; i < (size_t)T * D / 8; i += (size_t)G * 512) {
            const f32x4 a = *(const f32x4*)(X_IN + i * 8), b = *(const f32x4*)(X_IN + i * 8 + 4);
            u32x4 w; w.x = pk2(a[0], a[1]); w.y = pk2(a[2], a[3]); w.z = pk2(b[0], b[1]); w.w = pk2(b[2], b[3]);
            *(u32x4*)(XB + i * 8) = w;
        }
        for (int i = bx * 512 + tid; i < SEQ * 32; i += G * 512) {
            const int pos = i >> 5, f = i & 31;
            const double invf = exp2(-(double)f * (13.287712379549449 / 32.0));
            const double ang = (double)pos * invf;
            cosT[i] = (float)cos(ang); sinT[i] = (float)sin(ang);
        }
    }
    }
    SEAM(0);

    if (IN(1)) { REP_LOOP(1) { REP_SYNC();
        pg8::StaticOrder S; S.init(T, INW, G, bx);
        EpiInProj E{QA, KA, VAT, QB, KB, VBT, Gt, cosT, sinT};
        pg8::gemm_phase(lds, XB, WIN, 1024, S, pg8::ADense{}, E, pg8::NoHook{});
    }
    }
    SEAM(1);

    if (IN(2)) { REP_LOOP(2) { REP_SYNC();
        for (int ui = bx; ui < 1024; ui += G) {
            if (ui < 512) {
                const int kvh = ui & 3, blk = (ui >> 2) & 3, b = ui >> 4;
                for (int i = 0; i < 8; ++i) {
                    const int t = wave + 8 * i, qtl = t >> 2, hq = t & 3, head = kvh * 4 + hq;
                    attn_task(QA + (size_t)b * SEQ * 1024 + head * 64, 1024, KA + (size_t)b * SEQ * 256 + kvh * 64, 256, VAT + ((size_t)(b * 4 + kvh) * 64 << 11),
                              OAB + (size_t)b * SEQ * 1280 + head * 64, 1280, nullptr, 0, 1, blk * 16 + qtl, 127, true, sinks[head] * LOG2E, lane);
                }
            } else {
                const int id = ui - 512, hh = id & 3, blk = (id >> 2) & 3, b = id >> 4;
                for (int i = 0; i < 6; ++i) {
                    const int t = wave + 8 * i, g = t >> 4, tt = t & 15;
                    int res, qt, dil, L;
                    if (g == 0) { res = 0; qt = blk * 16 + tt; dil = 1; L = 2048; }
                    else if (g == 1) { res = tt >> 2; qt = blk * 4 + (tt & 3); dil = 4; L = 512; }
                    else { res = tt; qt = blk; dil = 16; L = 128; }
                    const int h12 = 4 * g + hh; const size_t trow = (size_t)b * SEQ + res;
                    attn_task(QB + trow * 768 + h12 * 64, 768, KB + trow * 768 + h12 * 64, 768, VBT + ((size_t)(b * 12 + h12) * 64 << 11) + res * L,
                              OG + trow * 768 + h12 * 64, 768, LSE + trow * 12 + h12, 12, dil, qt, 128, false, 0.f, lane);
                }
                VM_WAIT(); __syncthreads();
                for (int it = 0; it < 8; ++it) {
                    const int tokl = it * 64 + (tid >> 3), ch = tid & 7; const size_t tok = (size_t)b * SEQ + blk * 512 + tokl;
                    const float l0 = LSE[tok * 12 + hh], l1 = LSE[tok * 12 + 4 + hh], l2 = LSE[tok * 12 + 8 + hh];
                    const float mx = __builtin_fmaxf(l0, __builtin_fmaxf(l1, l2));
                    float w0 = __builtin_amdgcn_exp2f(l0 - mx), w1 = __builtin_amdgcn_exp2f(l1 - mx), w2 = __builtin_amdgcn_exp2f(l2 - mx);
                    const float inv = 1.0f / (w0 + w1 + w2); w0 *= inv; w1 *= inv; w2 *= inv;
                    const u32x4 a = *(const u32x4*)(OG + tok * 768 + hh * 64 + ch * 8), c = *(const u32x4*)(OG + tok * 768 + (4 + hh) * 64 + ch * 8), d = *(const u32x4*)(OG + tok * 768 + (8 + hh) * 64 + ch * 8);
                    u32x4 w;
                    w.x = pk2(w0 * bflo(a.x) + w1 * bflo(c.x) + w2 * bflo(d.x), w0 * bfhi(a.x) + w1 * bfhi(c.x) + w2 * bfhi(d.x));
                    w.y = pk2(w0 * bflo(a.y) + w1 * bflo(c.y) + w2 * bflo(d.y), w0 * bfhi(a.y) + w1 * bfhi(c.y) + w2 * bfhi(d.y));
                    w.z = pk2(w0 * bflo(a.z) + w1 * bflo(c.z) + w2 * bflo(d.z), w0 * bfhi(a.z) + w1 * bfhi(c.z) + w2 * bfhi(d.z));
                    w.w = pk2(w0 * bflo(a.w) + w1 * bflo(c.w) + w2 * bflo(d.w), w0 * bfhi(a.w) + w1 * bfhi(c.w) + w2 * bfhi(d.w));
                    *(u32x4*)(OAB + tok * 1280 + 1024 + hh * 64 + ch * 8) = w;
                }
                __syncthreads();
            }
        }
    }
    }
    SEAM(2);

    if (IN(3)) { REP_LOOP(3) { REP_SYNC();
        pg8::StaticOrder S; S.init(T, 1024, G, bx);
        EpiMerged E{Gt, MERGED}; HookGateRatio HK{Gt};
        pg8::gemm_phase(lds, OAB, WAB, 1280, S, pg8::ADense{}, E, HK);
    }
    }
    SEAM(3);

    if (IN(4)) { REP_LOOP(4) { REP_SYNC();
        pg8::StaticOrder S; S.init(T, 1024, G, bx);
        EpiPre E{X_IN, OUTP};
        pg8::gemm_phase(lds, MERGED, WOUT, 1024, S, pg8::ADense{}, E, pg8::NoHook{});
    }
    }
    SEAM(4);

    if (IN(5)) { REP_LOOP(5) { REP_SYNC();
        constexpr int GWROW = 2064;
        LAS unsigned char* GWH = lds; LAS unsigned char* GWL = lds + 32 * GWROW;
        LAS float* gws = (LAS float*)(lds + SCR_OFF); LAS float* bws = gws + 32; LAS int* histL = (LAS int*)(bws + 32); LAS float* partL = (LAS float*)(histL + 32);
        for (int idx = tid; idx < 32 * 1024; idx += 512) { const int d = idx >> 5, e = idx & 31;
            const float v = w_router[idx] * ln1g[d]; const unsigned hb = pk2(v, 0.f) & 0xffffu; const float vh = __uint_as_float(hb << 16); const unsigned lb = pk2(v - vh, 0.f) & 0xffffu;
            ((LAS bf16_t*)(GWH + e * GWROW))[d] = (bf16_t)hb; ((LAS bf16_t*)(GWL + e * GWROW))[d] = (bf16_t)lb; }
        { const int e = tid & 31, p = tid >> 5; float sg = 0.f, sb = 0.f;
          for (int d = 64 * p; d < 64 * p + 64; ++d) { const float w = w_router[d * 32 + e]; sg += ln1g[d] * w; sb += ln1b[d] * w; }
          partL[(p * 32 + e) * 2] = sg; partL[(p * 32 + e) * 2 + 1] = sb; }
        __syncthreads();
        if (tid < 32) { float sg = 0.f, sb = 0.f; for (int p = 0; p < 16; ++p) { sg += partL[(p * 32 + tid) * 2]; sb += partL[(p * 32 + tid) * 2 + 1]; } gws[tid] = sg; bws[tid] = sb + b_router[tid]; }
        __syncthreads();
        const int r32 = lane & 31, hi5 = lane >> 5;
        for (int vw = bx; vw < 256; vw += G) {
            if (tid < 32) histL[tid] = 0;
            __syncthreads();
            const int tok0 = vw * 256 + wave * 32;
            const float* src = OUTP + (size_t)(tok0 + r32) * 1024 + 8 * hi5;
            const LAS unsigned char* ahp = GWH + r32 * GWROW + 16 * hi5; const LAS unsigned char* alp = GWL + r32 * GWROW + 16 * hi5;
            f32x16 acc0 = {}, acc1 = {}, acc2 = {};
            float s1 = 0.f, s2 = 0.f;
            f32x4 xa[4][2], xb[4][2];
#define P5_LOAD(buf, ks0) do { _Pragma("unroll") for (int q_ = 0; q_ < 4; ++q_) { buf[q_][0] = *(const f32x4*)(src + 16 * ((ks0) + q_)); buf[q_][1] = *(const f32x4*)(src + 16 * ((ks0) + q_) + 4); } } while (0)
#define P5_COMP(buf, ks0) do { _Pragma("unroll") for (int q_ = 0; q_ < 4; ++q_) { const f32x4 u0_ = buf[q_][0], u1_ = buf[q_][1]; \
                s1 += (u0_[0] + u0_[1]) + (u0_[2] + u0_[3]) + (u1_[0] + u1_[1]) + (u1_[2] + u1_[3]); \
                s2 += (u0_[0] * u0_[0] + u0_[1] * u0_[1]) + (u0_[2] * u0_[2] + u0_[3] * u0_[3]) + (u1_[0] * u1_[0] + u1_[1] * u1_[1]) + (u1_[2] * u1_[2] + u1_[3] * u1_[3]); \
                u32x4 wh_, wl_; wh_.x = pk2(u0_[0], u0_[1]); wh_.y = pk2(u0_[2], u0_[3]); wh_.z = pk2(u1_[0], u1_[1]); wh_.w = pk2(u1_[2], u1_[3]); \
                wl_.x = pk2(u0_[0] - bflo(wh_.x), u0_[1] - bfhi(wh_.x)); wl_.y = pk2(u0_[2] - bflo(wh_.y), u0_[3] - bfhi(wh_.y)); \
                wl_.z = pk2(u1_[0] - bflo(wh_.z), u1_[1] - bfhi(wh_.z)); wl_.w = pk2(u1_[2] - bflo(wh_.w), u1_[3] - bfhi(wh_.w)); \
                const bf16x8 bh_ = __builtin_bit_cast(bf16x8, wh_), bl_ = __builtin_bit_cast(bf16x8, wl_); \
                const bf16x8 ah_ = *(const LAS bf16x8*)(ahp + 32 * ((ks0) + q_)), al_ = *(const LAS bf16x8*)(alp + 32 * ((ks0) + q_)); \
                acc0 = __builtin_amdgcn_mfma_f32_32x32x16_bf16(ah_, bh_, acc0, 0, 0, 0); acc1 = __builtin_amdgcn_mfma_f32_32x32x16_bf16(ah_, bl_, acc1, 0, 0, 0); \
                acc2 = __builtin_amdgcn_mfma_f32_32x32x16_bf16(al_, bh_, acc2, 0, 0, 0); } } while (0)
            P5_LOAD(xa, 0);
            for (int it = 0; it < 8; ++it) {
                P5_LOAD(xb, 8 * it + 4);
                P5_COMP(xa, 8 * it);
                if (it < 7) P5_LOAD(xa, 8 * it + 8);
                P5_COMP(xb, 8 * it + 4);
            }
#undef P5_LOAD
#undef P5_COMP
            s1 += __shfl_xor(s1, 32); s2 += __shfl_xor(s2, 32);
            const float mean = s1 * (1.f / 1024.f), var = __builtin_fmaxf(s2 * (1.f / 1024.f) - mean * mean, 0.f), rstd = 1.0f / sqrtf(var + LN_EPS);
            float v[16];
#pragma unroll
            for (int i = 0; i < 16; ++i) v[i] = rstd * ((acc0[i] + acc1[i] + acc2[i]) - mean * gws[crow(i, hi5)]) + bws[crow(i, hi5)];
            float cv[8]; int ce[8];
#pragma unroll
            for (int kk = 0; kk < 4; ++kk) {
                float bv = v[0]; int bi = 0;
#pragma unroll
                for (int i = 1; i < 16; ++i) if (v[i] > bv) { bv = v[i]; bi = i; }
                cv[kk] = bv; ce[kk] = crow(bi, hi5);
#pragma unroll
                for (int i = 0; i < 16; ++i) v[i] = (i == bi) ? -INFINITY : v[i];
            }
#pragma unroll
            for (int kk = 0; kk < 4; ++kk) { cv[4 + kk] = __shfl_xor(cv[kk], 32); ce[4 + kk] = __shfl_xor(ce[kk], 32); }
            float tv[4]; int te[4];
#pragma unroll
            for (int kk = 0; kk < 4; ++kk) {
                float bv = cv[0]; int be = ce[0], bi = 0;
#pragma unroll
                for (int i = 1; i < 8; ++i) if (cv[i] > bv || (cv[i] == bv && ce[i] < be)) { bv = cv[i]; be = ce[i]; bi = i; }
                tv[kk] = bv; te[kk] = be;
#pragma unroll
                for (int i = 0; i < 8; ++i) cv[i] = (i == bi) ? -INFINITY : cv[i];
            }
            { const float e1 = __expf(tv[1] - tv[0]), e2 = __expf(tv[2] - tv[0]), e3 = __expf(tv[3] - tv[0]); const float inv = 1.0f / (1.0f + e1 + e2 + e3);
              if (hi5 == 0) { const size_t tk = (size_t)(tok0 + r32) * 4;
                  *(int4*)(TOPE + tk) = make_int4(te[0], te[1], te[2], te[3]); *(f32x4*)(TOPW + tk) = (f32x4){inv, e1 * inv, e2 * inv, e3 * inv};
                  atomicAdd((int*)(histL + te[0]), 1); atomicAdd((int*)(histL + te[1]), 1); atomicAdd((int*)(histL + te[2]), 1); atomicAdd((int*)(histL + te[3]), 1); } }
            f32x4 gg[4], bb[4];
#pragma unroll
            for (int j = 0; j < 4; ++j) { gg[j] = *(const f32x4*)(ln1g + 4 * lane + 256 * j); bb[j] = *(const f32x4*)(ln1b + 4 * lane + 256 * j); }
#pragma unroll 4
            for (int i = 0; i < 32; ++i) {
                const float mi = __uint_as_float(__builtin_amdgcn_readlane(__float_as_uint(mean), i)), ri = __uint_as_float(__builtin_amdgcn_readlane(__float_as_uint(rstd), i));
                const float* pp = OUTP + (size_t)(tok0 + i) * 1024 + 4 * lane; bf16_t* hp = H1 + (size_t)(tok0 + i) * 1024 + 4 * lane;
#pragma unroll
                for (int j = 0; j < 4; ++j) { const f32x4 xv = (*(const f32x4*)(pp + 256 * j) - mi) * ri * gg[j] + bb[j]; u32x2 w; w.x = pk2(xv[0], xv[1]); w.y = pk2(xv[2], xv[3]); *(u32x2*)(hp + 256 * j) = w; }
            }
            __syncthreads();
            if (tid < 32) HIST[vw * 32 + tid] = histL[tid];
            __syncthreads();
        }
    } }
    SEAM(5);

    if (IN(6)) { REP_LOOP(6) { REP_SYNC();
        LAS int* part = (LAS int*)(lds + SCR_OFF);
        LAS int* cntL = part + 512; LAS int* befL = cntL + 32; LAS int* tstL = befL + 32; LAS int* baseL = tstL + 40; LAS int* curL = baseL + 32;
        for (int vw = bx; vw < 256; vw += G) {
            const int hf = vw >> 7, wl = vw & 127;
            { const int e = tid & 31, p = tid >> 5; int s = 0;
              for (int i = 0; i < 8; ++i) s += HIST[(128 * hf + 8 * p + i) * 32 + e];
              part[p * 32 + e] = s; }
            __syncthreads();
            if (tid < 32) { int tot = 0, bef = 0; const int pw = wl >> 3, iw = wl & 7;
                for (int p = 0; p < 16; ++p) { const int v = part[p * 32 + tid]; tot += v; if (p < pw) bef += v; }
                for (int i = 0; i < iw; ++i) bef += HIST[(128 * hf + 8 * pw + i) * 32 + tid];
                cntL[tid] = tot; befL[tid] = bef; curL[tid] = 0; }
            __syncthreads();
            if (tid == 0) { int run = 0; for (int e = 0; e < 32; ++e) { tstL[e] = run; run += (cntL[e] + 255) >> 8; } tstL[32] = run; }
            __syncthreads();
            if (tid < 32) baseL[tid] = tstL[tid] * 256 + befL[tid];
            __syncthreads();
            int* rt = ROWTOK + (size_t)hf * HROWS; int* rd = ROWDST + (size_t)hf * HROWS;
            for (int idx = tid; idx < 1024; idx += 512) {
                const int tok = vw * 256 + (idx >> 2), kk = idx & 3, e = TOPE[(size_t)tok * 4 + kk];
                const int pos = baseL[e] + atomicAdd((int*)(curL + e), 1);
                rt[pos] = tok; rd[pos] = (tok - hf * HALF_T) * 4 + kk;
            }
            if (wl < 32) { const int e = wl, r0 = tstL[e] * 256 + cntL[e], r1 = tstL[e + 1] * 256;
                for (int r = r0 + tid; r < r1; r += 512) { rt[r] = hf * HALF_T; rd[r] = -1; } }
            if (wl == 32) { int* te = TILEE + hf * 1024; const int nt = tstL[32];
                for (int t = tid; t < nt; t += 512) { int e = 0; for (int q = 1; q < 32; ++q) if (t >= tstL[q]) e = q; te[t] = e; }
                if (tid == 0) te[1000] = nt; }
            __syncthreads();
        }
    }
    }
    SEAM(6);

#pragma unroll
    for (int hf = 0; hf < 2; ++hf) {
        const int p_gu = 7 + 2 * hf, p_dn = 8 + 2 * hf, p_cb = 9 + 2 * hf;
        const int* te = TILEE + hf * 1024; const int* rt = ROWTOK + (size_t)hf * HROWS; const int* rd = ROWDST + (size_t)hf * HROWS;
        if (IN(p_gu)) { REP_LOOP(p_gu) { REP_SYNC();
            const int NT = te[1000];
            pg8::MoeOrder S; S.init(te, NT, 8, G, bx);
            EpiSwiglu E{b_gu, Hh};
            pg8::gemm_phase(lds, H1, WGU, 1024, S, pg8::AGather{rt}, E, pg8::NoHook{});
        } }
        SEAM(p_gu);
        if (IN(p_dn)) { REP_LOOP(p_dn) { REP_SYNC();
            const int NT = te[1000];
            pg8::MoeOrder S; S.init(te, NT, 4, G, bx);
            EpiDown E{b_dn, rd, Y};
            pg8::gemm_phase(lds, Hh, WDN, 1024, S, pg8::ADense{}, E, pg8::NoHook{});
        } }
        SEAM(p_dn);
        if (IN(p_cb)) { REP_LOOP(p_cb + 3) { REP_SYNC();
            f32x4 g2[4], b2[4];
#pragma unroll
            for (int j = 0; j < 2; ++j) { g2[2 * j] = *(const f32x4*)(ln2g + 8 * lane + 512 * j); g2[2 * j + 1] = *(const f32x4*)(ln2g + 8 * lane + 512 * j + 4);
                b2[2 * j] = *(const f32x4*)(ln2b + 8 * lane + 512 * j); b2[2 * j + 1] = *(const f32x4*)(ln2b + 8 * lane + 512 * j + 4); }
            for (int tl = gw; tl < HALF_T; tl += NGW) {
                const int tok = hf * HALF_T + tl;
                const f32x4 wv = *(const f32x4*)(TOPW + (size_t)tok * 4);
                f32x4 v[4]; float s = 0.f;
#pragma unroll
                for (int j = 0; j < 2; ++j) {
                    const int c = 8 * lane + 512 * j;
                    const u32x4 hh = *(const u32x4*)(H1 + (size_t)tok * 1024 + c);
                    f32x4 a = (f32x4){bflo(hh.x), bfhi(hh.x), bflo(hh.y), bfhi(hh.y)} * ALPHA, b = (f32x4){bflo(hh.z), bfhi(hh.z), bflo(hh.w), bfhi(hh.w)} * ALPHA;
#pragma unroll
                    for (int kk = 0; kk < 4; ++kk) { const u32x4 yy = *(const u32x4*)(Y + ((size_t)tl * 4 + kk) * 1024 + c); const float w = wv[kk];
                        a += (f32x4){bflo(yy.x), bfhi(yy.x), bflo(yy.y), bfhi(yy.y)} * w; b += (f32x4){bflo(yy.z), bfhi(yy.z), bflo(yy.w), bfhi(yy.w)} * w; }
                    v[2 * j] = a; v[2 * j + 1] = b; s += (a[0] + a[1]) + (a[2] + a[3]) + (b[0] + b[1]) + (b[2] + b[3]);
                }
                const float mean = wave_sum(s) * (1.f / 1024.f); float s2 = 0.f;
#pragma unroll
                for (int j = 0; j < 4; ++j) { v[j] = v[j] - mean; s2 += (v[j][0] * v[j][0] + v[j][1] * v[j][1]) + (v[j][2] * v[j][2] + v[j][3] * v[j][3]); }
                const float rstd = 1.0f / sqrtf(wave_sum(s2) * (1.f / 1024.f) + LN_EPS);
                float* op = OUTP + (size_t)tok * 1024 + 8 * lane;
#pragma unroll
                for (int j = 0; j < 2; ++j) { *(f32x4*)(op + 512 * j) = v[2 * j] * rstd * g2[2 * j] + b2[2 * j]; *(f32x4*)(op + 512 * j + 4) = v[2 * j + 1] * rstd * g2[2 * j + 1] + b2[2 * j + 1]; }
            }
        } }
    }
#undef IN
#undef SEAM
}

extern "C" void kernel_launch(void* const* d_in, const int* in_sizes, int n_in, void* d_out, int out_size, void* d_ws, size_t ws_size, hipStream_t stream) {
    static int grid = 0;
    if (grid == 0) {
        if (n_in != 16 || in_sizes[0] != T * D || out_size != T * D || ws_size < WS_END) { fprintf(stderr, "kernel_launch: unexpected shapes / workspace (%d inputs, ws %zu)\n", n_in, ws_size); grid = -1; return; }
        int dev = 0, cus = 0, per_cu = 0;
        if (hipGetDevice(&dev) != hipSuccess || hipDeviceGetAttribute(&cus, hipDeviceAttributeMultiprocessorCount, dev) != hipSuccess) { grid = -1; return; }
        if (hipFuncSetAttribute((const void*)mk_fwd, hipFuncAttributeMaxDynamicSharedMemorySize, LDS_BYTES) != hipSuccess) { fprintf(stderr, "kernel_launch: hipFuncSetAttribute failed\n"); grid = -1; return; }
        if (hipOccupancyMaxActiveBlocksPerMultiprocessor(&per_cu, (const void*)mk_fwd, 512, LDS_BYTES) != hipSuccess || per_cu < 1) { fprintf(stderr, "kernel_launch: occupancy query says %d\n", per_cu); }
        (void)hipGetLastError();
        grid = cus;
    }
    if (grid < 0) return;
    if (hipMemsetAsync((char*)d_ws + WS_CTL, 0, CTL_ZERO_BYTES, stream) != hipSuccess) return;
    Args a{};
    for (int i = 0; i < 16; ++i) a.in[i] = (const float*)d_in[i];
    a.out = (float*)d_out; a.ws = (unsigned char*)d_ws;
#if MK_ONE_LAUNCH
    a.ph_lo = 0; a.ph_hi = NPHASE;
    hipLaunchKernelGGL(mk_fwd, dim3(grid), dim3(512), LDS_BYTES, stream, a);
#else
    for (int p = 0; p < NPHASE; ++p) { a.ph_lo = p; a.ph_hi = p + 1; hipLaunchKernelGGL(mk_fwd, dim3(grid), dim3(512), LDS_BYTES, stream, a); }
#endif
}
```

```cpp
#include <hip/hip_runtime.h>
#include <cstdio>
#include <cstdint>

#ifndef MK_ONE_LAUNCH
#define MK_ONE_LAUNCH 1
#endif

#define LAS __attribute__((address_space(3)))
#define GAS __attribute__((address_space(1)))
typedef unsigned short bf16_t;
typedef short bf16x8 __attribute__((ext_vector_type(8)));
typedef short s16x4 __attribute__((ext_vector_type(4)));
typedef float f32x4 __attribute__((ext_vector_type(4)));
typedef float f32x2 __attribute__((ext_vector_type(2)));
typedef float f32x16 __attribute__((ext_vector_type(16)));
typedef unsigned u32x4 __attribute__((ext_vector_type(4)));
typedef unsigned u32x2 __attribute__((ext_vector_type(2)));
typedef __bf16 bf16x2_t __attribute__((ext_vector_type(2)));

constexpr int SEQ = 2048, NB = 32, T = NB * SEQ, D = 1024, INW = 5888, NE = 32, TOPK = 4;
constexpr float LN_EPS = 1e-5f;
constexpr float ALPHA = 1.189207115002721f;
constexpr float LOG2E = 1.4426950408889634f;
constexpr float QSCALE = 0.125f * LOG2E;
constexpr int HALF_T = T / 2;
constexpr int HROWS = HALF_T * TOPK + NE * 256;
constexpr int HTILES = HROWS / 256;

constexpr size_t MiB = 1u << 20;
constexpr size_t WS_CTL = 0, CTL_ZERO_BYTES = 1 * MiB;
constexpr size_t WS_COS = 1 * MiB, WS_SIN = WS_COS + 256 * 1024;
constexpr size_t WS_WIN = 2 * MiB;
constexpr size_t WS_WAB = 14 * MiB;
constexpr size_t WS_WOUT = 17 * MiB;
constexpr size_t WS_TOPE = 19 * MiB, WS_TOPW = 20 * MiB, WS_HIST = 21 * MiB;
constexpr size_t WS_ROWTOK = 22 * MiB, WS_ROWDST = 24 * MiB, WS_TILEE = 26 * MiB;
constexpr size_t WS_WGU = 32 * MiB;
constexpr size_t WS_WDN = 160 * MiB;
constexpr size_t WS_OAB = 224 * MiB;
constexpr size_t WS_XB = 224 * MiB;
constexpr size_t WS_H1 = 224 * MiB;
constexpr size_t WS_G = 384 * MiB;
constexpr size_t WS_KB = 640 * MiB;
constexpr size_t WS_VAT = 736 * MiB;
constexpr size_t WS_VBT = 768 * MiB;
constexpr size_t WS_OG = 864 * MiB;
constexpr size_t WS_LSE = 960 * MiB;
constexpr size_t WS_MERGED = 640 * MiB;
constexpr size_t WS_H = 352 * MiB;
constexpr size_t WS_Y = 624 * MiB;
constexpr size_t WS_END = 1024 * MiB;
static_assert(WS_H + (size_t)HROWS * 1024 * 2 <= WS_Y && WS_Y + (size_t)HALF_T * 4 * 1024 * 2 <= WS_END, "ws map");
static_assert(WS_LSE + (size_t)T * 12 * 4 <= WS_END && WS_OG + (size_t)T * 768 * 2 <= WS_LSE && WS_VBT + (size_t)T * 768 * 2 <= WS_OG, "ws map");
constexpr size_t DO_QA = 0, DO_QB = 128 * MiB, DO_KA = 224 * MiB;

constexpr int CW_TMO = 0, CW_CODE = 1, CW_BAR = 4096;

constexpr int RING_BYTES = 131072;
constexpr int LDSCTL_OFF = 135168, MISC_OFF = LDSCTL_OFF + 320, SCR_OFF = LDSCTL_OFF + 1024;
constexpr int LDS_BYTES = 151552;

#define RLX_AGENT __ATOMIC_RELAXED, __HIP_MEMORY_SCOPE_AGENT
#define LDS_WAIT() asm volatile("s_waitcnt lgkmcnt(0)" ::: "memory")
#define VM_WAIT() asm volatile("s_waitcnt vmcnt(0)" ::: "memory")
__device__ __forceinline__ unsigned pk2(float lo, float hi) { f32x2 v = {lo, hi}; bf16x2_t b = __builtin_convertvector(v, bf16x2_t); return __builtin_bit_cast(unsigned, b); }
__device__ __forceinline__ float bflo(unsigned w) { return __uint_as_float(w << 16); }
__device__ __forceinline__ float bfhi(unsigned w) { return __uint_as_float(w & 0xffff0000u); }
__device__ __forceinline__ float fast_sigmoid(float z) { return __builtin_amdgcn_rcpf(1.0f + __builtin_amdgcn_exp2f(-z * LOG2E)); }
__device__ __forceinline__ float wave_sum(float v) {
#pragma unroll
    for (int o = 1; o < 64; o <<= 1) v += __shfl_xor(v, o);
    return v;
}

#define XB_TMO      128
#define XB_XCNT(j)  (256  + 64 * (j))
#define XB_XSUB(j)  (1280 + 64 * (j))
#define XB_XGEN(j)  (2304 + 64 * (j))
#define XB_TOP      3328
#define XB_TOPGEN   3392
#define XCD_BAR_WORDS 3456
#define XB_SPIN_CAP (1u << 18)
__device__ __forceinline__ unsigned xb_ld(unsigned* p)              { return __hip_atomic_load(p, __ATOMIC_RELAXED, __HIP_MEMORY_SCOPE_AGENT); }
__device__ __forceinline__ unsigned xb_add(unsigned* p, unsigned v) { return __hip_atomic_fetch_add(p, v, __ATOMIC_RELAXED, __HIP_MEMORY_SCOPE_AGENT); }
__device__ __forceinline__ unsigned xb_xcc_id() { return (unsigned)__builtin_amdgcn_s_getreg((3 << 11) | 20) & 0xFu; }
#define XB_SPIN(cond, bar) do { unsigned _sp = 0; while (cond) { __builtin_amdgcn_s_sleep(1); \
    if ((++_sp & 255u) == 0u) { if (xb_ld(&(bar)[XB_TMO])) break; if (_sp > XB_SPIN_CAP) { atomicAdd(&(bar)[XB_TMO], 1u); break; } } } } while (0)
struct XcdBarrier { unsigned* bar; unsigned x; volatile LAS unsigned* st; };
__device__ __forceinline__ XcdBarrier xcd_barrier_post(unsigned* bar, volatile LAS unsigned* st) {
    XcdBarrier b; b.bar = bar; b.x = xb_xcc_id(); b.st = st;
    if (threadIdx.x == 0) (void)xb_add(&bar[XB_XCNT(b.x)], 1u);
    return b;
}
__device__ __forceinline__ void xcd_barrier_complete(unsigned* bar, unsigned x, unsigned& nloc, unsigned& nx) {
    const unsigned G = gridDim.x * gridDim.y * gridDim.z;
    unsigned sum, cnt, mine, sp = 0u;
    for (;;) {
        sum = 0u; cnt = 0u; mine = 0u;
#pragma unroll
        for (unsigned j = 0; j < 16; ++j) { const unsigned c = xb_ld(&bar[XB_XCNT(j)]); sum += c; cnt += (c > 0u) ? 1u : 0u; mine = (j == x) ? c : mine; }
        if (sum == G) break;
        __builtin_amdgcn_s_sleep(1);
        if ((++sp & 255u) == 0u) { if (xb_ld(&bar[XB_TMO])) break; if (sp > XB_SPIN_CAP) { atomicAdd(&bar[XB_TMO], 1u); break; } }
    }
    nloc = mine > 0u ? mine : 1u; nx = cnt > 0u ? cnt : 1u;
}
__device__ __forceinline__ void xcd_barrier(const XcdBarrier& b) {
    asm volatile("s_waitcnt vmcnt(0)" ::: "memory");
    __syncthreads();
    if (threadIdx.x == 0) {
        unsigned* bar = b.bar;
        __builtin_amdgcn_s_waitcnt(0);
        unsigned nloc = b.st[0], nx = b.st[1];
        if (nloc == 0u) { xcd_barrier_complete(bar, b.x, nloc, nx); b.st[0] = nloc; b.st[1] = nx; }
        const unsigned old = xb_add(&bar[XB_XSUB(b.x)], 1u);
        const unsigned gen = old / nloc;
        if (old + 1u == (gen + 1u) * nloc) {
            __builtin_amdgcn_fence(__ATOMIC_RELEASE, "agent");
            asm volatile("s_waitcnt vmcnt(0)" ::: "memory");
            const unsigned og = xb_add(&bar[XB_TOP], 1u);
            const unsigned tg = og / nx;
            if (og + 1u == (tg + 1u) * nx) xb_add(&bar[XB_TOPGEN], 1u);
            else XB_SPIN(xb_ld(&bar[XB_TOPGEN]) == tg, bar);
            __builtin_amdgcn_fence(__ATOMIC_ACQUIRE, "agent");
            xb_add(&bar[XB_XGEN(b.x)], 1u);
            asm volatile("s_waitcnt vmcnt(0)" ::: "memory");
        } else {
            XB_SPIN(xb_ld(&bar[XB_XGEN(b.x)]) == gen, bar);
            __builtin_amdgcn_fence(__ATOMIC_ACQUIRE, "agent");
            asm volatile("s_waitcnt vmcnt(0)" ::: "memory");
        }
    }
    __syncthreads();
}

namespace pg8 {
constexpr int BM = 256, BK = 64, HALF = 128, HTB = HALF * BK * 2, STAGE_BYTES = 8 * HTB, NXCD = 8, WGM = 8;
__host__ __device__ __forceinline__ int lds_byte(int r, int c) { const int st = (r >> 4) * 2 + (c >> 5), rr = r & 15, cc = c & 31, ob = rr * 64 + cc * 2; return st * 1024 + (ob ^ (((ob >> 9) & 1) << 5)); }
__host__ __device__ __forceinline__ void stage_rc(int b, int& R, int& C) { const int st = b / 1024, sb = b % 1024, swz = sb ^ (((sb >> 9) & 1) << 5); R = (st >> 1) * 16 + swz / 64; C = (st & 1) * 32 + (swz % 64) / 2; }
__host__ __device__ __forceinline__ int perm32(int rho) { const int n = rho >> 4, i = rho & 15; return 8 * (i >> 2) + 4 * n + (i & 3); }

struct Unit { int pm, pn; };

struct StaticOrder {
    int nM, nN, nwg, G, c;
    __device__ void init(int M, int N, int G_, int c_) { nM = M / BM; nN = N / BM; nwg = nM * nN; G = G_; c = c_; }
    __device__ bool next(int i, Unit& u) const {
        const long L = (long)i * G + c; if (L >= nwg) return false;
        int wgid = (int)L; { const int q = nwg / NXCD, r = nwg % NXCD, xcd = wgid % NXCD, off = wgid / NXCD; wgid = (xcd < r ? xcd * (q + 1) : r * (q + 1) + (xcd - r) * q) + off; }
        const int nig = WGM * nN, gid = wgid / nig, fm = gid * WGM, gsz = (nM - fm) < WGM ? (nM - fm) : WGM;
        u.pm = fm + ((wgid % nig) % gsz); u.pn = (wgid % nig) / gsz; return true;
    }
};
struct MoeOrder {
    const LAS int* tile_e; int NJ, W, r, t0, t1;
    __device__ void init(const LAS int* te, int NT, int NJ_, int G, int c) {
        tile_e = te; NJ = NJ_;
        if (G % 8 == 0) { const int x = c % 8; r = c / 8; W = G / 8; t0 = (int)((long)NT * x / 8); t1 = (int)((long)NT * (x + 1) / 8); }
        else { r = c; W = G; t0 = 0; t1 = NT; }
    }
    __device__ bool next(int i, Unit& u) const {
        const int idx = i * W + r, ntl = t1 - t0; if (idx >= ntl * NJ) return false;
        const int GT = 32 / NJ, per = GT * NJ, grp = idx / per, rem = idx - grp * per, gsz = (ntl - grp * GT) < GT ? (ntl - grp * GT) : GT;
        const int tile = t0 + grp * GT + rem % gsz, j = rem / gsz;
        u.pm = tile; u.pn = tile_e[tile] * NJ + j; return true;
    }
};
constexpr int TOKL_OFF = 135168 + 1024 + 4096;
struct ADense {
    __device__ __forceinline__ void prefetch(const Unit&, LAS unsigned char*, int, int, int) const {}
    __device__ __forceinline__ void rows(const Unit& u, LAS unsigned char*, int, const int (&R)[2], unsigned (&vr)[2][2]) const {
#pragma unroll
        for (int h = 0; h < 2; ++h)
#pragma unroll
            for (int i = 0; i < 2; ++i) vr[h][i] = (unsigned)(u.pm * BM + h * HALF + R[i]);
    }
};
struct AGather {
    const int* tok;
    __device__ __forceinline__ void prefetch(const Unit& u, LAS unsigned char* ldsb, int par, int wid, int lane) const {
        if (wid < 4) __builtin_amdgcn_global_load_lds((const unsigned*)(tok + u.pm * BM + wid * 64 + lane), (LAS unsigned*)(ldsb + TOKL_OFF + par * 1024 + wid * 256), 4, 0, 0);
    }
    __device__ __forceinline__ void rows(const Unit&, LAS unsigned char* ldsb, int par, const int (&R)[2], unsigned (&vr)[2][2]) const {
        const LAS unsigned* t = (const LAS unsigned*)(ldsb + TOKL_OFF + par * 1024);
#pragma unroll
        for (int h = 0; h < 2; ++h)
#pragma unroll
            for (int i = 0; i < 2; ++i) vr[h][i] = t[h * HALF + R[i]];
    }
};
struct NoHook { static constexpr int T = -1; __device__ __forceinline__ void operator()(f32x4 (&)[2][2][4][2], const Unit&, int, int, int, int) const {} };

template <class Epi, class Sched, class AMap, class Hook>
__device__ __forceinline__ void gemm_phase(LAS unsigned char* lds, const bf16_t* A, const bf16_t* Bt, const int K, const Sched& S, const AMap& AM, const Epi& E, const Hook& HK) {
    const int tid = threadIdx.x, wid = __builtin_amdgcn_readfirstlane(tid >> 6), lane = tid & 63, wr = wid >> 2, wc = wid & 3, fr = lane & 15, fq = lane >> 4;
    const int nt = K / BK;
    int Rr[2], Cc[2]; unsigned voffB[2];
#pragma unroll
    for (int i = 0; i < 2; ++i) { stage_rc(tid * 16 + i * 8192, Rr[i], Cc[i]); const int Rb = Epi::PERM ? ((Rr[i] & ~31) + perm32(Rr[i] & 31)) : Rr[i]; voffB[i] = (unsigned)(Rb * K + Cc[i]) * 2u; }
    const size_t kstep = (size_t)(BK * 2);
    const size_t hstep = (size_t)HALF * K * 2;
    const size_t tstep = 2 * hstep;
    const unsigned ldsw = (unsigned)wid * 1024u;
    const int aoff = lds_byte(wr * 64 + fr, fq * 8), boff = lds_byte(wc * 32 + fr, fq * 8);
#define PG8_SA(b, h) (((b) * 2 + (h)) * HTB)
#define PG8_SB(b, h) ((4 + (b) * 2 + (h)) * HTB)
#define PG8_STAGE(bufoff, gbase, voff) do { _Pragma("unroll") for (int _i = 0; _i < 2; ++_i) \
        __builtin_amdgcn_global_load_lds((const unsigned*)((const char*)(gbase) + (voff)[_i]), (LAS unsigned*)(lds + (bufoff) + ldsw + _i * 8192), 16, 0, 0); } while (0)
#define PG8_LDA(dst, b, h) do { _Pragma("unroll") for (int m = 0; m < 4; ++m) _Pragma("unroll") for (int k = 0; k < 2; ++k) dst[m][k] = *(const LAS bf16x8*)(lds + PG8_SA(b, h) + aoff + m * 2048 + k * 1024); } while (0)
#define PG8_LDB(dst, b, h) do { _Pragma("unroll") for (int n = 0; n < 2; ++n) _Pragma("unroll") for (int k = 0; k < 2; ++k) dst[n][k] = *(const LAS bf16x8*)(lds + PG8_SB(b, h) + boff + n * 2048 + k * 1024); } while (0)
#define PG8_MMA(ai, bj, At, Bt_) do { __builtin_amdgcn_s_setprio(1); _Pragma("unroll") for (int m = 0; m < 4; ++m) _Pragma("unroll") for (int n = 0; n < 2; ++n) _Pragma("unroll") for (int k = 0; k < 2; ++k) \
        acc[ai][bj][m][n] = __builtin_amdgcn_mfma_f32_16x16x32_bf16(Bt_[n][k], At[m][k], acc[ai][bj][m][n], 0, 0, 0); __builtin_amdgcn_s_setprio(0); } while (0)
#define PG8_WAIT_V(n) asm volatile("s_waitcnt vmcnt(" #n ")" ::: "memory")
#define PG8_WAIT_L(n) asm volatile("s_waitcnt lgkmcnt(" #n ")" ::: "memory")
#define PG8_BAR __builtin_amdgcn_s_barrier()
#define PG8_SCHED __builtin_amdgcn_sched_barrier(0)
    Unit cur, nxt, nn; int ui = 0;
    if (!S.next(0, cur)) return;
    bool has_next = S.next(1, nxt);
    f32x4 acc[2][2][4][2];
#pragma unroll
    for (int a = 0; a < 2; ++a)
#pragma unroll
        for (int b = 0; b < 2; ++b)
#pragma unroll
            for (int m = 0; m < 4; ++m)
#pragma unroll
                for (int n = 0; n < 2; ++n) acc[a][b][m][n] = (f32x4){0.f, 0.f, 0.f, 0.f};
    bf16x8 At[4][2], B0[2][2], B1[2][2];
    unsigned vC[2][2];
    AM.prefetch(cur, lds, 0, wid, lane);
    if (has_next) AM.prefetch(nxt, lds, 1, wid, lane);
    asm volatile("s_waitcnt vmcnt(0)" ::: "memory"); __builtin_amdgcn_s_barrier(); asm volatile("" ::: "memory");
    AM.rows(cur, lds, 0, Rr, vC);
#pragma unroll
    for (int h = 0; h < 2; ++h)
#pragma unroll
        for (int i = 0; i < 2; ++i) vC[h][i] = (vC[h][i] * (unsigned)K + (unsigned)Cc[i]) * 2u;
    const char* const Ab = (const char*)A;
    const char* cB = (const char*)Bt + (size_t)cur.pn * tstep;
    PG8_STAGE(PG8_SB(0, 0), cB, voffB); PG8_STAGE(PG8_SB(0, 1), cB + hstep, voffB); PG8_STAGE(PG8_SA(0, 0), Ab, vC[0]); PG8_STAGE(PG8_SA(0, 1), Ab, vC[1]);
    if (wr == 1) PG8_BAR;
    PG8_WAIT_V(2); PG8_BAR;
    PG8_STAGE(PG8_SB(1, 0), cB + kstep, voffB); PG8_STAGE(PG8_SA(1, 0), Ab + kstep, vC[0]); PG8_STAGE(PG8_SB(1, 1), cB + hstep + kstep, voffB);
    PG8_WAIT_V(6); PG8_BAR;
    for (;;) {
        const bool has_nn = has_next ? S.next(ui + 2, nn) : false;
        if (has_nn) AM.prefetch(nn, lds, ui & 1, wid, lane);
        const char* nB = has_next ? (const char*)Bt + (size_t)nxt.pn * tstep : cB;
        for (int t = 0; t < nt; t += 2) {
            const bool last = (t == nt - 2);
            if (Hook::T >= 0) { if (t == Hook::T) HK(acc, cur, wr, wc, fr, fq); }
            const char* a1 = Ab + (size_t)(t + 1) * kstep;
            const char* a2 = last ? Ab : Ab + (size_t)(t + 2) * kstep; const char* b2 = last ? nB : cB + (size_t)(t + 2) * kstep;
            const char* a3 = a2 + kstep; const char* b3 = b2 + kstep;
            PG8_LDB(B0, 0, 0); PG8_LDB(B1, 0, 1); PG8_SCHED; PG8_LDA(At, 0, 0); PG8_STAGE(PG8_SA(1, 1), a1, vC[1]);
            if (last && has_next) {
                AM.rows(nxt, lds, (ui + 1) & 1, Rr, vC);
#pragma unroll
                for (int h = 0; h < 2; ++h)
#pragma unroll
                    for (int i = 0; i < 2; ++i) vC[h][i] = (vC[h][i] * (unsigned)K + (unsigned)Cc[i]) * 2u;
            }
            PG8_WAIT_V(8); PG8_WAIT_L(0); PG8_BAR; PG8_MMA(0, 0, At, B0); PG8_MMA(0, 1, At, B1); PG8_BAR; PG8_SCHED;
            PG8_LDA(At, 0, 1); PG8_STAGE(PG8_SB(0, 0), b2, voffB); PG8_STAGE(PG8_SB(0, 1), b2 + hstep, voffB); PG8_STAGE(PG8_SA(0, 0), a2, vC[0]);
            PG8_WAIT_V(8); PG8_WAIT_L(0); PG8_BAR; PG8_MMA(1, 0, At, B0); PG8_MMA(1, 1, At, B1); PG8_BAR; PG8_SCHED;
            PG8_LDB(B0, 1, 0); PG8_LDB(B1, 1, 1); PG8_SCHED; PG8_LDA(At, 1, 0); PG8_STAGE(PG8_SA(0, 1), a2, vC[1]);
            PG8_WAIT_V(8); PG8_WAIT_L(0); PG8_BAR; PG8_MMA(0, 0, At, B0); PG8_MMA(0, 1, At, B1); PG8_BAR; PG8_SCHED;
            PG8_LDA(At, 1, 1); PG8_STAGE(PG8_SB(1, 0), b3, voffB); PG8_STAGE(PG8_SB(1, 1), b3 + hstep, voffB); PG8_STAGE(PG8_SA(1, 0), a3, vC[0]);
            PG8_WAIT_V(8); PG8_WAIT_L(0); PG8_BAR; PG8_MMA(1, 0, At, B0); PG8_MMA(1, 1, At, B1); PG8_BAR; PG8_SCHED;
        }
        if (wr == 0) PG8_BAR;
        E(acc, cur, wr, wc, fr, fq);
        if (!has_next) break;
#pragma unroll
        for (int a = 0; a < 2; ++a)
#pragma unroll
            for (int b = 0; b < 2; ++b)
#pragma unroll
                for (int m = 0; m < 4; ++m)
#pragma unroll
                    for (int n = 0; n < 2; ++n) acc[a][b][m][n] = (f32x4){0.f, 0.f, 0.f, 0.f};
        cur = nxt; nxt = nn; has_next = has_nn; cB = nB; ++ui;
        if (wr == 1) PG8_BAR;
    }
    PG8_WAIT_V(0);
    PG8_BAR;
#undef PG8_SA
#undef PG8_SB
#undef PG8_STAGE
#undef PG8_LDA
#undef PG8_LDB
#undef PG8_MMA
#undef PG8_WAIT_V
#undef PG8_WAIT_L
#undef PG8_BAR
#undef PG8_SCHED
}
}
using pg8::Unit;

struct EpiInProj {
    static constexpr bool PERM = true;
    bf16_t *QA, *KA, *VAT, *QB, *KB, *VBT, *G; const float* cosT; const float* sinT;
    __device__ __forceinline__ void operator()(const f32x4 (&acc)[2][2][4][2], const Unit& u, int wr, int wc, int fr, int fq) const {
        const int pn = u.pn, row0 = u.pm * 256 + wr * 64 + fr;
        if (pn < 5 || (pn >= 6 && pn < 12)) {
            bf16_t* base; int ld, colt; float sc;
            if (pn < 4) { base = QA; ld = 1024; colt = pn * 256; sc = QSCALE; }
            else if (pn == 4) { base = KA; ld = 256; colt = 0; sc = 1.f; }
            else if (pn < 9) { base = QB; ld = 768; colt = (pn - 6) * 256; sc = QSCALE; }
            else { base = KB; ld = 768; colt = (pn - 9) * 256; sc = 1.f; }
            const int col = colt + 64 * wc + 8 * fq;
#pragma unroll
            for (int ai = 0; ai < 2; ++ai)
#pragma unroll
                for (int m = 0; m < 4; ++m) {
                    const int row = row0 + ai * 128 + m * 16, pos = row & (SEQ - 1);
                    const f32x4 c0 = *(const f32x4*)(cosT + pos * 32 + 8 * fq), c1 = *(const f32x4*)(cosT + pos * 32 + 8 * fq + 4);
                    const f32x4 s0 = *(const f32x4*)(sinT + pos * 32 + 8 * fq), s1 = *(const f32x4*)(sinT + pos * 32 + 8 * fq + 4);
                    const f32x4 x10 = acc[ai][0][m][0], x11 = acc[ai][0][m][1], x20 = acc[ai][1][m][0], x21 = acc[ai][1][m][1];
                    const f32x4 o10 = (x10 * c0 - x20 * s0) * sc, o11 = (x11 * c1 - x21 * s1) * sc;
                    const f32x4 o20 = (x20 * c0 + x10 * s0) * sc, o21 = (x21 * c1 + x11 * s1) * sc;
                    u32x4 w1, w2;
                    w1.x = pk2(o10[0], o10[1]); w1.y = pk2(o10[2], o10[3]); w1.z = pk2(o11[0], o11[1]); w1.w = pk2(o11[2], o11[3]);
                    w2.x = pk2(o20[0], o20[1]); w2.y = pk2(o20[2], o20[3]); w2.z = pk2(o21[0], o21[1]); w2.w = pk2(o21[2], o21[3]);
                    bf16_t* rp = base + (size_t)row * ld + col;
                    *(u32x4*)rp = w1; *(u32x4*)(rp + 32) = w2;
                }
        } else if (pn == 5 || (pn >= 12 && pn < 15)) {
            bf16_t* base; int H, hoff, sh;
            if (pn == 5) { base = VAT; H = 4; hoff = 0; sh = 0; } else { base = VBT; H = 12; hoff = 4 * (pn - 12); sh = 2 * (pn - 12); }
            const int dmask = (1 << sh) - 1;
#pragma unroll
            for (int ai = 0; ai < 2; ++ai)
#pragma unroll
                for (int m = 0; m < 4; ++m) {
                    const int row = row0 + ai * 128 + m * 16, b = row >> 11, pos = row & (SEQ - 1);
                    const int idx = ((pos & dmask) << (11 - sh)) | (pos >> sh);
#pragma unroll
                    for (int bj = 0; bj < 2; ++bj) {
                        const int head = hoff + 2 * bj + (wc >> 1), d0 = 32 * (wc & 1) + 8 * fq;
                        bf16_t* p = base + ((size_t)((b * H + head) * 64 + d0) << 11) + idx;
#pragma unroll
                        for (int n = 0; n < 2; ++n) { const f32x4 v = acc[ai][bj][m][n];
                            const unsigned w0 = pk2(v[0], v[1]), w1 = pk2(v[2], v[3]);
                            p[(size_t)(4 * n + 0) << 11] = (bf16_t)(w0 & 0xffffu); p[(size_t)(4 * n + 1) << 11] = (bf16_t)(w0 >> 16);
                            p[(size_t)(4 * n + 2) << 11] = (bf16_t)(w1 & 0xffffu); p[(size_t)(4 * n + 3) << 11] = (bf16_t)(w1 >> 16); }
                    }
                }
        } else {
            const int col = (pn - 15) * 256 + wc * 32 + 8 * fq;
#pragma unroll
            for (int ai = 0; ai < 2; ++ai)
#pragma unroll
                for (int m = 0; m < 4; ++m) {
                    bf16_t* rp = G + (size_t)(row0 + ai * 128 + m * 16) * 2048 + col;
#pragma unroll
                    for (int bj = 0; bj < 2; ++bj) { const f32x4 v0 = acc[ai][bj][m][0], v1 = acc[ai][bj][m][1]; u32x4 w;
                        w.x = pk2(fast_sigmoid(v0[0]), fast_sigmoid(v0[1])); w.y = pk2(fast_sigmoid(v0[2]), fast_sigmoid(v0[3]));
                        w.z = pk2(fast_sigmoid(v1[0]), fast_sigmoid(v1[1])); w.w = pk2(fast_sigmoid(v1[2]), fast_sigmoid(v1[3]));
                        *(u32x4*)(rp + bj * 128) = w; }
                }
        }
    }
};
struct HookGateRatio {
    static constexpr int T = 16;
    const bf16_t* G;
    __device__ __forceinline__ void operator()(f32x4 (&acc)[2][2][4][2], const Unit& u, int wr, int wc, int fr, int fq) const {
        unsigned loff = (unsigned)((wr * 64 + fr) * 2048 + wc * 32 + 8 * fq) * 2u;
        asm volatile("" : "+v"(loff));
        const char* gbase = (const char*)G + ((size_t)u.pm * 256 * 2048 + (size_t)u.pn * 256) * 2;
#pragma unroll
        for (int ai = 0; ai < 2; ++ai)
#pragma unroll
            for (int m = 0; m < 4; ++m) {
                const bf16_t* rp = (const bf16_t*)(gbase + (size_t)(ai * 128 + m * 16) * 4096 + loff);
#pragma unroll
                for (int bj = 0; bj < 2; ++bj) {
                    const u32x4 ga = *(const u32x4*)(rp + bj * 128), gb = *(const u32x4*)(rp + 1024 + bj * 128);
                    f32x4 r0, r1;
                    r0[0] = bflo(ga.x) * __builtin_amdgcn_rcpf(bflo(gb.x)); r0[1] = bfhi(ga.x) * __builtin_amdgcn_rcpf(bfhi(gb.x));
                    r0[2] = bflo(ga.y) * __builtin_amdgcn_rcpf(bflo(gb.y)); r0[3] = bfhi(ga.y) * __builtin_amdgcn_rcpf(bfhi(gb.y));
                    r1[0] = bflo(ga.z) * __builtin_amdgcn_rcpf(bflo(gb.z)); r1[1] = bfhi(ga.z) * __builtin_amdgcn_rcpf(bfhi(gb.z));
                    r1[2] = bflo(ga.w) * __builtin_amdgcn_rcpf(bflo(gb.w)); r1[3] = bfhi(ga.w) * __builtin_amdgcn_rcpf(bfhi(gb.w));
                    acc[ai][bj][m][0] *= r0; acc[ai][bj][m][1] *= r1;
                }
                asm volatile("" ::: "memory");
            }
    }
};
struct EpiMerged {
    static constexpr bool PERM = true;
    const bf16_t* G; bf16_t* O;
    __device__ __forceinline__ void operator()(const f32x4 (&acc)[2][2][4][2], const Unit& u, int wr, int wc, int fr, int fq) const {
        const int row0 = u.pm * 256 + wr * 64 + fr, col = u.pn * 256 + wc * 32 + 8 * fq;
#pragma unroll
        for (int ai = 0; ai < 2; ++ai)
#pragma unroll
            for (int m = 0; m < 4; ++m) {
                const size_t r = (size_t)(row0 + ai * 128 + m * 16);
#pragma unroll
                for (int bj = 0; bj < 2; ++bj) {
                    const u32x4 gb = *(const u32x4*)(G + r * 2048 + 1024 + col + bj * 128);
                    const f32x4 v0 = acc[ai][bj][m][0], v1 = acc[ai][bj][m][1]; u32x4 w;
                    w.x = pk2(v0[0] * bflo(gb.x), v0[1] * bfhi(gb.x)); w.y = pk2(v0[2] * bflo(gb.y), v0[3] * bfhi(gb.y));
                    w.z = pk2(v1[0] * bflo(gb.z), v1[1] * bfhi(gb.z)); w.w = pk2(v1[2] * bflo(gb.w), v1[3] * bfhi(gb.w));
                    *(u32x4*)(O + r * 1024 + col + bj * 128) = w;
                }
                if (m & 1) asm volatile("" ::: "memory");
            }
    }
};
struct EpiPre {
    static constexpr bool PERM = false;
    const float* X; float* O;
    __device__ __forceinline__ void operator()(const f32x4 (&acc)[2][2][4][2], const Unit& u, int wr, int wc, int fr, int fq) const {
        const int row0 = u.pm * 256 + wr * 64 + fr, col = u.pn * 256 + wc * 32 + 4 * fq;
#pragma unroll
        for (int ai = 0; ai < 2; ++ai)
#pragma unroll
            for (int m = 0; m < 4; ++m) {
                const size_t off = (size_t)(row0 + ai * 128 + m * 16) * 1024 + col;
#pragma unroll
                for (int bj = 0; bj < 2; ++bj)
#pragma unroll
                    for (int n = 0; n < 2; ++n) { const f32x4 xv = *(const f32x4*)(X + off + bj * 128 + n * 16); *(f32x4*)(O + off + bj * 128 + n * 16) = xv * ALPHA + acc[ai][bj][m][n]; }
            }
    }
};
struct EpiSwiglu {
    static constexpr bool PERM = true;
    const float* bgu; bf16_t* Hh;
    __device__ __forceinline__ void operator()(const f32x4 (&acc)[2][2][4][2], const Unit& u, int wr, int wc, int fr, int fq) const {
        const int e = u.pn >> 3, j = u.pn & 7, row0 = u.pm * 256 + wr * 64 + fr, col = j * 128 + wc * 32 + 8 * fq;
        const float* bp = bgu + (size_t)e * 2048 + col;
        const f32x4 bg0 = *(const f32x4*)bp, bg1 = *(const f32x4*)(bp + 4), bu0 = *(const f32x4*)(bp + 1024), bu1 = *(const f32x4*)(bp + 1028);
#pragma unroll
        for (int ai = 0; ai < 2; ++ai)
#pragma unroll
            for (int m = 0; m < 4; ++m) {
                f32x4 g0 = acc[ai][0][m][0] + bg0, g1 = acc[ai][0][m][1] + bg1, u0 = acc[ai][1][m][0] + bu0, u1 = acc[ai][1][m][1] + bu1;
                float o[8];
#pragma unroll
                for (int q = 0; q < 4; ++q) {
                    float g = __builtin_fminf(g0[q], 7.f), up = __builtin_fminf(__builtin_fmaxf(u0[q], -7.f), 7.f); o[q] = (up + 1.f) * g * fast_sigmoid(1.702f * g);
                    g = __builtin_fminf(g1[q], 7.f); up = __builtin_fminf(__builtin_fmaxf(u1[q], -7.f), 7.f); o[4 + q] = (up + 1.f) * g * fast_sigmoid(1.702f * g);
                }
                u32x4 w; w.x = pk2(o[0], o[1]); w.y = pk2(o[2], o[3]); w.z = pk2(o[4], o[5]); w.w = pk2(o[6], o[7]);
                *(u32x4*)(Hh + (size_t)(row0 + ai * 128 + m * 16) * 1024 + col) = w;
            }
    }
};
struct EpiDown {
    static constexpr bool PERM = true;
    const float* bd; const int* dst; bf16_t* Y;
    __device__ __forceinline__ void operator()(const f32x4 (&acc)[2][2][4][2], const Unit& u, int wr, int wc, int fr, int fq) const {
        const int e = u.pn >> 2, j = u.pn & 3, row0 = u.pm * 256 + wr * 64 + fr, col = j * 256 + wc * 32 + 8 * fq;
        const float* bp = bd + (size_t)e * 1024 + col;
        f32x4 bv[2][2];
#pragma unroll
        for (int bj = 0; bj < 2; ++bj) { bv[bj][0] = *(const f32x4*)(bp + bj * 128); bv[bj][1] = *(const f32x4*)(bp + bj * 128 + 4); }
#pragma unroll
        for (int ai = 0; ai < 2; ++ai)
#pragma unroll
            for (int m = 0; m < 4; ++m) {
                const int d = dst[row0 + ai * 128 + m * 16];
                if (d >= 0) {
                    bf16_t* rp = Y + (size_t)d * 1024 + col;
#pragma unroll
                    for (int bj = 0; bj < 2; ++bj) { const f32x4 v0 = acc[ai][bj][m][0] + bv[bj][0], v1 = acc[ai][bj][m][1] + bv[bj][1]; u32x4 w;
                        w.x = pk2(v0[0], v0[1]); w.y = pk2(v0[2], v0[3]); w.z = pk2(v1[0], v1[1]); w.w = pk2(v1[2], v1[3]);
                        *(u32x4*)(rp + bj * 128) = w; }
                }
            }
    }
};

__device__ __forceinline__ int crow(int r, int hi) { return (r & 3) + 8 * (r >> 2) + 4 * hi; }
__device__ __forceinline__ void attn_task(const bf16_t* __restrict__ q, int qld, const bf16_t* __restrict__ k, int kld, const bf16_t* __restrict__ vt, bf16_t* o, int old,
                                          float* lse, int lseld, int dil, int qt, int nback, bool has_sink, float sink2, int lane) {
    const int r = lane & 31, hi = lane >> 5, c0 = 32 * qt;
    bf16x8 qf[4];
    { const bf16_t* qp = q + (size_t)(c0 + r) * dil * qld + 8 * hi;
#pragma unroll
      for (int ds = 0; ds < 4; ++ds) qf[ds] = *(const bf16x8*)(qp + 16 * ds); }
    float m = has_sink ? sink2 : -1e30f, l = (has_sink && hi == 0) ? 1.f : 0.f;
    f32x16 O0 = {}, O1 = {};
    const int kt0 = qt > 4 ? qt - 4 : 0;
    const int qpos = c0 + r;
    for (int kt = kt0; kt <= qt; ++kt) {
        bf16x8 kf[4];
        { const bf16_t* kp = k + (size_t)(32 * kt + r) * dil * kld + 8 * hi;
#pragma unroll
          for (int ds = 0; ds < 4; ++ds) kf[ds] = *(const bf16x8*)(kp + 16 * ds); }
        s16x4 va[2][2][2];
#pragma unroll
        for (int dt = 0; dt < 2; ++dt)
#pragma unroll
            for (int s = 0; s < 2; ++s) { const bf16_t* vp = vt + ((size_t)(32 * dt + r) << 11) + 32 * kt + 16 * s + 4 * hi; va[dt][s][0] = *(const s16x4*)vp; va[dt][s][1] = *(const s16x4*)(vp + 8); }
        f32x16 x = {};
#pragma unroll
        for (int ds = 0; ds < 4; ++ds) x = __builtin_amdgcn_mfma_f32_32x32x16_bf16(kf[ds], qf[ds], x, 0, 0, 0);
        if (kt == qt || kt == qt - 4) {
            const int kb = 32 * kt;
#pragma unroll
            for (int i = 0; i < 16; ++i) { const int dist = qpos - (kb + crow(i, hi)); if (dist < 0 || dist > nback) x[i] = -INFINITY; }
        }
        float mx = x[0];
#pragma unroll
        for (int i = 1; i < 16; ++i) mx = __builtin_fmaxf(mx, x[i]);
        mx = __builtin_fmaxf(mx, __shfl_xor(mx, 32));
        const float mnew = __builtin_fmaxf(m, mx), alpha = __builtin_amdgcn_exp2f(m - mnew);
        m = mnew;
        float ls = 0.f;
#pragma unroll
        for (int i = 0; i < 16; ++i) { x[i] = __builtin_amdgcn_exp2f(x[i] - mnew); ls += x[i]; }
        l = l * alpha + ls;
#pragma unroll
        for (int i = 0; i < 16; ++i) { O0[i] *= alpha; O1[i] *= alpha; }
        bf16x8 pf[2];
#pragma unroll
        for (int s = 0; s < 2; ++s) { u32x4 p; p.x = pk2(x[8 * s], x[8 * s + 1]); p.y = pk2(x[8 * s + 2], x[8 * s + 3]); p.z = pk2(x[8 * s + 4], x[8 * s + 5]); p.w = pk2(x[8 * s + 6], x[8 * s + 7]); pf[s] = __builtin_bit_cast(bf16x8, p); }
#pragma unroll
        for (int s = 0; s < 2; ++s) {
            const bf16x8 v0 = __builtin_shufflevector(va[0][s][0], va[0][s][1], 0, 1, 2, 3, 4, 5, 6, 7), v1 = __builtin_shufflevector(va[1][s][0], va[1][s][1], 0, 1, 2, 3, 4, 5, 6, 7);
            O0 = __builtin_amdgcn_mfma_f32_32x32x16_bf16(v0, pf[s], O0, 0, 0, 0);
            O1 = __builtin_amdgcn_mfma_f32_32x32x16_bf16(v1, pf[s], O1, 0, 0, 0);
        }
    }
    l += __shfl_xor(l, 32);
    const float inv = 1.0f / l;
    bf16_t* op = o + (size_t)(c0 + r) * dil * old + 4 * hi;
#pragma unroll
    for (int g = 0; g < 4; ++g) {
        u32x2 w0, w1;
        w0.x = pk2(O0[4 * g] * inv, O0[4 * g + 1] * inv); w0.y = pk2(O0[4 * g + 2] * inv, O0[4 * g + 3] * inv);
        w1.x = pk2(O1[4 * g] * inv, O1[4 * g + 1] * inv); w1.y = pk2(O1[4 * g + 2] * inv, O1[4 * g + 3] * inv);
        *(u32x2*)(op + 8 * g) = w0; *(u32x2*)(op + 32 + 8 * g) = w1;
    }
    if (lse && hi == 0) lse[(size_t)(c0 + r) * dil * lseld] = m + __builtin_amdgcn_logf(l);
}

struct Args { const float* in[16]; float* out; unsigned char* ws; int ph_lo, ph_hi; };
constexpr int NPHASE = 12;

__device__ __forceinline__ void p0_transpose_item(const float* W, int N, int k0, int n0, bf16_t* WT, size_t ldo, size_t orow0, size_t ocol0, LAS float* scr, int lane) {
#pragma unroll 8
    for (int i = 0; i < 32; ++i) { const int kk = 2 * i + (lane >> 5); scr[kk * 33 + (lane & 31)] = W[(size_t)(k0 + kk) * N + n0 + (lane & 31)]; }
    LDS_WAIT(); asm volatile("" ::: "memory");
    const int c = lane & 7;
#pragma unroll
    for (int j = 0; j < 4; ++j) { const int n = (lane >> 3) + 8 * j; const LAS float* s = scr + (8 * c) * 33 + n;
        u32x4 o; o.x = pk2(s[0 * 33], s[1 * 33]); o.y = pk2(s[2 * 33], s[3 * 33]); o.z = pk2(s[4 * 33], s[5 * 33]); o.w = pk2(s[6 * 33], s[7 * 33]);
        *(u32x4*)(WT + (orow0 + n) * ldo + ocol0 + 8 * c) = o; }
    LDS_WAIT(); asm volatile("" ::: "memory");
}

__global__ void __launch_bounds__(512, 2) mk_fwd(Args args) {
    extern __shared__ __attribute__((aligned(16))) unsigned char lds_raw[];
    LAS unsigned char* lds = (LAS unsigned char*)lds_raw;
    volatile LAS unsigned* MISC = (volatile LAS unsigned*)(lds + MISC_OFF);
    const int tid = threadIdx.x, lane = tid & 63, wave = __builtin_amdgcn_readfirstlane(tid >> 6);
    const int G = gridDim.x, bx = blockIdx.x;
    const int gw = bx * 8 + wave, NGW = G * 8;
    unsigned char* const ws = args.ws;
    unsigned* const ctl = (unsigned*)(ws + WS_CTL);
#define X_IN     (args.in[0])
#define w_in     (args.in[1])
#define sinks    (args.in[2])
#define w_ba     (args.in[3])
#define w_bb     (args.in[4])
#define w_out    (args.in[5])
#define ln1g     (args.in[6])
#define ln1b     (args.in[7])
#define w_router (args.in[8])
#define b_router (args.in[9])
#define w_gu     (args.in[10])
#define b_gu     (args.in[11])
#define w_dn     (args.in[12])
#define b_dn     (args.in[13])
#define ln2g     (args.in[14])
#define ln2b     (args.in[15])
#define OUTP     (args.out)
#define cosT   ((float*)(ws + WS_COS))
#define sinT   ((float*)(ws + WS_SIN))
#define WIN    ((bf16_t*)(ws + WS_WIN))
#define WAB    ((bf16_t*)(ws + WS_WAB))
#define WOUT   ((bf16_t*)(ws + WS_WOUT))
#define WGU    ((bf16_t*)(ws + WS_WGU))
#define WDN    ((bf16_t*)(ws + WS_WDN))
#define TOPE   ((int*)(ws + WS_TOPE))
#define TOPW   ((float*)(ws + WS_TOPW))
#define HIST   ((int*)(ws + WS_HIST))
#define ROWTOK ((int*)(ws + WS_ROWTOK))
#define ROWDST ((int*)(ws + WS_ROWDST))
#define TILEE  ((int*)(ws + WS_TILEE))
#define OAB    ((bf16_t*)(ws + WS_OAB))
#define XB     ((bf16_t*)(ws + WS_XB))
#define H1     ((bf16_t*)(ws + WS_H1))
#define Gt     ((bf16_t*)(ws + WS_G))
#define KB     ((bf16_t*)(ws + WS_KB))
#define VAT    ((bf16_t*)(ws + WS_VAT))
#define VBT    ((bf16_t*)(ws + WS_VBT))
#define OG     ((bf16_t*)(ws + WS_OG))
#define LSE    ((float*)(ws + WS_LSE))
#define MERGED ((bf16_t*)(ws + WS_MERGED))
#define Hh     ((bf16_t*)(ws + WS_H))
#define Y      ((bf16_t*)(ws + WS_Y))
#define QA     ((bf16_t*)((unsigned char*)args.out + DO_QA))
#define QB     ((bf16_t*)((unsigned char*)args.out + DO_QB))
#define KA     ((bf16_t*)((unsigned char*)args.out + DO_KA))

    for (int u = tid; u < (LDS_BYTES - LDSCTL_OFF) / 4; u += 512) ((LAS unsigned*)(lds + LDSCTL_OFF))[u] = 0u;
    __syncthreads();
    XcdBarrier bar; bar.bar = ctl + CW_BAR; bar.x = 0; bar.st = nullptr;
    if (MK_ONE_LAUNCH) bar = xcd_barrier_post(ctl + CW_BAR, MISC + 8);
    const int lo = args.ph_lo, hi = args.ph_hi;
#ifndef PH_MASK
#define PH_MASK 0xFFFF
#endif
#define IN(k) (((PH_MASK >> (k)) & 1) && lo <= (k) && (k) < hi)
#define SEAM(k) do { if (IN(k) && IN((k) + 1)) xcd_barrier(bar); } while (0)
#ifndef REPEAT_MASK
#define REPEAT_MASK 0
#endif
#define REPN(k) ((((REPEAT_MASK) >> (k)) & 1) ? 2 : 1)
#define REP_LOOP(k) for (int rep_ = 0; rep_ < REPN(k); ++rep_)
#define REP_SYNC() do { if (rep_) xcd_barrier(bar); } while (0)

    if (IN(0)) { REP_LOOP(0) { REP_SYNC();
        LAS float* scr = (LAS float*)(lds + wave * 16384);
        constexpr int I_IN = 16 * 184, I_BA = 16 * 32, I_BB = 4 * 32, I_OUT = 16 * 32, I_GU = 32 * 16 * 64, I_DN = 32 * 16 * 32;
        constexpr int NITEMS = I_IN + I_BA + I_BB + I_OUT + I_GU + I_DN;
        for (int it = gw; it < NITEMS; it += NGW) {
            int r = it;
            if (r < I_IN) { const int kb = r / 184, nb = r % 184, n0 = 32 * nb, tile = n0 >> 8, within = n0 & 255;
                const bool rope = tile < 5 || (tile >= 6 && tile < 12);
                const int orow = rope ? tile * 256 + 128 * ((within & 63) >> 5) + 32 * (within >> 6) : n0;
                p0_transpose_item(w_in, INW, 64 * kb, n0, WIN, 1024, orow, 64 * kb, scr, lane); continue; } r -= I_IN;
            if (r < I_BA) { const int kb = r / 32, nb = r % 32; p0_transpose_item(w_ba, 1024, 64 * kb, 32 * nb, WAB, 1280, 32 * nb, 64 * kb, scr, lane); continue; } r -= I_BA;
            if (r < I_BB) { const int kb = r / 32, nb = r % 32; p0_transpose_item(w_bb, 1024, 64 * kb, 32 * nb, WAB, 1280, 32 * nb, 1024 + 64 * kb, scr, lane); continue; } r -= I_BB;
            if (r < I_OUT) { const int kb = r / 32, nb = r % 32; p0_transpose_item(w_out, 1024, 64 * kb, 32 * nb, WOUT, 1024, 32 * nb, 64 * kb, scr, lane); continue; } r -= I_OUT;
            if (r < I_GU) { const int e = r / 1024, q = r % 1024, kb = q / 64, nb = q % 64, n0 = 32 * nb, np = n0 & 1023;
                const int orow = e * 2048 + (np >> 7) * 256 + (n0 >= 1024 ? 128 : 0) + (np & 127);
                p0_transpose_item(w_gu + (size_t)e * 1024 * 2048, 2048, 64 * kb, n0, WGU, 1024, orow, 64 * kb, scr, lane); continue; } r -= I_GU;
            { const int e = r / 512, q = r % 512, kb = q / 32, nb = q % 32;
                p0_transpose_item(w_dn + (size_t)e * 1024 * 1024, 1024, 64 * kb, 32 * nb, WDN, 1024, e * 1024 + 32 * nb, 64 * kb, scr, lane); }
        }
        for (size_t i = (size_t)bx * 512 + tid; i < (size_t)T * D / 8; i += (size_t)G * 512) {
            const f32x4 a = *(const f32x4*)(X_IN + i * 8), b = *(const f32x4*)(X_IN + i * 8 + 4);
            u32x4 w; w.x = pk2(a[0], a[1]); w.y = pk2(a[2], a[3]); w.z = pk2(b[0], b[1]); w.w = pk2(b[2], b[3]);
            *(u32x4*)(XB + i * 8) = w;
        }
        for (int i = bx * 512 + tid; i < SEQ * 32; i += G * 512) {
            const int pos = i >> 5, f = i & 31;
            const double invf = exp2(-(double)f * (13.287712379549449 / 32.0));
            const double ang = (double)pos * invf;
            cosT[i] = (float)cos(ang); sinT[i] = (float)sin(ang);
        }
    }
    }
    SEAM(0);

    if (IN(1)) { REP_LOOP(1) { REP_SYNC();
        pg8::StaticOrder S; S.init(T, INW, G, bx);
        EpiInProj E{QA, KA, VAT, QB, KB, VBT, Gt, cosT, sinT};
        pg8::gemm_phase(lds, XB, WIN, 1024, S, pg8::ADense{}, E, pg8::NoHook{});
    }
    }
    SEAM(1);

    if (IN(2)) { REP_LOOP(2) { REP_SYNC();
        for (int ui = bx; ui < 1024; ui += G) {
            if (ui < 512) {
                const int kvh = ui & 3, blk = (ui >> 2) & 3, b = ui >> 4;
                for (int i = 0; i < 8; ++i) {
                    const int t = wave + 8 * i, qtl = t >> 2, hq = t & 3, head = kvh * 4 + hq;
                    attn_task(QA + (size_t)b * SEQ * 1024 + head * 64, 1024, KA + (size_t)b * SEQ * 256 + kvh * 64, 256, VAT + ((size_t)(b * 4 + kvh) * 64 << 11),
                              OAB + (size_t)b * SEQ * 1280 + head * 64, 1280, nullptr, 0, 1, blk * 16 + qtl, 127, true, sinks[head] * LOG2E, lane);
                }
            } else {
                const int id = ui - 512, hh = id & 3, blk = (id >> 2) & 3, b = id >> 4;
                for (int i = 0; i < 6; ++i) {
                    const int t = wave + 8 * i, g = t >> 4, tt = t & 15;
                    int res, qt, dil, L;
                    if (g == 0) { res = 0; qt = blk * 16 + tt; dil = 1; L = 2048; }
                    else if (g == 1) { res = tt >> 2; qt = blk * 4 + (tt & 3); dil = 4; L = 512; }
                    else { res = tt; qt = blk; dil = 16; L = 128; }
                    const int h12 = 4 * g + hh; const size_t trow = (size_t)b * SEQ + res;
                    attn_task(QB + trow * 768 + h12 * 64, 768, KB + trow * 768 + h12 * 64, 768, VBT + ((size_t)(b * 12 + h12) * 64 << 11) + res * L,
                              OG + trow * 768 + h12 * 64, 768, LSE + trow * 12 + h12, 12, dil, qt, 128, false, 0.f, lane);
                }
                VM_WAIT(); __syncthreads();
                for (int it = 0; it < 8; ++it) {
                    const int tokl = it * 64 + (tid >> 3), ch = tid & 7; const size_t tok = (size_t)b * SEQ + blk * 512 + tokl;
                    const float l0 = LSE[tok * 12 + hh], l1 = LSE[tok * 12 + 4 + hh], l2 = LSE[tok * 12 + 8 + hh];
                    const float mx = __builtin_fmaxf(l0, __builtin_fmaxf(l1, l2));
                    float w0 = __builtin_amdgcn_exp2f(l0 - mx), w1 = __builtin_amdgcn_exp2f(l1 - mx), w2 = __builtin_amdgcn_exp2f(l2 - mx);
                    const float inv = 1.0f / (w0 + w1 + w2); w0 *= inv; w1 *= inv; w2 *= inv;
                    const u32x4 a = *(const u32x4*)(OG + tok * 768 + hh * 64 + ch * 8), c = *(const u32x4*)(OG + tok * 768 + (4 + hh) * 64 + ch * 8), d = *(const u32x4*)(OG + tok * 768 + (8 + hh) * 64 + ch * 8);
                    u32x4 w;
                    w.x = pk2(w0 * bflo(a.x) + w1 * bflo(c.x) + w2 * bflo(d.x), w0 * bfhi(a.x) + w1 * bfhi(c.x) + w2 * bfhi(d.x));
                    w.y = pk2(w0 * bflo(a.y) + w1 * bflo(c.y) + w2 * bflo(d.y), w0 * bfhi(a.y) + w1 * bfhi(c.y) + w2 * bfhi(d.y));
                    w.z = pk2(w0 * bflo(a.z) + w1 * bflo(c.z) + w2 * bflo(d.z), w0 * bfhi(a.z) + w1 * bfhi(c.z) + w2 * bfhi(d.z));
                    w.w = pk2(w0 * bflo(a.w) + w1 * bflo(c.w) + w2 * bflo(d.w), w0 * bfhi(a.w) + w1 * bfhi(c.w) + w2 * bfhi(d.w));
                    *(u32x4*)(OAB + tok * 1280 + 1024 + hh * 64 + ch * 8) = w;
                }
                __syncthreads();
            }
        }
    }
    }
    SEAM(2);

    if (IN(3)) { REP_LOOP(3) { REP_SYNC();
        pg8::StaticOrder S; S.init(T, 1024, G, bx);
        EpiMerged E{Gt, MERGED}; HookGateRatio HK{Gt};
        pg8::gemm_phase(lds, OAB, WAB, 1280, S, pg8::ADense{}, E, HK);
    }
    }
    SEAM(3);

    if (IN(4)) { REP_LOOP(4) { REP_SYNC();
        pg8::StaticOrder S; S.init(T, 1024, G, bx);
        EpiPre E{X_IN, OUTP};
        pg8::gemm_phase(lds, MERGED, WOUT, 1024, S, pg8::ADense{}, E, pg8::NoHook{});
    }
    }
    SEAM(4);

    if (IN(5)) { REP_LOOP(5) { REP_SYNC();
        constexpr int GWROW = 2064;
        LAS unsigned char* GWH = lds; LAS unsigned char* GWL = lds + 32 * GWROW;
        LAS float* gws = (LAS float*)(lds + SCR_OFF); LAS float* bws = gws + 32; LAS int* histL = (LAS int*)(bws + 32); LAS float* partL = (LAS float*)(histL + 32);
        for (int idx = tid; idx < 32 * 1024; idx += 512) { const int d = idx >> 5, e = idx & 31;
            const float v = w_router[idx] * ln1g[d]; const unsigned hb = pk2(v, 0.f) & 0xffffu; const float vh = __uint_as_float(hb << 16); const unsigned lb = pk2(v - vh, 0.f) & 0xffffu;
            ((LAS bf16_t*)(GWH + e * GWROW))[d] = (bf16_t)hb; ((LAS bf16_t*)(GWL + e * GWROW))[d] = (bf16_t)lb; }
        { const int e = tid & 31, p = tid >> 5; float sg = 0.f, sb = 0.f;
          for (int d = 64 * p; d < 64 * p + 64; ++d) { const float w = w_router[d * 32 + e]; sg += ln1g[d] * w; sb += ln1b[d] * w; }
          partL[(p * 32 + e) * 2] = sg; partL[(p * 32 + e) * 2 + 1] = sb; }
        __syncthreads();
        if (tid < 32) { float sg = 0.f, sb = 0.f; for (int p = 0; p < 16; ++p) { sg += partL[(p * 32 + tid) * 2]; sb += partL[(p * 32 + tid) * 2 + 1]; } gws[tid] = sg; bws[tid] = sb + b_router[tid]; }
        __syncthreads();
        const int r32 = lane & 31, hi5 = lane >> 5;
        for (int vw = bx; vw < 256; vw += G) {
            if (tid < 32) histL[tid] = 0;
            __syncthreads();
            const int tok0 = vw * 256 + wave * 32;
            const float* src = OUTP + (size_t)(tok0 + r32) * 1024 + 8 * hi5;
            const LAS unsigned char* ahp = GWH + r32 * GWROW + 16 * hi5; const LAS unsigned char* alp = GWL + r32 * GWROW + 16 * hi5;
            f32x16 acc0 = {}, acc1 = {}, acc2 = {};
            float s1 = 0.f, s2 = 0.f;
            f32x4 xa[4][2], xb[4][2];
#define P5_LOAD(buf, ks0) do { _Pragma("unroll") for (int q_ = 0; q_ < 4; ++q_) { buf[q_][0] = *(const f32x4*)(src + 16 * ((ks0) + q_)); buf[q_][1] = *(const f32x4*)(src + 16 * ((ks0) + q_) + 4); } } while (0)
#define P5_COMP(buf, ks0) do { _Pragma("unroll") for (int q_ = 0; q_ < 4; ++q_) { const f32x4 u0_ = buf[q_][0], u1_ = buf[q_][1]; \
                s1 += (u0_[0] + u0_[1]) + (u0_[2] + u0_[3]) + (u1_[0] + u1_[1]) + (u1_[2] + u1_[3]); \
                s2 += (u0_[0] * u0_[0] + u0_[1] * u0_[1]) + (u0_[2] * u0_[2] + u0_[3] * u0_[3]) + (u1_[0] * u1_[0] + u1_[1] * u1_[1]) + (u1_[2] * u1_[2] + u1_[3] * u1_[3]); \
                u32x4 wh_, wl_; wh_.x = pk2(u0_[0], u0_[1]); wh_.y = pk2(u0_[2], u0_[3]); wh_.z = pk2(u1_[0], u1_[1]); wh_.w = pk2(u1_[2], u1_[3]); \
                wl_.x = pk2(u0_[0] - bflo(wh_.x), u0_[1] - bfhi(wh_.x)); wl_.y = pk2(u0_[2] - bflo(wh_.y), u0_[3] - bfhi(wh_.y)); \
                wl_.z = pk2(u1_[0] - bflo(wh_.z), u1_[1] - bfhi(wh_.z)); wl_.w = pk2(u1_[2] - bflo(wh_.w), u1_[3] - bfhi(wh_.w)); \
                const bf16x8 bh_ = __builtin_bit_cast(bf16x8, wh_), bl_ = __builtin_bit_cast(bf16x8, wl_); \
                const bf16x8 ah_ = *(const LAS bf16x8*)(ahp + 32 * ((ks0) + q_)), al_ = *(const LAS bf16x8*)(alp + 32 * ((ks0) + q_)); \
                acc0 = __builtin_amdgcn_mfma_f32_32x32x16_bf16(ah_, bh_, acc0, 0, 0, 0); acc1 = __builtin_amdgcn_mfma_f32_32x32x16_bf16(ah_, bl_, acc1, 0, 0, 0); \
                acc2 = __builtin_amdgcn_mfma_f32_32x32x16_bf16(al_, bh_, acc2, 0, 0, 0); } } while (0)
            P5_LOAD(xa, 0);
            for (int it = 0; it < 8; ++it) {
                P5_LOAD(xb, 8 * it + 4);
                P5_COMP(xa, 8 * it);
                if (it < 7) P5_LOAD(xa, 8 * it + 8);
                P5_COMP(xb, 8 * it + 4);
            }
#undef P5_LOAD
#undef P5_COMP
            s1 += __shfl_xor(s1, 32); s2 += __shfl_xor(s2, 32);
            const float mean = s1 * (1.f / 1024.f), var = __builtin_fmaxf(s2 * (1.f / 1024.f) - mean * mean, 0.f), rstd = 1.0f / sqrtf(var + LN_EPS);
            float v[16];
#pragma unroll
            for (int i = 0; i < 16; ++i) v[i] = rstd * ((acc0[i] + acc1[i] + acc2[i]) - mean * gws[crow(i, hi5)]) + bws[crow(i, hi5)];
            float cv[8]; int ce[8];
#pragma unroll
            for (int kk = 0; kk < 4; ++kk) {
                float bv = v[0]; int bi = 0;
#pragma unroll
                for (int i = 1; i < 16; ++i) if (v[i] > bv) { bv = v[i]; bi = i; }
                cv[kk] = bv; ce[kk] = crow(bi, hi5);
#pragma unroll
                for (int i = 0; i < 16; ++i) v[i] = (i == bi) ? -INFINITY : v[i];
            }
#pragma unroll
            for (int kk = 0; kk < 4; ++kk) { cv[4 + kk] = __shfl_xor(cv[kk], 32); ce[4 + kk] = __shfl_xor(ce[kk], 32); }
            float tv[4]; int te[4];
#pragma unroll
            for (int kk = 0; kk < 4; ++kk) {
                float bv = cv[0]; int be = ce[0], bi = 0;
#pragma unroll
                for (int i = 1; i < 8; ++i) if (cv[i] > bv || (cv[i] == bv && ce[i] < be)) { bv = cv[i]; be = ce[i]; bi = i; }
                tv[kk] = bv; te[kk] = be;
#pragma unroll
                for (int i = 0; i < 8; ++i) cv[i] = (i == bi) ? -INFINITY : cv[i];
            }
            { const float e1 = __expf(tv[1] - tv[0]), e2 = __expf(tv[2] - tv[0]), e3 = __expf(tv[3] - tv[0]); const float inv = 1.0f / (1.0f + e1 + e2 + e3);
              if (hi5 == 0) { const size_t tk = (size_t)(tok0 + r32) * 4;
                  *(int4*)(TOPE + tk) = make_int4(te[0], te[1], te[2], te[3]); *(f32x4*)(TOPW + tk) = (f32x4){inv, e1 * inv, e2 * inv, e3 * inv};
                  atomicAdd((int*)(histL + te[0]), 1); atomicAdd((int*)(histL + te[1]), 1); atomicAdd((int*)(histL + te[2]), 1); atomicAdd((int*)(histL + te[3]), 1); } }
            f32x4 gg[4], bb[4];
#pragma unroll
            for (int j = 0; j < 4; ++j) { gg[j] = *(const f32x4*)(ln1g + 4 * lane + 256 * j); bb[j] = *(const f32x4*)(ln1b + 4 * lane + 256 * j); }
#pragma unroll 4
            for (int i = 0; i < 32; ++i) {
                const float mi = __uint_as_float(__builtin_amdgcn_readlane(__float_as_uint(mean), i)), ri = __uint_as_float(__builtin_amdgcn_readlane(__float_as_uint(rstd), i));
                const float* pp = OUTP + (size_t)(tok0 + i) * 1024 + 4 * lane; bf16_t* hp = H1 + (size_t)(tok0 + i) * 1024 + 4 * lane;
#pragma unroll
                for (int j = 0; j < 4; ++j) { const f32x4 xv = (*(const f32x4*)(pp + 256 * j) - mi) * ri * gg[j] + bb[j]; u32x2 w; w.x = pk2(xv[0], xv[1]); w.y = pk2(xv[2], xv[3]); *(u32x2*)(hp + 256 * j) = w; }
            }
            __syncthreads();
            if (tid < 32) HIST[vw * 32 + tid] = histL[tid];
            __syncthreads();
        }
    } }
    SEAM(5);

    if (IN(6)) { REP_LOOP(6) { REP_SYNC();
        LAS int* part = (LAS int*)(lds + SCR_OFF);
        LAS int* cntL = part + 512; LAS int* befL = cntL + 32; LAS int* tstL = befL + 32; LAS int* baseL = tstL + 40; LAS int* curL = baseL + 32;
        for (int vw = bx; vw < 256; vw += G) {
            const int hf = vw >> 7, wl = vw & 127;
            { const int e = tid & 31, p = tid >> 5; int s = 0;
              for (int i = 0; i < 8; ++i) s += HIST[(128 * hf + 8 * p + i) * 32 + e];
              part[p * 32 + e] = s; }
            __syncthreads();
            if (tid < 32) { int tot = 0, bef = 0; const int pw = wl >> 3, iw = wl & 7;
                for (int p = 0; p < 16; ++p) { const int v = part[p * 32 + tid]; tot += v; if (p < pw) bef += v; }
                for (int i = 0; i < iw; ++i) bef += HIST[(128 * hf + 8 * pw + i) * 32 + tid];
                cntL[tid] = tot; befL[tid] = bef; curL[tid] = 0; }
            __syncthreads();
            if (tid == 0) { int run = 0; for (int e = 0; e < 32; ++e) { tstL[e] = run; run += (cntL[e] + 255) >> 8; } tstL[32] = run; }
            __syncthreads();
            if (tid < 32) baseL[tid] = tstL[tid] * 256 + befL[tid];
            __syncthreads();
            int* rt = ROWTOK + (size_t)hf * HROWS; int* rd = ROWDST + (size_t)hf * HROWS;
            for (int idx = tid; idx < 1024; idx += 512) {
                const int tok = vw * 256 + (idx >> 2), kk = idx & 3, e = TOPE[(size_t)tok * 4 + kk];
                const int pos = baseL[e] + atomicAdd((int*)(curL + e), 1);
                rt[pos] = tok; rd[pos] = (tok - hf * HALF_T) * 4 + kk;
            }
            if (wl < 32) { const int e = wl, r0 = tstL[e] * 256 + cntL[e], r1 = tstL[e + 1] * 256;
                for (int r = r0 + tid; r < r1; r += 512) { rt[r] = hf * HALF_T; rd[r] = -1; } }
            if (wl == 32) { int* te = TILEE + hf * 1024; const int nt = tstL[32];
                for (int t = tid; t < nt; t += 512) { int e = 0; for (int q = 1; q < 32; ++q) if (t >= tstL[q]) e = q; te[t] = e; }
                if (tid == 0) te[1000] = nt; }
            __syncthreads();
        }
    }
    }
    SEAM(6);

#pragma unroll
    for (int hf = 0; hf < 2; ++hf) {
        const int p_gu = 7 + 2 * hf, p_dn = 8 + 2 * hf, p_cb = 9 + 2 * hf;
        const int* te = TILEE + hf * 1024; const int* rt = ROWTOK + (size_t)hf * HROWS; const int* rd = ROWDST + (size_t)hf * HROWS;
        if (IN(p_gu)) { REP_LOOP(p_gu) { REP_SYNC();
            const int NT = te[1000];
            LAS int* teL = (LAS int*)(lds + SCR_OFF);
            for (int t = tid; t < NT; t += 512) teL[t] = te[t];
            __syncthreads();
            pg8::MoeOrder S; S.init(teL, NT, 8, G, bx);
            EpiSwiglu E{b_gu, Hh};
            pg8::gemm_phase(lds, H1, WGU, 1024, S, pg8::AGather{rt}, E, pg8::NoHook{});
        } }
        SEAM(p_gu);
        if (IN(p_dn)) { REP_LOOP(p_dn) { REP_SYNC();
            const int NT = te[1000];
            LAS int* teL = (LAS int*)(lds + SCR_OFF);
            for (int t = tid; t < NT; t += 512) teL[t] = te[t];
            __syncthreads();
            pg8::MoeOrder S; S.init(teL, NT, 4, G, bx);
            EpiDown E{b_dn, rd, Y};
            pg8::gemm_phase(lds, Hh, WDN, 1024, S, pg8::ADense{}, E, pg8::NoHook{});
        } }
        SEAM(p_dn);
        if (IN(p_cb)) { REP_LOOP(p_cb + 3) { REP_SYNC();
            f32x4 g2[4], b2[4];
#pragma unroll
            for (int j = 0; j < 2; ++j) { g2[2 * j] = *(const f32x4*)(ln2g + 8 * lane + 512 * j); g2[2 * j + 1] = *(const f32x4*)(ln2g + 8 * lane + 512 * j + 4);
                b2[2 * j] = *(const f32x4*)(ln2b + 8 * lane + 512 * j); b2[2 * j + 1] = *(const f32x4*)(ln2b + 8 * lane + 512 * j + 4); }
            for (int tl = gw; tl < HALF_T; tl += NGW) {
                const int tok = hf * HALF_T + tl;
                const f32x4 wv = *(const f32x4*)(TOPW + (size_t)tok * 4);
                f32x4 v[4]; float s = 0.f;
#pragma unroll
                for (int j = 0; j < 2; ++j) {
                    const int c = 8 * lane + 512 * j;
                    const u32x4 hh = *(const u32x4*)(H1 + (size_t)tok * 1024 + c);
                    f32x4 a = (f32x4){bflo(hh.x), bfhi(hh.x), bflo(hh.y), bfhi(hh.y)} * ALPHA, b = (f32x4){bflo(hh.z), bfhi(hh.z), bflo(hh.w), bfhi(hh.w)} * ALPHA;
#pragma unroll
                    for (int kk = 0; kk < 4; ++kk) { const u32x4 yy = *(const u32x4*)(Y + ((size_t)tl * 4 + kk) * 1024 + c); const float w = wv[kk];
                        a += (f32x4){bflo(yy.x), bfhi(yy.x), bflo(yy.y), bfhi(yy.y)} * w; b += (f32x4){bflo(yy.z), bfhi(yy.z), bflo(yy.w), bfhi(yy.w)} * w; }
                    v[2 * j] = a; v[2 * j + 1] = b; s += (a[0] + a[1]) + (a[2] + a[3]) + (b[0] + b[1]) + (b[2] + b[3]);
                }
                const float mean = wave_sum(s) * (1.f / 1024.f); float s2 = 0.f;
#pragma unroll
                for (int j = 0; j < 4; ++j) { v[j] = v[j] - mean; s2 += (v[j][0] * v[j][0] + v[j][1] * v[j][1]) + (v[j][2] * v[j][2] + v[j][3] * v[j][3]); }
                const float rstd = 1.0f / sqrtf(wave_sum(s2) * (1.f / 1024.f) + LN_EPS);
                float* op = OUTP + (size_t)tok * 1024 + 8 * lane;
#pragma unroll
                for (int j = 0; j < 2; ++j) { *(f32x4*)(op + 512 * j) = v[2 * j] * rstd * g2[2 * j] + b2[2 * j]; *(f32x4*)(op + 512 * j + 4) = v[2 * j + 1] * rstd * g2[2 * j + 1] + b2[2 * j + 1]; }
            }
        } }
    }
#undef IN
#undef SEAM
}

extern "C" void kernel_launch(void* const* d_in, const int* in_sizes, int n_in, void* d_out, int out_size, void* d_ws, size_t ws_size, hipStream_t stream) {
    static int grid = 0;
    if (grid == 0) {
        if (n_in != 16 || in_sizes[0] != T * D || out_size != T * D || ws_size < WS_END) { fprintf(stderr, "kernel_launch: unexpected shapes / workspace (%d inputs, ws %zu)\n", n_in, ws_size); grid = -1; return; }
        int dev = 0, cus = 0, per_cu = 0;
        if (hipGetDevice(&dev) != hipSuccess || hipDeviceGetAttribute(&cus, hipDeviceAttributeMultiprocessorCount, dev) != hipSuccess) { grid = -1; return; }
        if (hipFuncSetAttribute((const void*)mk_fwd, hipFuncAttributeMaxDynamicSharedMemorySize, LDS_BYTES) != hipSuccess) { fprintf(stderr, "kernel_launch: hipFuncSetAttribute failed\n"); grid = -1; return; }
        if (hipOccupancyMaxActiveBlocksPerMultiprocessor(&per_cu, (const void*)mk_fwd, 512, LDS_BYTES) != hipSuccess || per_cu < 1) { fprintf(stderr, "kernel_launch: occupancy query says %d\n", per_cu); }
        (void)hipGetLastError();
        grid = cus;
    }
    if (grid < 0) return;
    if (hipMemsetAsync((char*)d_ws + WS_CTL, 0, CTL_ZERO_BYTES, stream) != hipSuccess) return;
    Args a{};
    for (int i = 0; i < 16; ++i) a.in[i] = (const float*)d_in[i];
    a.out = (float*)d_out; a.ws = (unsigned char*)d_ws;
#if MK_ONE_LAUNCH
    a.ph_lo = 0; a.ph_hi = NPHASE;
    hipLaunchKernelGGL(mk_fwd, dim3(grid), dim3(512), LDS_BYTES, stream, a);
#else
    for (int p = 0; p < NPHASE; ++p) { a.ph_lo = p; a.ph_hi = p + 1; hipLaunchKernelGGL(mk_fwd, dim3(grid), dim3(512), LDS_BYTES, stream, a); }
#endif
}
```

```cpp
#include <hip/hip_runtime.h>
#include <cstdio>
#include <cstdint>

#ifndef MK_ONE_LAUNCH
#define MK_ONE_LAUNCH 1
#endif

#define LAS __attribute__((address_space(3)))
#define GAS __attribute__((address_space(1)))
typedef unsigned short bf16_t;
typedef short bf16x8 __attribute__((ext_vector_type(8)));
typedef short s16x4 __attribute__((ext_vector_type(4)));
typedef float f32x4 __attribute__((ext_vector_type(4)));
typedef float f32x2 __attribute__((ext_vector_type(2)));
typedef float f32x16 __attribute__((ext_vector_type(16)));
typedef unsigned u32x4 __attribute__((ext_vector_type(4)));
typedef unsigned u32x2 __attribute__((ext_vector_type(2)));
typedef __bf16 bf16x2_t __attribute__((ext_vector_type(2)));

constexpr int SEQ = 2048, NB = 32, T = NB * SEQ, D = 1024, INW = 5888, NE = 32, TOPK = 4;
constexpr float LN_EPS = 1e-5f;
constexpr float ALPHA = 1.189207115002721f;
constexpr float LOG2E = 1.4426950408889634f;
constexpr float QSCALE = 0.125f * LOG2E;
constexpr int HALF_T = T / 2;
constexpr int HROWS = HALF_T * TOPK + NE * 256;
constexpr int HTILES = HROWS / 256;

constexpr size_t MiB = 1u << 20;
constexpr size_t WS_CTL = 0, CTL_ZERO_BYTES = 1 * MiB;
constexpr size_t WS_COS = 1 * MiB, WS_SIN = WS_COS + 256 * 1024;
constexpr size_t WS_WIN = 2 * MiB;
constexpr size_t WS_WAB = 14 * MiB;
constexpr size_t WS_WOUT = 17 * MiB;
constexpr size_t WS_TOPE = 19 * MiB, WS_TOPW = 20 * MiB, WS_HIST = 21 * MiB;
constexpr size_t WS_ROWTOK = 22 * MiB, WS_ROWDST = 24 * MiB, WS_TILEE = 26 * MiB;
constexpr size_t WS_WGU = 32 * MiB;
constexpr size_t WS_WDN = 160 * MiB;
constexpr size_t WS_OAB = 224 * MiB;
constexpr size_t WS_XB = 224 * MiB;
constexpr size_t WS_H1 = 224 * MiB;
constexpr size_t WS_G = 384 * MiB;
constexpr size_t WS_KB = 640 * MiB;
constexpr size_t WS_VAT = 736 * MiB;
constexpr size_t WS_VBT = 768 * MiB;
constexpr size_t WS_OG = 864 * MiB;
constexpr size_t WS_LSE = 960 * MiB;
constexpr size_t WS_MERGED = 640 * MiB;
constexpr size_t WS_H = 352 * MiB;
constexpr size_t WS_Y = 624 * MiB;
constexpr size_t WS_END = 1024 * MiB;
static_assert(WS_H + (size_t)HROWS * 1024 * 2 <= WS_Y && WS_Y + (size_t)HALF_T * 4 * 1024 * 2 <= WS_END, "ws map");
static_assert(WS_LSE + (size_t)T * 12 * 4 <= WS_END && WS_OG + (size_t)T * 768 * 2 <= WS_LSE && WS_VBT + (size_t)T * 768 * 2 <= WS_OG, "ws map");
constexpr size_t DO_QA = 0, DO_QB = 128 * MiB, DO_KA = 224 * MiB;

constexpr int CW_TMO = 0, CW_CODE = 1, CW_BAR = 4096;

constexpr int RING_BYTES = 131072;
constexpr int LDSCTL_OFF = 135168, MISC_OFF = LDSCTL_OFF + 320, SCR_OFF = LDSCTL_OFF + 1024;
constexpr int LDS_BYTES = 151552;

#define RLX_AGENT __ATOMIC_RELAXED, __HIP_MEMORY_SCOPE_AGENT
#define LDS_WAIT() asm volatile("s_waitcnt lgkmcnt(0)" ::: "memory")
#define VM_WAIT() asm volatile("s_waitcnt vmcnt(0)" ::: "memory")
__device__ __forceinline__ unsigned pk2(float lo, float hi) { f32x2 v = {lo, hi}; bf16x2_t b = __builtin_convertvector(v, bf16x2_t); return __builtin_bit_cast(unsigned, b); }
__device__ __forceinline__ float bflo(unsigned w) { return __uint_as_float(w << 16); }
__device__ __forceinline__ float bfhi(unsigned w) { return __uint_as_float(w & 0xffff0000u); }
__device__ __forceinline__ float fast_sigmoid(float z) { return __builtin_amdgcn_rcpf(1.0f + __builtin_amdgcn_exp2f(-z * LOG2E)); }
__device__ __forceinline__ float wave_sum(float v) {
#pragma unroll
    for (int o = 1; o < 64; o <<= 1) v += __shfl_xor(v, o);
    return v;
}

#define XB_TMO      128
#define XB_XCNT(j)  (256  + 64 * (j))
#define XB_XSUB(j)  (1280 + 64 * (j))
#define XB_XGEN(j)  (2304 + 64 * (j))
#define XB_TOP      3328
#define XB_TOPGEN   3392
#define XCD_BAR_WORDS 3456
#define XB_SPIN_CAP (1u << 18)
__device__ __forceinline__ unsigned xb_ld(unsigned* p)              { return __hip_atomic_load(p, __ATOMIC_RELAXED, __HIP_MEMORY_SCOPE_AGENT); }
__device__ __forceinline__ unsigned xb_add(unsigned* p, unsigned v) { return __hip_atomic_fetch_add(p, v, __ATOMIC_RELAXED, __HIP_MEMORY_SCOPE_AGENT); }
__device__ __forceinline__ unsigned xb_xcc_id() { return (unsigned)__builtin_amdgcn_s_getreg((3 << 11) | 20) & 0xFu; }
#define XB_SPIN(cond, bar) do { unsigned _sp = 0; while (cond) { __builtin_amdgcn_s_sleep(1); \
    if ((++_sp & 255u) == 0u) { if (xb_ld(&(bar)[XB_TMO])) break; if (_sp > XB_SPIN_CAP) { atomicAdd(&(bar)[XB_TMO], 1u); break; } } } } while (0)
struct XcdBarrier { unsigned* bar; unsigned x; volatile LAS unsigned* st; };
__device__ __forceinline__ XcdBarrier xcd_barrier_post(unsigned* bar, volatile LAS unsigned* st) {
    XcdBarrier b; b.bar = bar; b.x = xb_xcc_id(); b.st = st;
    if (threadIdx.x == 0) (void)xb_add(&bar[XB_XCNT(b.x)], 1u);
    return b;
}
__device__ __forceinline__ void xcd_barrier_complete(unsigned* bar, unsigned x, unsigned& nloc, unsigned& nx) {
    const unsigned G = gridDim.x * gridDim.y * gridDim.z;
    unsigned sum, cnt, mine, sp = 0u;
    for (;;) {
        sum = 0u; cnt = 0u; mine = 0u;
#pragma unroll
        for (unsigned j = 0; j < 16; ++j) { const unsigned c = xb_ld(&bar[XB_XCNT(j)]); sum += c; cnt += (c > 0u) ? 1u : 0u; mine = (j == x) ? c : mine; }
        if (sum == G) break;
        __builtin_amdgcn_s_sleep(1);
        if ((++sp & 255u) == 0u) { if (xb_ld(&bar[XB_TMO])) break; if (sp > XB_SPIN_CAP) { atomicAdd(&bar[XB_TMO], 1u); break; } }
    }
    nloc = mine > 0u ? mine : 1u; nx = cnt > 0u ? cnt : 1u;
}
__device__ __forceinline__ void xcd_barrier(const XcdBarrier& b) {
    asm volatile("s_waitcnt vmcnt(0)" ::: "memory");
    __syncthreads();
    if (threadIdx.x == 0) {
        unsigned* bar = b.bar;
        __builtin_amdgcn_s_waitcnt(0);
        unsigned nloc = b.st[0], nx = b.st[1];
        if (nloc == 0u) { xcd_barrier_complete(bar, b.x, nloc, nx); b.st[0] = nloc; b.st[1] = nx; }
        const unsigned old = xb_add(&bar[XB_XSUB(b.x)], 1u);
        const unsigned gen = old / nloc;
        if (old + 1u == (gen + 1u) * nloc) {
            __builtin_amdgcn_fence(__ATOMIC_RELEASE, "agent");
            asm volatile("s_waitcnt vmcnt(0)" ::: "memory");
            const unsigned og = xb_add(&bar[XB_TOP], 1u);
            const unsigned tg = og / nx;
            if (og + 1u == (tg + 1u) * nx) xb_add(&bar[XB_TOPGEN], 1u);
            else XB_SPIN(xb_ld(&bar[XB_TOPGEN]) == tg, bar);
            __builtin_amdgcn_fence(__ATOMIC_ACQUIRE, "agent");
            xb_add(&bar[XB_XGEN(b.x)], 1u);
            asm volatile("s_waitcnt vmcnt(0)" ::: "memory");
        } else {
            XB_SPIN(xb_ld(&bar[XB_XGEN(b.x)]) == gen, bar);
            __builtin_amdgcn_fence(__ATOMIC_ACQUIRE, "agent");
            asm volatile("s_waitcnt vmcnt(0)" ::: "memory");
        }
    }
    __syncthreads();
}

namespace pg8 {
constexpr int BM = 256, BK = 64, HALF = 128, HTB = HALF * BK * 2, STAGE_BYTES = 8 * HTB, NXCD = 8, WGM = 8;
__host__ __device__ __forceinline__ int lds_byte(int r, int c) { const int st = (r >> 4) * 2 + (c >> 5), rr = r & 15, cc = c & 31, ob = rr * 64 + cc * 2; return st * 1024 + (ob ^ (((ob >> 9) & 1) << 5)); }
__host__ __device__ __forceinline__ void stage_rc(int b, int& R, int& C) { const int st = b / 1024, sb = b % 1024, swz = sb ^ (((sb >> 9) & 1) << 5); R = (st >> 1) * 16 + swz / 64; C = (st & 1) * 32 + (swz % 64) / 2; }
__host__ __device__ __forceinline__ int perm32(int rho) { const int n = rho >> 4, i = rho & 15; return 8 * (i >> 2) + 4 * n + (i & 3); }

struct Unit { int pm, pn; };

struct StaticOrder {
    int nM, nN, nwg, G, c;
    __device__ void init(int M, int N, int G_, int c_) { nM = M / BM; nN = N / BM; nwg = nM * nN; G = G_; c = c_; }
    __device__ bool next(int i, Unit& u) const {
        const long L = (long)i * G + c; if (L >= nwg) return false;
        int wgid = (int)L; { const int q = nwg / NXCD, r = nwg % NXCD, xcd = wgid % NXCD, off = wgid / NXCD; wgid = (xcd < r ? xcd * (q + 1) : r * (q + 1) + (xcd - r) * q) + off; }
        const int nig = WGM * nN, gid = wgid / nig, fm = gid * WGM, gsz = (nM - fm) < WGM ? (nM - fm) : WGM;
        u.pm = fm + ((wgid % nig) % gsz); u.pn = (wgid % nig) / gsz; return true;
    }
};
struct MoeOrder {
    const LAS int* tile_e; int NJ, W, r, t0, t1;
    __device__ void init(const LAS int* te, int NT, int NJ_, int G, int c) {
        tile_e = te; NJ = NJ_;
        if (G % 8 == 0) { const int x = c % 8; r = c / 8; W = G / 8; t0 = (int)((long)NT * x / 8); t1 = (int)((long)NT * (x + 1) / 8); }
        else { r = c; W = G; t0 = 0; t1 = NT; }
    }
    __device__ bool next(int i, Unit& u) const {
        const int idx = i * W + r, ntl = t1 - t0; if (idx >= ntl * NJ) return false;
        const int GT = 32 / NJ, per = GT * NJ, grp = idx / per, rem = idx - grp * per, gsz = (ntl - grp * GT) < GT ? (ntl - grp * GT) : GT;
        const int tile = t0 + grp * GT + rem % gsz, j = rem / gsz;
        u.pm = tile; u.pn = tile_e[tile] * NJ + j; return true;
    }
};
constexpr int TOKL_OFF = 135168 + 1024 + 4096;
struct ADense {
    __device__ __forceinline__ void prefetch(const Unit&, LAS unsigned char*, int, int, int) const {}
    __device__ __forceinline__ void rows(const Unit& u, LAS unsigned char*, int, const int (&R)[2], unsigned (&vr)[2][2]) const {
#pragma unroll
        for (int h = 0; h < 2; ++h)
#pragma unroll
            for (int i = 0; i < 2; ++i) vr[h][i] = (unsigned)(u.pm * BM + h * HALF + R[i]);
    }
};
struct AGather {
    const int* tok;
    __device__ __forceinline__ void prefetch(const Unit& u, LAS unsigned char* ldsb, int par, int wid, int lane) const {
        if (wid < 4) __builtin_amdgcn_global_load_lds((const unsigned*)(tok + u.pm * BM + wid * 64 + lane), (LAS unsigned*)(ldsb + TOKL_OFF + par * 1024 + wid * 256), 4, 0, 0);
    }
    __device__ __forceinline__ void rows(const Unit&, LAS unsigned char* ldsb, int par, const int (&R)[2], unsigned (&vr)[2][2]) const {
        const LAS unsigned* t = (const LAS unsigned*)(ldsb + TOKL_OFF + par * 1024);
#pragma unroll
        for (int h = 0; h < 2; ++h)
#pragma unroll
            for (int i = 0; i < 2; ++i) vr[h][i] = t[h * HALF + R[i]];
    }
};
struct NoHook { static constexpr int T = -1; __device__ __forceinline__ void operator()(f32x4 (&)[2][2][4][2], const Unit&, int, int, int, int) const {} };

template <class Epi, class Sched, class AMap, class Hook>
__device__ __forceinline__ void gemm_phase(LAS unsigned char* lds, const bf16_t* A, const bf16_t* Bt, const int K, const Sched& S, const AMap& AM, const Epi& E, const Hook& HK) {
    const int tid = threadIdx.x, wid = __builtin_amdgcn_readfirstlane(tid >> 6), lane = tid & 63, wr = wid >> 2, wc = wid & 3, fr = lane & 15, fq = lane >> 4;
    const int nt = K / BK;
    int Rr[2], Cc[2]; unsigned voffB[2];
#pragma unroll
    for (int i = 0; i < 2; ++i) { stage_rc(tid * 16 + i * 8192, Rr[i], Cc[i]); const int Rb = Epi::PERM ? ((Rr[i] & ~31) + perm32(Rr[i] & 31)) : Rr[i]; voffB[i] = (unsigned)(Rb * K + Cc[i]) * 2u; }
    const size_t kstep = (size_t)(BK * 2);
    const size_t hstep = (size_t)HALF * K * 2;
    const size_t tstep = 2 * hstep;
    const unsigned ldsw = (unsigned)wid * 1024u;
    const int aoff = lds_byte(wr * 64 + fr, fq * 8), boff = lds_byte(wc * 32 + fr, fq * 8);
#define PG8_SA(b, h) (((b) * 2 + (h)) * HTB)
#define PG8_SB(b, h) ((4 + (b) * 2 + (h)) * HTB)
#define PG8_STAGE(bufoff, gbase, voff) do { _Pragma("unroll") for (int _i = 0; _i < 2; ++_i) \
        __builtin_amdgcn_global_load_lds((const unsigned*)((const char*)(gbase) + (voff)[_i]), (LAS unsigned*)(lds + (bufoff) + ldsw + _i * 8192), 16, 0, 0); } while (0)
#define PG8_LDA(dst, b, h) do { _Pragma("unroll") for (int m = 0; m < 4; ++m) _Pragma("unroll") for (int k = 0; k < 2; ++k) dst[m][k] = *(const LAS bf16x8*)(lds + PG8_SA(b, h) + aoff + m * 2048 + k * 1024); } while (0)
#define PG8_LDB(dst, b, h) do { _Pragma("unroll") for (int n = 0; n < 2; ++n) _Pragma("unroll") for (int k = 0; k < 2; ++k) dst[n][k] = *(const LAS bf16x8*)(lds + PG8_SB(b, h) + boff + n * 2048 + k * 1024); } while (0)
#define PG8_MMA(ai, bj, At, Bt_) do { __builtin_amdgcn_s_setprio(1); _Pragma("unroll") for (int m = 0; m < 4; ++m) _Pragma("unroll") for (int n = 0; n < 2; ++n) _Pragma("unroll") for (int k = 0; k < 2; ++k) \
        acc[ai][bj][m][n] = __builtin_amdgcn_mfma_f32_16x16x32_bf16(Bt_[n][k], At[m][k], acc[ai][bj][m][n], 0, 0, 0); __builtin_amdgcn_s_setprio(0); } while (0)
#define PG8_WAIT_V(n) asm volatile("s_waitcnt vmcnt(" #n ")" ::: "memory")
#define PG8_WAIT_L(n) asm volatile("s_waitcnt lgkmcnt(" #n ")" ::: "memory")
#define PG8_BAR __builtin_amdgcn_s_barrier()
#define PG8_SCHED __builtin_amdgcn_sched_barrier(0)
    Unit cur, nxt, nn; int ui = 0;
    if (!S.next(0, cur)) return;
    bool has_next = S.next(1, nxt);
    f32x4 acc[2][2][4][2];
#pragma unroll
    for (int a = 0; a < 2; ++a)
#pragma unroll
        for (int b = 0; b < 2; ++b)
#pragma unroll
            for (int m = 0; m < 4; ++m)
#pragma unroll
                for (int n = 0; n < 2; ++n) acc[a][b][m][n] = (f32x4){0.f, 0.f, 0.f, 0.f};
    bf16x8 At[4][2], B0[2][2], B1[2][2];
    unsigned vC[2][2];
    AM.prefetch(cur, lds, 0, wid, lane);
    if (has_next) AM.prefetch(nxt, lds, 1, wid, lane);
    asm volatile("s_waitcnt vmcnt(0)" ::: "memory"); __builtin_amdgcn_s_barrier(); asm volatile("" ::: "memory");
    AM.rows(cur, lds, 0, Rr, vC);
#pragma unroll
    for (int h = 0; h < 2; ++h)
#pragma unroll
        for (int i = 0; i < 2; ++i) vC[h][i] = (vC[h][i] * (unsigned)K + (unsigned)Cc[i]) * 2u;
    const char* const Ab = (const char*)A;
    const char* cB = (const char*)Bt + (size_t)cur.pn * tstep;
    PG8_STAGE(PG8_SB(0, 0), cB, voffB); PG8_STAGE(PG8_SB(0, 1), cB + hstep, voffB); PG8_STAGE(PG8_SA(0, 0), Ab, vC[0]); PG8_STAGE(PG8_SA(0, 1), Ab, vC[1]);
    if (wr == 1) PG8_BAR;
    PG8_WAIT_V(2); PG8_BAR;
    PG8_STAGE(PG8_SB(1, 0), cB + kstep, voffB); PG8_STAGE(PG8_SA(1, 0), Ab + kstep, vC[0]); PG8_STAGE(PG8_SB(1, 1), cB + hstep + kstep, voffB);
    PG8_WAIT_V(6); PG8_BAR;
    for (;;) {
        const bool has_nn = has_next ? S.next(ui + 2, nn) : false;
        if (has_nn) AM.prefetch(nn, lds, ui & 1, wid, lane);
        const char* nB = has_next ? (const char*)Bt + (size_t)nxt.pn * tstep : cB;
        for (int t = 0; t < nt; t += 2) {
            const bool last = (t == nt - 2);
            if (Hook::T >= 0) { if (t == Hook::T) HK(acc, cur, wr, wc, fr, fq); }
            const char* a1 = Ab + (size_t)(t + 1) * kstep;
            const char* a2 = last ? Ab : Ab + (size_t)(t + 2) * kstep; const char* b2 = last ? nB : cB + (size_t)(t + 2) * kstep;
            const char* a3 = a2 + kstep; const char* b3 = b2 + kstep;
            PG8_LDB(B0, 0, 0); PG8_LDB(B1, 0, 1); PG8_SCHED; PG8_LDA(At, 0, 0); PG8_STAGE(PG8_SA(1, 1), a1, vC[1]);
            if (last && has_next) {
                AM.rows(nxt, lds, (ui + 1) & 1, Rr, vC);
#pragma unroll
                for (int h = 0; h < 2; ++h)
#pragma unroll
                    for (int i = 0; i < 2; ++i) vC[h][i] = (vC[h][i] * (unsigned)K + (unsigned)Cc[i]) * 2u;
            }
            PG8_WAIT_V(8); PG8_WAIT_L(0); PG8_BAR; PG8_MMA(0, 0, At, B0); PG8_MMA(0, 1, At, B1); PG8_BAR; PG8_SCHED;
            PG8_LDA(At, 0, 1); PG8_STAGE(PG8_SB(0, 0), b2, voffB); PG8_STAGE(PG8_SB(0, 1), b2 + hstep, voffB); PG8_STAGE(PG8_SA(0, 0), a2, vC[0]);
            PG8_WAIT_V(8); PG8_WAIT_L(0); PG8_BAR; PG8_MMA(1, 0, At, B0); PG8_MMA(1, 1, At, B1); PG8_BAR; PG8_SCHED;
            PG8_LDB(B0, 1, 0); PG8_LDB(B1, 1, 1); PG8_SCHED; PG8_LDA(At, 1, 0); PG8_STAGE(PG8_SA(0, 1), a2, vC[1]);
            PG8_WAIT_V(8); PG8_WAIT_L(0); PG8_BAR; PG8_MMA(0, 0, At, B0); PG8_MMA(0, 1, At, B1); PG8_BAR; PG8_SCHED;
            PG8_LDA(At, 1, 1); PG8_STAGE(PG8_SB(1, 0), b3, voffB); PG8_STAGE(PG8_SB(1, 1), b3 + hstep, voffB); PG8_STAGE(PG8_SA(1, 0), a3, vC[0]);
            PG8_WAIT_V(8); PG8_WAIT_L(0); PG8_BAR; PG8_MMA(1, 0, At, B0); PG8_MMA(1, 1, At, B1); PG8_BAR; PG8_SCHED;
        }
        if (wr == 0) PG8_BAR;
        E(acc, cur, wr, wc, fr, fq);
        if (!has_next) break;
#pragma unroll
        for (int a = 0; a < 2; ++a)
#pragma unroll
            for (int b = 0; b < 2; ++b)
#pragma unroll
                for (int m = 0; m < 4; ++m)
#pragma unroll
                    for (int n = 0; n < 2; ++n) acc[a][b][m][n] = (f32x4){0.f, 0.f, 0.f, 0.f};
        cur = nxt; nxt = nn; has_next = has_nn; cB = nB; ++ui;
        if (wr == 1) PG8_BAR;
    }
    PG8_WAIT_V(0);
    PG8_BAR;
#undef PG8_SA
#undef PG8_SB
#undef PG8_STAGE
#undef PG8_LDA
#undef PG8_LDB
#undef PG8_MMA
#undef PG8_WAIT_V
#undef PG8_WAIT_L
#undef PG8_BAR
#undef PG8_SCHED
}
}
using pg8::Unit;

struct EpiInProj {
    static constexpr bool PERM = true;
    bf16_t *QA, *KA, *VAT, *QB, *KB, *VBT, *G; const float* cosT; const float* sinT;
    __device__ __forceinline__ void operator()(const f32x4 (&acc)[2][2][4][2], const Unit& u, int wr, int wc, int fr, int fq) const {
        const int pn = u.pn, row0 = u.pm * 256 + wr * 64 + fr;
        if (pn < 5 || (pn >= 6 && pn < 12)) {
            bf16_t* base; int ld, colt; float sc;
            if (pn < 4) { base = QA; ld = 1024; colt = pn * 256; sc = QSCALE; }
            else if (pn == 4) { base = KA; ld = 256; colt = 0; sc = 1.f; }
            else if (pn < 9) { base = QB; ld = 768; colt = (pn - 6) * 256; sc = QSCALE; }
            else { base = KB; ld = 768; colt = (pn - 9) * 256; sc = 1.f; }
            const int col = colt + 64 * wc + 8 * fq;
#pragma unroll
            for (int ai = 0; ai < 2; ++ai) {
                f32x4 cs[4][2], sn[4][2];
#pragma unroll
                for (int m = 0; m < 4; ++m) { const int pos = (row0 + ai * 128 + m * 16) & (SEQ - 1);
                    cs[m][0] = *(const f32x4*)(cosT + pos * 32 + 8 * fq); cs[m][1] = *(const f32x4*)(cosT + pos * 32 + 8 * fq + 4);
                    sn[m][0] = *(const f32x4*)(sinT + pos * 32 + 8 * fq); sn[m][1] = *(const f32x4*)(sinT + pos * 32 + 8 * fq + 4); }
                asm volatile("" ::: "memory");
#pragma unroll
                for (int m = 0; m < 4; ++m) {
                    const int row = row0 + ai * 128 + m * 16;
                    const f32x4 x10 = acc[ai][0][m][0], x11 = acc[ai][0][m][1], x20 = acc[ai][1][m][0], x21 = acc[ai][1][m][1];
                    const f32x4 o10 = (x10 * cs[m][0] - x20 * sn[m][0]) * sc, o11 = (x11 * cs[m][1] - x21 * sn[m][1]) * sc;
                    const f32x4 o20 = (x20 * cs[m][0] + x10 * sn[m][0]) * sc, o21 = (x21 * cs[m][1] + x11 * sn[m][1]) * sc;
                    u32x4 w1, w2;
                    w1.x = pk2(o10[0], o10[1]); w1.y = pk2(o10[2], o10[3]); w1.z = pk2(o11[0], o11[1]); w1.w = pk2(o11[2], o11[3]);
                    w2.x = pk2(o20[0], o20[1]); w2.y = pk2(o20[2], o20[3]); w2.z = pk2(o21[0], o21[1]); w2.w = pk2(o21[2], o21[3]);
                    bf16_t* rp = base + (size_t)row * ld + col;
                    *(u32x4*)rp = w1; *(u32x4*)(rp + 32) = w2;
                }
                asm volatile("" ::: "memory");
            }
        } else if (pn == 5 || (pn >= 12 && pn < 15)) {
            bf16_t* base; int ld, colt;
            if (pn == 5) { base = VAT; ld = 256; colt = 0; } else { base = VBT; ld = 768; colt = (pn - 12) * 256; }
            const int col = colt + wc * 32 + 8 * fq;
#pragma unroll
            for (int ai = 0; ai < 2; ++ai)
#pragma unroll
                for (int m = 0; m < 4; ++m) {
                    bf16_t* rp = base + (size_t)(row0 + ai * 128 + m * 16) * ld + col;
#pragma unroll
                    for (int bj = 0; bj < 2; ++bj) { const f32x4 v0 = acc[ai][bj][m][0], v1 = acc[ai][bj][m][1]; u32x4 w;
                        w.x = pk2(v0[0], v0[1]); w.y = pk2(v0[2], v0[3]); w.z = pk2(v1[0], v1[1]); w.w = pk2(v1[2], v1[3]);
                        *(u32x4*)(rp + bj * 128) = w; }
                }
        } else {
            const int col = (pn - 15) * 256 + wc * 32 + 8 * fq;
#pragma unroll
            for (int ai = 0; ai < 2; ++ai)
#pragma unroll
                for (int m = 0; m < 4; ++m) {
                    bf16_t* rp = G + (size_t)(row0 + ai * 128 + m * 16) * 2048 + col;
#pragma unroll
                    for (int bj = 0; bj < 2; ++bj) { const f32x4 v0 = acc[ai][bj][m][0], v1 = acc[ai][bj][m][1]; u32x4 w;
                        w.x = pk2(fast_sigmoid(v0[0]), fast_sigmoid(v0[1])); w.y = pk2(fast_sigmoid(v0[2]), fast_sigmoid(v0[3]));
                        w.z = pk2(fast_sigmoid(v1[0]), fast_sigmoid(v1[1])); w.w = pk2(fast_sigmoid(v1[2]), fast_sigmoid(v1[3]));
                        *(u32x4*)(rp + bj * 128) = w; }
                }
        }
    }
};
struct HookGateRatio {
    static constexpr int T = 16;
    const bf16_t* G;
    __device__ __forceinline__ void operator()(f32x4 (&acc)[2][2][4][2], const Unit& u, int wr, int wc, int fr, int fq) const {
        unsigned loff = (unsigned)((wr * 64 + fr) * 2048 + wc * 32 + 8 * fq) * 2u;
        asm volatile("" : "+v"(loff));
        const char* gbase = (const char*)G + ((size_t)u.pm * 256 * 2048 + (size_t)u.pn * 256) * 2;
#pragma unroll
        for (int ai = 0; ai < 2; ++ai) {
            u32x4 ga[4][2], gb[4][2];
#pragma unroll
            for (int m = 0; m < 4; ++m) { const bf16_t* rp = (const bf16_t*)(gbase + (size_t)(ai * 128 + m * 16) * 4096 + loff);
#pragma unroll
                for (int bj = 0; bj < 2; ++bj) { ga[m][bj] = *(const u32x4*)(rp + bj * 128); gb[m][bj] = *(const u32x4*)(rp + 1024 + bj * 128); } }
            asm volatile("" ::: "memory");
#pragma unroll
            for (int m = 0; m < 4; ++m)
#pragma unroll
                for (int bj = 0; bj < 2; ++bj) {
                    const u32x4 a = ga[m][bj], b = gb[m][bj];
                    f32x4 r0, r1;
                    r0[0] = bflo(a.x) * __builtin_amdgcn_rcpf(bflo(b.x)); r0[1] = bfhi(a.x) * __builtin_amdgcn_rcpf(bfhi(b.x));
                    r0[2] = bflo(a.y) * __builtin_amdgcn_rcpf(bflo(b.y)); r0[3] = bfhi(a.y) * __builtin_amdgcn_rcpf(bfhi(b.y));
                    r1[0] = bflo(a.z) * __builtin_amdgcn_rcpf(bflo(b.z)); r1[1] = bfhi(a.z) * __builtin_amdgcn_rcpf(bfhi(b.z));
                    r1[2] = bflo(a.w) * __builtin_amdgcn_rcpf(bflo(b.w)); r1[3] = bfhi(a.w) * __builtin_amdgcn_rcpf(bfhi(b.w));
                    acc[ai][bj][m][0] *= r0; acc[ai][bj][m][1] *= r1;
                }
            asm volatile("" ::: "memory");
        }
    }
};
struct EpiMerged {
    static constexpr bool PERM = true;
    const bf16_t* G; bf16_t* O;
    __device__ __forceinline__ void operator()(const f32x4 (&acc)[2][2][4][2], const Unit& u, int wr, int wc, int fr, int fq) const {
        const int row0 = u.pm * 256 + wr * 64 + fr, col = u.pn * 256 + wc * 32 + 8 * fq;
        u32x4 gb[2][4][2];
#pragma unroll
        for (int ai = 0; ai < 2; ++ai)
#pragma unroll
            for (int m = 0; m < 4; ++m)
#pragma unroll
                for (int bj = 0; bj < 2; ++bj) gb[ai][m][bj] = *(const u32x4*)(G + (size_t)(row0 + ai * 128 + m * 16) * 2048 + 1024 + col + bj * 128);
        asm volatile("" ::: "memory");
#pragma unroll
        for (int ai = 0; ai < 2; ++ai)
#pragma unroll
            for (int m = 0; m < 4; ++m) {
                const size_t r = (size_t)(row0 + ai * 128 + m * 16);
#pragma unroll
                for (int bj = 0; bj < 2; ++bj) {
                    const u32x4 g = gb[ai][m][bj];
                    const f32x4 v0 = acc[ai][bj][m][0], v1 = acc[ai][bj][m][1]; u32x4 w;
                    w.x = pk2(v0[0] * bflo(g.x), v0[1] * bfhi(g.x)); w.y = pk2(v0[2] * bflo(g.y), v0[3] * bfhi(g.y));
                    w.z = pk2(v1[0] * bflo(g.z), v1[1] * bfhi(g.z)); w.w = pk2(v1[2] * bflo(g.w), v1[3] * bfhi(g.w));
                    *(u32x4*)(O + r * 1024 + col + bj * 128) = w;
                }
            }
    }
};
struct EpiPre {
    static constexpr bool PERM = false;
    const float* X; float* O;
    __device__ __forceinline__ void operator()(const f32x4 (&acc)[2][2][4][2], const Unit& u, int wr, int wc, int fr, int fq) const {
        const int row0 = u.pm * 256 + wr * 64 + fr, col = u.pn * 256 + wc * 32 + 4 * fq;
#pragma unroll
        for (int ai = 0; ai < 2; ++ai) {
            f32x4 xv[4][2][2];
#pragma unroll
            for (int m = 0; m < 4; ++m) { const size_t off = (size_t)(row0 + ai * 128 + m * 16) * 1024 + col;
#pragma unroll
                for (int bj = 0; bj < 2; ++bj)
#pragma unroll
                    for (int n = 0; n < 2; ++n) xv[m][bj][n] = *(const f32x4*)(X + off + bj * 128 + n * 16); }
            asm volatile("" ::: "memory");
#pragma unroll
            for (int m = 0; m < 4; ++m) { const size_t off = (size_t)(row0 + ai * 128 + m * 16) * 1024 + col;
#pragma unroll
                for (int bj = 0; bj < 2; ++bj)
#pragma unroll
                    for (int n = 0; n < 2; ++n) *(f32x4*)(O + off + bj * 128 + n * 16) = xv[m][bj][n] * ALPHA + acc[ai][bj][m][n]; }
            asm volatile("" ::: "memory");
        }
    }
};
struct EpiSwiglu {
    static constexpr bool PERM = true;
    const float* bgu; bf16_t* Hh;
    __device__ __forceinline__ void operator()(const f32x4 (&acc)[2][2][4][2], const Unit& u, int wr, int wc, int fr, int fq) const {
        const int e = u.pn >> 3, j = u.pn & 7, row0 = u.pm * 256 + wr * 64 + fr, col = j * 128 + wc * 32 + 8 * fq;
        const float* bp = bgu + (size_t)e * 2048 + col;
        const f32x4 bg0 = *(const f32x4*)bp, bg1 = *(const f32x4*)(bp + 4), bu0 = *(const f32x4*)(bp + 1024), bu1 = *(const f32x4*)(bp + 1028);
#pragma unroll
        for (int ai = 0; ai < 2; ++ai)
#pragma unroll
            for (int m = 0; m < 4; ++m) {
                f32x4 g0 = acc[ai][0][m][0] + bg0, g1 = acc[ai][0][m][1] + bg1, u0 = acc[ai][1][m][0] + bu0, u1 = acc[ai][1][m][1] + bu1;
                float o[8];
#pragma unroll
                for (int q = 0; q < 4; ++q) {
                    float g = __builtin_fminf(g0[q], 7.f), up = __builtin_fminf(__builtin_fmaxf(u0[q], -7.f), 7.f); o[q] = (up + 1.f) * g * fast_sigmoid(1.702f * g);
                    g = __builtin_fminf(g1[q], 7.f); up = __builtin_fminf(__builtin_fmaxf(u1[q], -7.f), 7.f); o[4 + q] = (up + 1.f) * g * fast_sigmoid(1.702f * g);
                }
                u32x4 w; w.x = pk2(o[0], o[1]); w.y = pk2(o[2], o[3]); w.z = pk2(o[4], o[5]); w.w = pk2(o[6], o[7]);
                *(u32x4*)(Hh + (size_t)(row0 + ai * 128 + m * 16) * 1024 + col) = w;
            }
    }
};
struct EpiDown {
    static constexpr bool PERM = true;
    const float* bd; const int* dst; bf16_t* Y;
    __device__ __forceinline__ void operator()(const f32x4 (&acc)[2][2][4][2], const Unit& u, int wr, int wc, int fr, int fq) const {
        const int e = u.pn >> 2, j = u.pn & 3, row0 = u.pm * 256 + wr * 64 + fr, col = j * 256 + wc * 32 + 8 * fq;
        const float* bp = bd + (size_t)e * 1024 + col;
        f32x4 bv[2][2];
#pragma unroll
        for (int bj = 0; bj < 2; ++bj) { bv[bj][0] = *(const f32x4*)(bp + bj * 128); bv[bj][1] = *(const f32x4*)(bp + bj * 128 + 4); }
        int dd[2][4];
#pragma unroll
        for (int ai = 0; ai < 2; ++ai)
#pragma unroll
            for (int m = 0; m < 4; ++m) dd[ai][m] = dst[row0 + ai * 128 + m * 16];
        asm volatile("" ::: "memory");
#pragma unroll
        for (int ai = 0; ai < 2; ++ai)
#pragma unroll
            for (int m = 0; m < 4; ++m) {
                const int d = dd[ai][m];
                if (d >= 0) {
                    bf16_t* rp = Y + (size_t)d * 1024 + col;
#pragma unroll
                    for (int bj = 0; bj < 2; ++bj) { const f32x4 v0 = acc[ai][bj][m][0] + bv[bj][0], v1 = acc[ai][bj][m][1] + bv[bj][1]; u32x4 w;
                        w.x = pk2(v0[0], v0[1]); w.y = pk2(v0[2], v0[3]); w.z = pk2(v1[0], v1[1]); w.w = pk2(v1[2], v1[3]);
                        *(u32x4*)(rp + bj * 128) = w; }
                }
            }
    }
};

__device__ __forceinline__ int crow(int r, int hi) { return (r & 3) + 8 * (r >> 2) + 4 * hi; }
constexpr int AT_KROW = 144, AT_VROW = 128, AT_MAXT = 12;
constexpr int AT_KOFF = 0, AT_VOFF = AT_MAXT * 32 * AT_KROW;
static_assert(AT_VOFF + AT_MAXT * 32 * AT_VROW <= 131072, "attention LDS images fit the ring region");
struct AttnUnit {
    const bf16_t* q; const bf16_t* k; const bf16_t* v; bf16_t* o; float* lse;
    const float* sink;
    int qld, kvld, old, lseld, dil, qt0, NQ, NH, nback;
};
constexpr int AT_NUNITS = 6144;
__device__ __forceinline__ AttnUnit attn_decode(int id, bf16_t* QA, bf16_t* KA, bf16_t* VA, bf16_t* QB, bf16_t* KB, bf16_t* VB, bf16_t* OAB, bf16_t* OG, float* LSE, const float* sinks) {
    AttnUnit u;
    if (id < 2048) { const int kvh = id & 3, qb = (id >> 2) & 15, b = id >> 6; const size_t t0 = (size_t)b * SEQ;
        u.q = QA + t0 * 1024 + kvh * 256; u.k = KA + t0 * 256 + kvh * 64; u.v = VA + t0 * 256 + kvh * 64; u.o = OAB + t0 * 1280 + kvh * 256; u.lse = nullptr; u.sink = sinks + kvh * 4;
        u.qld = 1024; u.kvld = 256; u.old = 1280; u.lseld = 0; u.dil = 1; u.qt0 = 4 * qb; u.NQ = 4; u.NH = 4; u.nback = 127; return u; }
    id -= 2048; int head, res, b;
    if (id < 1024) { head = id & 3; u.qt0 = 8 * ((id >> 2) & 7); b = id >> 5; res = 0; u.dil = 1; u.NQ = 8; }
    else if (id < 2048) { id -= 1024; head = 4 + (id & 3); res = (id >> 2) & 3; u.qt0 = 8 * ((id >> 4) & 1); b = id >> 5; u.dil = 4; u.NQ = 8; }
    else { id -= 2048; head = 8 + (id & 3); res = (id >> 2) & 15; b = id >> 6; u.qt0 = 0; u.dil = 16; u.NQ = 4; }
    const size_t t0 = (size_t)b * SEQ + res;
    u.q = QB + t0 * 768 + head * 64; u.k = KB + t0 * 768 + head * 64; u.v = VB + t0 * 768 + head * 64; u.o = OG + t0 * 768 + head * 64; u.lse = LSE + t0 * 12 + head; u.sink = nullptr;
    u.qld = 768; u.kvld = 768; u.old = 768; u.lseld = 12; u.NH = 1; u.nback = 128; return u;
}
__device__ __forceinline__ void attn_prefetch(const AttnUnit& u, u32x4 (&pre)[AT_MAXT], int tid) {
    const int w0 = u.qt0 > 4 ? u.qt0 - 4 : 0, NK = u.qt0 + u.NQ - w0;
    const int part = tid & 15;
    const bf16_t* src = (part < 8 ? u.k : u.v) + (size_t)(32 * w0 + (tid >> 4)) * u.dil * u.kvld + (part & 7) * 8;
    const size_t step = (size_t)32 * u.dil * u.kvld;
#pragma unroll
    for (int j = 0; j < AT_MAXT; ++j) if (j < NK) pre[j] = *(const u32x4*)(src + j * step);
}
__device__ __forceinline__ void attn_stage(const AttnUnit& u, const u32x4 (&pre)[AT_MAXT], LAS unsigned char* lds, int tid) {
    const int w0 = u.qt0 > 4 ? u.qt0 - 4 : 0, NK = u.qt0 + u.NQ - w0;
    const int part = tid & 15, row0 = tid >> 4;
#pragma unroll
    for (int j = 0; j < AT_MAXT; ++j) if (j < NK) {
        const int row = row0 + 32 * j;
        if (part < 8) *(LAS u32x4*)(lds + AT_KOFF + row * AT_KROW + part * 16) = pre[j];
        else *(LAS u32x4*)(lds + AT_VOFF + row * AT_VROW + ((((part - 8) * 16)) ^ (((row >> 1) & 1) << 6))) = pre[j];
    }
}
typedef short v4i16_t __attribute__((ext_vector_type(4)));
__device__ __forceinline__ void attn_load_q(const AttnUnit& u, int t, int lane, bf16x8 (&qf)[4]) {
    const int qi = t / u.NH, hq = t - qi * u.NH;
    const bf16_t* qp = u.q + (size_t)(32 * (u.qt0 + qi) + (lane & 31)) * u.dil * u.qld + hq * 64 + 8 * (lane >> 5);
#pragma unroll
    for (int ds = 0; ds < 4; ++ds) qf[ds] = *(const bf16x8*)(qp + 16 * ds);
}
__device__ __forceinline__ void attn_compute(const AttnUnit& u, LAS unsigned char* lds, int wave, int lane, bf16x8 (&qf)[4]) {
    const int r = lane & 31, hi = lane >> 5, w0 = u.qt0 > 4 ? u.qt0 - 4 : 0;
    const int ntask = u.NQ * u.NH;
    const int q4 = (lane & 15) >> 2, p4 = lane & 3, blk = (lane >> 4) & 1;
    const int vlane = (4 * hi + q4) * AT_VROW + 32 * blk + 8 * p4, vsw = ((q4 >> 1) & 1) << 6;
    for (int t = wave; t < ntask; t += 8) {
        const int qi = t / u.NH, hq = t - qi * u.NH, qt = u.qt0 + qi, c0 = 32 * qt;
        const bool has_sink = u.sink != nullptr;
        float m = has_sink ? u.sink[hq] * LOG2E : -1e30f, l = (has_sink && hi == 0) ? 1.f : 0.f;
        f32x16 O0 = {}, O1 = {};
        const int kt0 = qt > 4 ? qt - 4 : 0, qpos = c0 + r;
        for (int kt = kt0; kt <= qt; ++kt) {
            const int ti = kt - w0;
            const LAS unsigned char* kp = lds + AT_KOFF + (ti * 32 + r) * AT_KROW + 16 * hi;
            bf16x8 kf[4];
#pragma unroll
            for (int ds = 0; ds < 4; ++ds) kf[ds] = *(const LAS bf16x8*)(kp + 32 * ds);
            const LAS unsigned char* vp = lds + AT_VOFF + ti * 32 * AT_VROW + vlane;
            s16x4 va[2][2][2];
#pragma unroll
            for (int dt = 0; dt < 2; ++dt)
#pragma unroll
                for (int sx = 0; sx < 2; ++sx)
#pragma unroll
                    for (int tx = 0; tx < 2; ++tx)
                        va[dt][sx][tx] = __builtin_bit_cast(s16x4, __builtin_amdgcn_ds_read_tr16_b64_v4i16((LAS v4i16_t*)(vp + (16 * sx + 8 * tx) * AT_VROW + ((64 * dt) ^ vsw))));
            f32x16 x = {};
#pragma unroll
            for (int ds = 0; ds < 4; ++ds) x = __builtin_amdgcn_mfma_f32_32x32x16_bf16(kf[ds], qf[ds], x, 0, 0, 0);
            if (kt == qt || kt == qt - 4) {
                const int kb = 32 * kt;
#pragma unroll
                for (int i = 0; i < 16; ++i) { const int dist = qpos - (kb + crow(i, hi)); if (dist < 0 || dist > u.nback) x[i] = -INFINITY; }
            }
            float mx = x[0];
#pragma unroll
            for (int i = 1; i < 16; ++i) mx = __builtin_fmaxf(mx, x[i]);
            mx = __builtin_fmaxf(mx, __shfl_xor(mx, 32));
            const float mnew = __builtin_fmaxf(m, mx), alpha = __builtin_amdgcn_exp2f(m - mnew);
            m = mnew;
            float ls = 0.f;
#pragma unroll
            for (int i = 0; i < 16; ++i) { x[i] = __builtin_amdgcn_exp2f(x[i] - mnew); ls += x[i]; }
            l = l * alpha + ls;
#pragma unroll
            for (int i = 0; i < 16; ++i) { O0[i] *= alpha; O1[i] *= alpha; }
            bf16x8 pf[2];
#pragma unroll
            for (int sx = 0; sx < 2; ++sx) { u32x4 p; p.x = pk2(x[8 * sx], x[8 * sx + 1]); p.y = pk2(x[8 * sx + 2], x[8 * sx + 3]); p.z = pk2(x[8 * sx + 4], x[8 * sx + 5]); p.w = pk2(x[8 * sx + 6], x[8 * sx + 7]); pf[sx] = __builtin_bit_cast(bf16x8, p); }
#pragma unroll
            for (int sx = 0; sx < 2; ++sx) {
                const bf16x8 v0 = __builtin_shufflevector(va[0][sx][0], va[0][sx][1], 0, 1, 2, 3, 4, 5, 6, 7), v1 = __builtin_shufflevector(va[1][sx][0], va[1][sx][1], 0, 1, 2, 3, 4, 5, 6, 7);
                O0 = __builtin_amdgcn_mfma_f32_32x32x16_bf16(v0, pf[sx], O0, 0, 0, 0);
                O1 = __builtin_amdgcn_mfma_f32_32x32x16_bf16(v1, pf[sx], O1, 0, 0, 0);
            }
        }
        bf16x8 qn[4];
        if (t + 8 < ntask) attn_load_q(u, t + 8, lane, qn);
        l += __shfl_xor(l, 32);
        const float inv = 1.0f / l;
        bf16_t* op = u.o + (size_t)(c0 + r) * u.dil * u.old + hq * 64 + 4 * hi;
#pragma unroll
        for (int g = 0; g < 4; ++g) {
            u32x2 w0_, w1_;
            w0_.x = pk2(O0[4 * g] * inv, O0[4 * g + 1] * inv); w0_.y = pk2(O0[4 * g + 2] * inv, O0[4 * g + 3] * inv);
            w1_.x = pk2(O1[4 * g] * inv, O1[4 * g + 1] * inv); w1_.y = pk2(O1[4 * g + 2] * inv, O1[4 * g + 3] * inv);
            *(u32x2*)(op + 8 * g) = w0_; *(u32x2*)(op + 32 + 8 * g) = w1_;
        }
        if (u.lse && hi == 0) u.lse[(size_t)(c0 + r) * u.dil * u.lseld] = m + __builtin_amdgcn_logf(l);
        if (t + 8 < ntask) {
#pragma unroll
            for (int ds = 0; ds < 4; ++ds) qf[ds] = qn[ds];
        }
    }
}

struct Args { const float* in[16]; float* out; unsigned char* ws; int ph_lo, ph_hi, li, pad; };
constexpr int NPHASE = 12;

__device__ __forceinline__ void p0_transpose_item(const float* W, int N, int k0, int n0, bf16_t* WT, size_t ldo, size_t orow0, size_t ocol0, LAS float* scr, int lane) {
#pragma unroll 8
    for (int i = 0; i < 32; ++i) { const int kk = 2 * i + (lane >> 5); scr[kk * 33 + (lane & 31)] = W[(size_t)(k0 + kk) * N + n0 + (lane & 31)]; }
    LDS_WAIT(); asm volatile("" ::: "memory");
    const int c = lane & 7;
#pragma unroll
    for (int j = 0; j < 4; ++j) { const int n = (lane >> 3) + 8 * j; const LAS float* s = scr + (8 * c) * 33 + n;
        u32x4 o; o.x = pk2(s[0 * 33], s[1 * 33]); o.y = pk2(s[2 * 33], s[3 * 33]); o.z = pk2(s[4 * 33], s[5 * 33]); o.w = pk2(s[6 * 33], s[7 * 33]);
        *(u32x4*)(WT + (orow0 + n) * ldo + ocol0 + 8 * c) = o; }
    LDS_WAIT(); asm volatile("" ::: "memory");
}

__global__ void __launch_bounds__(512, 2) mk_fwd(Args args) {
    extern __shared__ __attribute__((aligned(16))) unsigned char lds_raw[];
    LAS unsigned char* lds = (LAS unsigned char*)lds_raw;
    volatile LAS unsigned* MISC = (volatile LAS unsigned*)(lds + MISC_OFF);
    const int tid = threadIdx.x, lane = tid & 63, wave = __builtin_amdgcn_readfirstlane(tid >> 6);
    const int G = gridDim.x, bx = blockIdx.x;
    const int gw = bx * 8 + wave, NGW = G * 8;
    unsigned char* const ws = args.ws;
    unsigned* const ctl = (unsigned*)(ws + WS_CTL);
#define X_IN     (args.in[0])
#define w_in     (args.in[1])
#define sinks    (args.in[2])
#define w_ba     (args.in[3])
#define w_bb     (args.in[4])
#define w_out    (args.in[5])
#define ln1g     (args.in[6])
#define ln1b     (args.in[7])
#define w_router (args.in[8])
#define b_router (args.in[9])
#define w_gu     (args.in[10])
#define b_gu     (args.in[11])
#define w_dn     (args.in[12])
#define b_dn     (args.in[13])
#define ln2g     (args.in[14])
#define ln2b     (args.in[15])
#define OUTP     (args.out)
#define cosT   ((float*)(ws + WS_COS))
#define sinT   ((float*)(ws + WS_SIN))
#define WIN    ((bf16_t*)(ws + WS_WIN))
#define WAB    ((bf16_t*)(ws + WS_WAB))
#define WOUT   ((bf16_t*)(ws + WS_WOUT))
#define WGU    ((bf16_t*)(ws + WS_WGU))
#define WDN    ((bf16_t*)(ws + WS_WDN))
#define TOPE   ((int*)(ws + WS_TOPE))
#define TOPW   ((float*)(ws + WS_TOPW))
#define HIST   ((int*)(ws + WS_HIST))
#define ROWTOK ((int*)(ws + WS_ROWTOK))
#define ROWDST ((int*)(ws + WS_ROWDST))
#define TILEE  ((int*)(ws + WS_TILEE))
#define OAB    ((bf16_t*)(ws + WS_OAB))
#define XB     ((bf16_t*)(ws + WS_XB))
#define H1     ((bf16_t*)(ws + WS_H1))
#define Gt     ((bf16_t*)(ws + WS_G))
#define KB     ((bf16_t*)(ws + WS_KB))
#define VAT    ((bf16_t*)(ws + WS_VAT))
#define VBT    ((bf16_t*)(ws + WS_VBT))
#define OG     ((bf16_t*)(ws + WS_OG))
#define LSE    ((float*)(ws + WS_LSE))
#define MERGED ((bf16_t*)(ws + WS_MERGED))
#define Hh     ((bf16_t*)(ws + WS_H))
#define Y      ((bf16_t*)(ws + WS_Y))
#define QA     ((bf16_t*)((unsigned char*)args.out + DO_QA))
#define QB     ((bf16_t*)((unsigned char*)args.out + DO_QB))
#define KA     ((bf16_t*)((unsigned char*)args.out + DO_KA))

    for (int u = tid; u < (LDS_BYTES - LDSCTL_OFF) / 4; u += 512) ((LAS unsigned*)(lds + LDSCTL_OFF))[u] = 0u;
    __syncthreads();
    XcdBarrier bar; bar.bar = ctl + CW_BAR + args.li * XCD_BAR_WORDS; bar.x = 0; bar.st = nullptr;
    if (MK_ONE_LAUNCH) bar = xcd_barrier_post(ctl + CW_BAR + args.li * XCD_BAR_WORDS, MISC + 8);
    const int lo = args.ph_lo, hi = args.ph_hi;
#ifndef PH_MASK
#define PH_MASK 0xFFFF
#endif
#define IN(k) (((PH_MASK >> (k)) & 1) && lo <= (k) && (k) < hi)
#define SEAM(k) do { if (IN(k) && IN((k) + 1)) xcd_barrier(bar); } while (0)
#ifndef REPEAT_MASK
#define REPEAT_MASK 0
#endif
#define REPN(k) ((((REPEAT_MASK) >> (k)) & 1) ? 2 : 1)
#define REP_LOOP(k) for (int rep_ = 0; rep_ < REPN(k); ++rep_)
#define REP_SYNC() do { if (rep_) xcd_barrier(bar); } while (0)

    if (IN(0)) { REP_LOOP(0) { REP_SYNC();
        LAS float* scr = (LAS float*)(lds + wave * 16384);
        constexpr int I_IN = 16 * 184, I_BA = 16 * 32, I_BB = 4 * 32, I_OUT = 16 * 32, I_GU = 32 * 16 * 64, I_DN = 32 * 16 * 32;
        constexpr int NITEMS = I_IN + I_BA + I_BB + I_OUT + I_GU + I_DN;
        for (int it = gw; it < NITEMS; it += NGW) {
            int r = it;
            if (r < I_IN) { const int kb = r / 184, nb = r % 184, n0 = 32 * nb, tile = n0 >> 8, within = n0 & 255;
                const bool rope = tile < 5 || (tile >= 6 && tile < 12);
                const int orow = rope ? tile * 256 + 128 * ((within & 63) >> 5) + 32 * (within >> 6) : n0;
                p0_transpose_item(w_in, INW, 64 * kb, n0, WIN, 1024, orow, 64 * kb, scr, lane); continue; } r -= I_IN;
            if (r < I_BA) { const int kb = r / 32, nb = r % 32; p0_transpose_item(w_ba, 1024, 64 * kb, 32 * nb, WAB, 1280, 32 * nb, 64 * kb, scr, lane); continue; } r -= I_BA;
            if (r < I_BB) { const int kb = r / 32, nb = r % 32; p0_transpose_item(w_bb, 1024, 64 * kb, 32 * nb, WAB, 1280, 32 * nb, 1024 + 64 * kb, scr, lane); continue; } r -= I_BB;
            if (r < I_OUT) { const int kb = r / 32, nb = r % 32; p0_transpose_item(w_out, 1024, 64 * kb, 32 * nb, WOUT, 1024, 32 * nb, 64 * kb, scr, lane); continue; } r -= I_OUT;
            if (r < I_GU) { const int e = r / 1024, q = r % 1024, kb = q / 64, nb = q % 64, n0 = 32 * nb, np = n0 & 1023;
                const int orow = e * 2048 + (np >> 7) * 256 + (n0 >= 1024 ? 128 : 0) + (np & 127);
                p0_transpose_item(w_gu + (size_t)e * 1024 * 2048, 2048, 64 * kb, n0, WGU, 1024, orow, 64 * kb, scr, lane); continue; } r -= I_GU;
            { const int e = r / 512, q = r % 512, kb = q / 32, nb = q % 32;
                p0_transpose_item(w_dn + (size_t)e * 1024 * 1024, 1024, 64 * kb, 32 * nb, WDN, 1024, e * 1024 + 32 * nb, 64 * kb, scr, lane); }
        }
        for (size_t i = (size_t)bx * 512 + tid; i < (size_t)T * D / 8; i += (size_t)G * 512) {
            const f32x4 a = *(const f32x4*)(X_IN + i * 8), b = *(const f32x4*)(X_IN + i * 8 + 4);
            u32x4 w; w.x = pk2(a[0], a[1]); w.y = pk2(a[2], a[3]); w.z = pk2(b[0], b[1]); w.w = pk2(b[2], b[3]);
            *(u32x4*)(XB + i * 8) = w;
        }
        for (int i = bx * 512 + tid; i < SEQ * 32; i += G * 512) {
            const int pos = i >> 5, f = i & 31;
            const double invf = exp2(-(double)f * (13.287712379549449 / 32.0));
            const double ang = (double)pos * invf;
            cosT[i] = (float)cos(ang); sinT[i] = (float)sin(ang);
        }
    }
    }
    SEAM(0);

    if (IN(1)) { REP_LOOP(1) { REP_SYNC();
        pg8::StaticOrder S; S.init(T, INW, G, bx);
        EpiInProj E{QA, KA, VAT, QB, KB, VBT, Gt, cosT, sinT};
        pg8::gemm_phase(lds, XB, WIN, 1024, S, pg8::ADense{}, E, pg8::NoHook{});
    }
    }
    SEAM(1);

    if (IN(2)) { REP_LOOP(2) { REP_SYNC();
        u32x4 pre[AT_MAXT];
        AttnUnit cu = attn_decode(bx, QA, KA, VAT, QB, KB, VBT, OAB, OG, LSE, sinks);
        if (bx < AT_NUNITS) attn_prefetch(cu, pre, tid);
        for (int id = bx; id < AT_NUNITS; id += G) {
            attn_stage(cu, pre, lds, tid);
            LDS_WAIT(); __builtin_amdgcn_s_barrier(); asm volatile("" ::: "memory");
            const AttnUnit me = cu;
            bf16x8 qf[4];
            if (wave < me.NQ * me.NH) attn_load_q(me, wave, lane, qf);
            if (id + G < AT_NUNITS) { cu = attn_decode(id + G, QA, KA, VAT, QB, KB, VBT, OAB, OG, LSE, sinks); attn_prefetch(cu, pre, tid); }
            attn_compute(me, lds, wave, lane, qf);
            LDS_WAIT(); __builtin_amdgcn_s_barrier(); asm volatile("" ::: "memory");
        }
    } }
    SEAM(2);

    if (IN(3)) { REP_LOOP(3) { REP_SYNC();
        for (size_t i = (size_t)bx * 512 + tid; i < (size_t)T * 32; i += (size_t)G * 512) {
            const size_t tok = i >> 5; const int hh = (int)(i >> 3) & 3, ch = (int)i & 7;
            const float l0 = LSE[tok * 12 + hh], l1 = LSE[tok * 12 + 4 + hh], l2 = LSE[tok * 12 + 8 + hh];
            const float mx = __builtin_fmaxf(l0, __builtin_fmaxf(l1, l2));
            float w0 = __builtin_amdgcn_exp2f(l0 - mx), w1 = __builtin_amdgcn_exp2f(l1 - mx), w2 = __builtin_amdgcn_exp2f(l2 - mx);
            const float inv = 1.0f / (w0 + w1 + w2); w0 *= inv; w1 *= inv; w2 *= inv;
            const u32x4 a = *(const u32x4*)(OG + tok * 768 + hh * 64 + ch * 8), c = *(const u32x4*)(OG + tok * 768 + (4 + hh) * 64 + ch * 8), d = *(const u32x4*)(OG + tok * 768 + (8 + hh) * 64 + ch * 8);
            u32x4 w;
            w.x = pk2(w0 * bflo(a.x) + w1 * bflo(c.x) + w2 * bflo(d.x), w0 * bfhi(a.x) + w1 * bfhi(c.x) + w2 * bfhi(d.x));
            w.y = pk2(w0 * bflo(a.y) + w1 * bflo(c.y) + w2 * bflo(d.y), w0 * bfhi(a.y) + w1 * bfhi(c.y) + w2 * bfhi(d.y));
            w.z = pk2(w0 * bflo(a.z) + w1 * bflo(c.z) + w2 * bflo(d.z), w0 * bfhi(a.z) + w1 * bfhi(c.z) + w2 * bfhi(d.z));
            w.w = pk2(w0 * bflo(a.w) + w1 * bflo(c.w) + w2 * bflo(d.w), w0 * bfhi(a.w) + w1 * bfhi(c.w) + w2 * bfhi(d.w));
            *(u32x4*)(OAB + tok * 1280 + 1024 + hh * 64 + ch * 8) = w;
        }
        xcd_barrier(bar);
        pg8::StaticOrder S; S.init(T, 1024, G, bx);
        EpiMerged E{Gt, MERGED}; HookGateRatio HK{Gt};
        pg8::gemm_phase(lds, OAB, WAB, 1280, S, pg8::ADense{}, E, HK);
    }
    }
    SEAM(3);

    if (IN(4)) { REP_LOOP(4) { REP_SYNC();
        pg8::StaticOrder S; S.init(T, 1024, G, bx);
        EpiPre E{X_IN, OUTP};
        pg8::gemm_phase(lds, MERGED, WOUT, 1024, S, pg8::ADense{}, E, pg8::NoHook{});
    }
    }
    SEAM(4);

    if (IN(5)) { REP_LOOP(5) { REP_SYNC();
        constexpr int GWROW = 2064;
        LAS unsigned char* GWH = lds; LAS unsigned char* GWL = lds + 32 * GWROW;
        LAS float* gws = (LAS float*)(lds + SCR_OFF); LAS float* bws = gws + 32; LAS int* histL = (LAS int*)(bws + 32); LAS float* partL = (LAS float*)(histL + 32);
        for (int idx = tid; idx < 32 * 1024; idx += 512) { const int d = idx >> 5, e = idx & 31;
            const float v = w_router[idx] * ln1g[d]; const unsigned hb = pk2(v, 0.f) & 0xffffu; const float vh = __uint_as_float(hb << 16); const unsigned lb = pk2(v - vh, 0.f) & 0xffffu;
            ((LAS bf16_t*)(GWH + e * GWROW))[d] = (bf16_t)hb; ((LAS bf16_t*)(GWL + e * GWROW))[d] = (bf16_t)lb; }
        { const int e = tid & 31, p = tid >> 5; float sg = 0.f, sb = 0.f;
          for (int d = 64 * p; d < 64 * p + 64; ++d) { const float w = w_router[d * 32 + e]; sg += ln1g[d] * w; sb += ln1b[d] * w; }
          partL[(p * 32 + e) * 2] = sg; partL[(p * 32 + e) * 2 + 1] = sb; }
        __syncthreads();
        if (tid < 32) { float sg = 0.f, sb = 0.f; for (int p = 0; p < 16; ++p) { sg += partL[(p * 32 + tid) * 2]; sb += partL[(p * 32 + tid) * 2 + 1]; } gws[tid] = sg; bws[tid] = sb + b_router[tid]; }
        __syncthreads();
        const int r32 = lane & 31, hi5 = lane >> 5;
        for (int vw = bx; vw < 256; vw += G) {
            if (tid < 32) histL[tid] = 0;
            __syncthreads();
            const int tok0 = vw * 256 + wave * 32;
            const float* src = OUTP + (size_t)(tok0 + r32) * 1024 + 8 * hi5;
            const LAS unsigned char* ahp = GWH + r32 * GWROW + 16 * hi5; const LAS unsigned char* alp = GWL + r32 * GWROW + 16 * hi5;
            f32x16 acc0 = {}, acc1 = {}, acc2 = {};
            float s1 = 0.f, s2 = 0.f;
            f32x4 xa[4][2], xb[4][2];
#define P5_LOAD(buf, ks0) do { _Pragma("unroll") for (int q_ = 0; q_ < 4; ++q_) { buf[q_][0] = *(const f32x4*)(src + 16 * ((ks0) + q_)); buf[q_][1] = *(const f32x4*)(src + 16 * ((ks0) + q_) + 4); } } while (0)
#define P5_COMP(buf, ks0) do { _Pragma("unroll") for (int q_ = 0; q_ < 4; ++q_) { const f32x4 u0_ = buf[q_][0], u1_ = buf[q_][1]; \
                s1 += (u0_[0] + u0_[1]) + (u0_[2] + u0_[3]) + (u1_[0] + u1_[1]) + (u1_[2] + u1_[3]); \
                s2 += (u0_[0] * u0_[0] + u0_[1] * u0_[1]) + (u0_[2] * u0_[2] + u0_[3] * u0_[3]) + (u1_[0] * u1_[0] + u1_[1] * u1_[1]) + (u1_[2] * u1_[2] + u1_[3] * u1_[3]); \
                u32x4 wh_, wl_; wh_.x = pk2(u0_[0], u0_[1]); wh_.y = pk2(u0_[2], u0_[3]); wh_.z = pk2(u1_[0], u1_[1]); wh_.w = pk2(u1_[2], u1_[3]); \
                wl_.x = pk2(u0_[0] - bflo(wh_.x), u0_[1] - bfhi(wh_.x)); wl_.y = pk2(u0_[2] - bflo(wh_.y), u0_[3] - bfhi(wh_.y)); \
                wl_.z = pk2(u1_[0] - bflo(wh_.z), u1_[1] - bfhi(wh_.z)); wl_.w = pk2(u1_[2] - bflo(wh_.w), u1_[3] - bfhi(wh_.w)); \
                const bf16x8 bh_ = __builtin_bit_cast(bf16x8, wh_), bl_ = __builtin_bit_cast(bf16x8, wl_); \
                const bf16x8 ah_ = *(const LAS bf16x8*)(ahp + 32 * ((ks0) + q_)), al_ = *(const LAS bf16x8*)(alp + 32 * ((ks0) + q_)); \
                acc0 = __builtin_amdgcn_mfma_f32_32x32x16_bf16(ah_, bh_, acc0, 0, 0, 0); acc1 = __builtin_amdgcn_mfma_f32_32x32x16_bf16(ah_, bl_, acc1, 0, 0, 0); \
                acc2 = __builtin_amdgcn_mfma_f32_32x32x16_bf16(al_, bh_, acc2, 0, 0, 0); } } while (0)
            P5_LOAD(xa, 0);
            for (int it = 0; it < 8; ++it) {
                P5_LOAD(xb, 8 * it + 4);
                P5_COMP(xa, 8 * it);
                if (it < 7) P5_LOAD(xa, 8 * it + 8);
                P5_COMP(xb, 8 * it + 4);
            }
#undef P5_LOAD
#undef P5_COMP
            s1 += __shfl_xor(s1, 32); s2 += __shfl_xor(s2, 32);
            const float mean = s1 * (1.f / 1024.f), var = __builtin_fmaxf(s2 * (1.f / 1024.f) - mean * mean, 0.f), rstd = 1.0f / sqrtf(var + LN_EPS);
            float v[16];
#pragma unroll
            for (int i = 0; i < 16; ++i) v[i] = rstd * ((acc0[i] + acc1[i] + acc2[i]) - mean * gws[crow(i, hi5)]) + bws[crow(i, hi5)];
            float cv[8]; int ce[8];
#pragma unroll
            for (int kk = 0; kk < 4; ++kk) {
                float bv = v[0]; int bi = 0;
#pragma unroll
                for (int i = 1; i < 16; ++i) if (v[i] > bv) { bv = v[i]; bi = i; }
                cv[kk] = bv; ce[kk] = crow(bi, hi5);
#pragma unroll
                for (int i = 0; i < 16; ++i) v[i] = (i == bi) ? -INFINITY : v[i];
            }
#pragma unroll
            for (int kk = 0; kk < 4; ++kk) { cv[4 + kk] = __shfl_xor(cv[kk], 32); ce[4 + kk] = __shfl_xor(ce[kk], 32); }
            float tv[4]; int te[4];
#pragma unroll
            for (int kk = 0; kk < 4; ++kk) {
                float bv = cv[0]; int be = ce[0], bi = 0;
#pragma unroll
                for (int i = 1; i < 8; ++i) if (cv[i] > bv || (cv[i] == bv && ce[i] < be)) { bv = cv[i]; be = ce[i]; bi = i; }
                tv[kk] = bv; te[kk] = be;
#pragma unroll
                for (int i = 0; i < 8; ++i) cv[i] = (i == bi) ? -INFINITY : cv[i];
            }
            { const float e1 = __expf(tv[1] - tv[0]), e2 = __expf(tv[2] - tv[0]), e3 = __expf(tv[3] - tv[0]); const float inv = 1.0f / (1.0f + e1 + e2 + e3);
              if (hi5 == 0) { const size_t tk = (size_t)(tok0 + r32) * 4;
                  *(int4*)(TOPE + tk) = make_int4(te[0], te[1], te[2], te[3]); *(f32x4*)(TOPW + tk) = (f32x4){inv, e1 * inv, e2 * inv, e3 * inv};
                  atomicAdd((int*)(histL + te[0]), 1); atomicAdd((int*)(histL + te[1]), 1); atomicAdd((int*)(histL + te[2]), 1); atomicAdd((int*)(histL + te[3]), 1); } }
            f32x4 gg[4], bb[4];
#pragma unroll
            for (int j = 0; j < 4; ++j) { gg[j] = *(const f32x4*)(ln1g + 4 * lane + 256 * j); bb[j] = *(const f32x4*)(ln1b + 4 * lane + 256 * j); }
#pragma unroll 4
            for (int i = 0; i < 32; ++i) {
                const float mi = __uint_as_float(__builtin_amdgcn_readlane(__float_as_uint(mean), i)), ri = __uint_as_float(__builtin_amdgcn_readlane(__float_as_uint(rstd), i));
                const float* pp = OUTP + (size_t)(tok0 + i) * 1024 + 4 * lane; bf16_t* hp = H1 + (size_t)(tok0 + i) * 1024 + 4 * lane;
#pragma unroll
                for (int j = 0; j < 4; ++j) { const f32x4 xv = (*(const f32x4*)(pp + 256 * j) - mi) * ri * gg[j] + bb[j]; u32x2 w; w.x = pk2(xv[0], xv[1]); w.y = pk2(xv[2], xv[3]); *(u32x2*)(hp + 256 * j) = w; }
            }
            __syncthreads();
            if (tid < 32) HIST[vw * 32 + tid] = histL[tid];
            __syncthreads();
        }
    } }
    SEAM(5);

    if (IN(6)) { REP_LOOP(6) { REP_SYNC();
        LAS int* part = (LAS int*)(lds + SCR_OFF);
        LAS int* cntL = part + 512; LAS int* befL = cntL + 32; LAS int* tstL = befL + 32; LAS int* baseL = tstL + 40; LAS int* curL = baseL + 32;
        for (int vw = bx; vw < 256; vw += G) {
            const int hf = vw >> 7, wl = vw & 127;
            { const int e = tid & 31, p = tid >> 5; int s = 0;
              for (int i = 0; i < 8; ++i) s += HIST[(128 * hf + 8 * p + i) * 32 + e];
              part[p * 32 + e] = s; }
            __syncthreads();
            if (tid < 32) { int tot = 0, bef = 0; const int pw = wl >> 3, iw = wl & 7;
                for (int p = 0; p < 16; ++p) { const int v = part[p * 32 + tid]; tot += v; if (p < pw) bef += v; }
                for (int i = 0; i < iw; ++i) bef += HIST[(128 * hf + 8 * pw + i) * 32 + tid];
                cntL[tid] = tot; befL[tid] = bef; curL[tid] = 0; }
            __syncthreads();
            if (tid == 0) { int run = 0; for (int e = 0; e < 32; ++e) { tstL[e] = run; run += (cntL[e] + 255) >> 8; } tstL[32] = run; }
            __syncthreads();
            if (tid < 32) baseL[tid] = tstL[tid] * 256 + befL[tid];
            __syncthreads();
            int* rt = ROWTOK + (size_t)hf * HROWS; int* rd = ROWDST + (size_t)hf * HROWS;
            for (int idx = tid; idx < 1024; idx += 512) {
                const int tok = vw * 256 + (idx >> 2), kk = idx & 3, e = TOPE[(size_t)tok * 4 + kk];
                const int pos = baseL[e] + atomicAdd((int*)(curL + e), 1);
                rt[pos] = tok; rd[pos] = (tok - hf * HALF_T) * 4 + kk;
            }
            if (wl < 32) { const int e = wl, r0 = tstL[e] * 256 + cntL[e], r1 = tstL[e + 1] * 256;
                for (int r = r0 + tid; r < r1; r += 512) { rt[r] = hf * HALF_T; rd[r] = -1; } }
            if (wl == 32) { int* te = TILEE + hf * 1024; const int nt = tstL[32];
                for (int t = tid; t < nt; t += 512) { int e = 0; for (int q = 1; q < 32; ++q) if (t >= tstL[q]) e = q; te[t] = e; }
                if (tid == 0) te[1000] = nt; }
            __syncthreads();
        }
    }
    }
    SEAM(6);

#pragma unroll
    for (int hf = 0; hf < 2; ++hf) {
        const int p_gu = 7 + 2 * hf, p_dn = 8 + 2 * hf, p_cb = 9 + 2 * hf;
        const int* te = TILEE + hf * 1024; const int* rt = ROWTOK + (size_t)hf * HROWS; const int* rd = ROWDST + (size_t)hf * HROWS;
        if (IN(p_gu)) { REP_LOOP(p_gu) { REP_SYNC();
            const int NT = te[1000];
            LAS int* teL = (LAS int*)(lds + SCR_OFF);
            for (int t = tid; t < NT; t += 512) teL[t] = te[t];
            __syncthreads();
            pg8::MoeOrder S; S.init(teL, NT, 8, G, bx);
            EpiSwiglu E{b_gu, Hh};
            pg8::gemm_phase(lds, H1, WGU, 1024, S, pg8::AGather{rt}, E, pg8::NoHook{});
        } }
        SEAM(p_gu);
        if (IN(p_dn)) { REP_LOOP(p_dn) { REP_SYNC();
            const int NT = te[1000];
            LAS int* teL = (LAS int*)(lds + SCR_OFF);
            for (int t = tid; t < NT; t += 512) teL[t] = te[t];
            __syncthreads();
            pg8::MoeOrder S; S.init(teL, NT, 4, G, bx);
            EpiDown E{b_dn, rd, Y};
            pg8::gemm_phase(lds, Hh, WDN, 1024, S, pg8::ADense{}, E, pg8::NoHook{});
        } }
        SEAM(p_dn);
        if (IN(p_cb)) { REP_LOOP(p_cb + 3) { REP_SYNC();
            f32x4 g2[4], b2[4];
#pragma unroll
            for (int j = 0; j < 2; ++j) { g2[2 * j] = *(const f32x4*)(ln2g + 8 * lane + 512 * j); g2[2 * j + 1] = *(const f32x4*)(ln2g + 8 * lane + 512 * j + 4);
                b2[2 * j] = *(const f32x4*)(ln2b + 8 * lane + 512 * j); b2[2 * j + 1] = *(const f32x4*)(ln2b + 8 * lane + 512 * j + 4); }
            for (int tl = gw; tl < HALF_T; tl += NGW) {
                const int tok = hf * HALF_T + tl;
                const f32x4 wv = *(const f32x4*)(TOPW + (size_t)tok * 4);
                f32x4 v[4]; float s = 0.f;
#pragma unroll
                for (int j = 0; j < 2; ++j) {
                    const int c = 8 * lane + 512 * j;
                    const u32x4 hh = *(const u32x4*)(H1 + (size_t)tok * 1024 + c);
                    f32x4 a = (f32x4){bflo(hh.x), bfhi(hh.x), bflo(hh.y), bfhi(hh.y)} * ALPHA, b = (f32x4){bflo(hh.z), bfhi(hh.z), bflo(hh.w), bfhi(hh.w)} * ALPHA;
#pragma unroll
                    for (int kk = 0; kk < 4; ++kk) { const u32x4 yy = *(const u32x4*)(Y + ((size_t)tl * 4 + kk) * 1024 + c); const float w = wv[kk];
                        a += (f32x4){bflo(yy.x), bfhi(yy.x), bflo(yy.y), bfhi(yy.y)} * w; b += (f32x4){bflo(yy.z), bfhi(yy.z), bflo(yy.w), bfhi(yy.w)} * w; }
                    v[2 * j] = a; v[2 * j + 1] = b; s += (a[0] + a[1]) + (a[2] + a[3]) + (b[0] + b[1]) + (b[2] + b[3]);
                }
                const float mean = wave_sum(s) * (1.f / 1024.f); float s2 = 0.f;
#pragma unroll
                for (int j = 0; j < 4; ++j) { v[j] = v[j] - mean; s2 += (v[j][0] * v[j][0] + v[j][1] * v[j][1]) + (v[j][2] * v[j][2] + v[j][3] * v[j][3]); }
                const float rstd = 1.0f / sqrtf(wave_sum(s2) * (1.f / 1024.f) + LN_EPS);
                float* op = OUTP + (size_t)tok * 1024 + 8 * lane;
#pragma unroll
                for (int j = 0; j < 2; ++j) { *(f32x4*)(op + 512 * j) = v[2 * j] * rstd * g2[2 * j] + b2[2 * j]; *(f32x4*)(op + 512 * j + 4) = v[2 * j + 1] * rstd * g2[2 * j + 1] + b2[2 * j + 1]; }
            }
        } }
    }
#undef IN
#undef SEAM
}

extern "C" void kernel_launch(void* const* d_in, const int* in_sizes, int n_in, void* d_out, int out_size, void* d_ws, size_t ws_size, hipStream_t stream) {
    static int grid = 0;
    if (grid == 0) {
        if (n_in != 16 || in_sizes[0] != T * D || out_size != T * D || ws_size < WS_END) { fprintf(stderr, "kernel_launch: unexpected shapes / workspace (%d inputs, ws %zu)\n", n_in, ws_size); grid = -1; return; }
        int dev = 0, cus = 0, per_cu = 0;
        if (hipGetDevice(&dev) != hipSuccess || hipDeviceGetAttribute(&cus, hipDeviceAttributeMultiprocessorCount, dev) != hipSuccess) { grid = -1; return; }
        if (hipFuncSetAttribute((const void*)mk_fwd, hipFuncAttributeMaxDynamicSharedMemorySize, LDS_BYTES) != hipSuccess) { fprintf(stderr, "kernel_launch: hipFuncSetAttribute failed\n"); grid = -1; return; }
        if (hipOccupancyMaxActiveBlocksPerMultiprocessor(&per_cu, (const void*)mk_fwd, 512, LDS_BYTES) != hipSuccess || per_cu < 1) { fprintf(stderr, "kernel_launch: occupancy query says %d\n", per_cu); }
        (void)hipGetLastError();
        grid = cus;
    }
    if (grid < 0) return;
    if (hipMemsetAsync((char*)d_ws + WS_CTL, 0, CTL_ZERO_BYTES, stream) != hipSuccess) return;
    Args a{};
    for (int i = 0; i < 16; ++i) a.in[i] = (const float*)d_in[i];
    a.out = (float*)d_out; a.ws = (unsigned char*)d_ws;
#if MK_ONE_LAUNCH && defined(PROBE_SPLIT)
    a.ph_lo = 0; a.ph_hi = PROBE_SPLIT + 1; a.li = 0;
    hipLaunchKernelGGL(mk_fwd, dim3(grid), dim3(512), LDS_BYTES, stream, a);
    a.ph_lo = PROBE_SPLIT; a.ph_hi = NPHASE; a.li = 1;
    hipLaunchKernelGGL(mk_fwd, dim3(grid), dim3(512), LDS_BYTES, stream, a);
#elif MK_ONE_LAUNCH
    a.ph_lo = 0; a.ph_hi = NPHASE;
    hipLaunchKernelGGL(mk_fwd, dim3(grid), dim3(512), LDS_BYTES, stream, a);
#else
    for (int p = 0; p < NPHASE; ++p) { a.ph_lo = p; a.ph_hi = p + 1; hipLaunchKernelGGL(mk_fwd, dim3(grid), dim3(512), LDS_BYTES, stream, a); }
#endif
}
```

```cpp
#include <hip/hip_runtime.h>
#include <cstdio>
#include <cstdint>

#ifndef MK_ONE_LAUNCH
#define MK_ONE_LAUNCH 1
#endif
#ifndef P5_SINGLE
#define PRE16 1
#define P5_SINGLE 1
#endif
#ifndef QKV_FP8
#define QKV_FP8 1
#endif
#ifndef P3_FP8
#define P3_FP8 1
#endif
#ifndef G_FP8
#define G_FP8 1
#endif
#ifndef Y_FP8
#define Y_FP8 1
#endif
#ifndef P4_FP8
#define P4_FP8 1
#endif
#ifndef P1_FP8
#define P1_FP8 1
#endif

#define LAS __attribute__((address_space(3)))
#define GAS __attribute__((address_space(1)))
typedef unsigned short bf16_t;
typedef short bf16x8 __attribute__((ext_vector_type(8)));
typedef short s16x4 __attribute__((ext_vector_type(4)));
typedef float f32x4 __attribute__((ext_vector_type(4)));
typedef float f32x2 __attribute__((ext_vector_type(2)));
typedef float f32x16 __attribute__((ext_vector_type(16)));
typedef unsigned u32x4 __attribute__((ext_vector_type(4)));
typedef unsigned u32x2 __attribute__((ext_vector_type(2)));
typedef __bf16 bf16x2_t __attribute__((ext_vector_type(2)));
typedef int v4i32_t __attribute__((ext_vector_type(4)));
typedef int v8i32_t __attribute__((ext_vector_type(8)));

constexpr int SEQ = 2048, NB = 32, T = NB * SEQ, D = 1024, INW = 5888, NE = 32, TOPK = 4;
constexpr float LN_EPS = 1e-5f;
constexpr float ALPHA = 1.189207115002721f;
constexpr float LOG2E = 1.4426950408889634f;
constexpr float QSCALE = 0.125f * LOG2E;
constexpr float W8_SCALE = 32.0f, W8_INV = 1.0f / 32.0f, MG_SCALE = 16.0f, MG_INV = 1.0f / 16.0f, OA_SCALE = 16.0f, OA_INV = 1.0f / 16.0f;
#ifndef NHALF
#define NHALF 1
#endif
constexpr int HALF_T = T / NHALF;
constexpr int HROWS = HALF_T * TOPK + NE * 256;
constexpr int HTILES = HROWS / 256;

constexpr size_t MiB = 1u << 20;
constexpr size_t WS_CTL = 0, CTL_ZERO_BYTES = 1 * MiB;
constexpr size_t WS_COS = 1 * MiB;
constexpr size_t WS_WIN = 2 * MiB;
constexpr size_t WS_WAB = 14 * MiB;
constexpr size_t WS_WOUT = 17 * MiB;
constexpr size_t WS_TOPE = 19 * MiB, WS_TOPW = 20 * MiB, WS_HIST = 21 * MiB;
constexpr size_t WS_ROWTOK = 22 * MiB, WS_ROWDST = 24 * MiB, WS_TILEE = 26 * MiB;
constexpr size_t WS_WGU = 32 * MiB;
constexpr size_t WS_WDN = 96 * MiB;
constexpr size_t WS_H1F8 = 352 * MiB;
constexpr size_t WS_OAB = 224 * MiB;
constexpr size_t WS_XB = 224 * MiB;
constexpr size_t WS_H1 = 224 * MiB;
constexpr size_t WS_G = 384 * MiB;
constexpr size_t WS_KB = 640 * MiB;
constexpr size_t WS_VAT = 736 * MiB;
constexpr size_t WS_VBT = 768 * MiB;
constexpr size_t WS_OG = 864 * MiB;
constexpr size_t WS_STATS = 964 * MiB;
constexpr size_t WS_LSE = 960 * MiB;
constexpr size_t WS_MERGED = 640 * MiB;
constexpr size_t WS_H = 416 * MiB;
constexpr size_t WS_Y = 680 * MiB;
constexpr size_t WS_MR = 973 * MiB;
constexpr size_t WS_END = 1024 * MiB;
static_assert(WS_H1F8 + (size_t)T * 1024 <= WS_H && WS_H + (size_t)HROWS * 1024 <= WS_Y && WS_Y + ((size_t)HALF_T * 4 + 1) * 1024 * 2 <= WS_END + (size_t)HALF_T * 4 * 1024, "ws map");
static_assert(WS_Y + ((size_t)HALF_T * 4 + 1) * 1024 <= WS_END && (size_t)NHALF * HROWS * 4 <= 2 * MiB && HTILES * 4 + 256 <= 8192, "ws / LDS tables");
static_assert(WS_LSE + (size_t)T * 12 * 4 <= WS_END && WS_OG + (size_t)T * 768 * 2 <= WS_LSE && WS_VBT + (size_t)T * 768 * 2 <= WS_OG, "ws map");
constexpr size_t DO_QA = 0, DO_QB = 128 * MiB, DO_KA = 224 * MiB;

constexpr int CW_TMO = 0, CW_CODE = 1, CW_BAR = 4096;

constexpr int RING_BYTES = 131072;
constexpr int LDSCTL_OFF = 135168, MISC_OFF = LDSCTL_OFF + 320, SCR_OFF = LDSCTL_OFF + 1024;
constexpr int LDS_BYTES = 151552;

#define RLX_AGENT __ATOMIC_RELAXED, __HIP_MEMORY_SCOPE_AGENT
#define LDS_WAIT() asm volatile("s_waitcnt lgkmcnt(0)" ::: "memory")
#define VM_WAIT() asm volatile("s_waitcnt vmcnt(0)" ::: "memory")
__device__ __forceinline__ unsigned pk2(float lo, float hi) { f32x2 v = {lo, hi}; bf16x2_t b = __builtin_convertvector(v, bf16x2_t); return __builtin_bit_cast(unsigned, b); }
__device__ __forceinline__ unsigned pk4_fp8(float a, float b, float c, float d) { int w = __builtin_amdgcn_cvt_pk_fp8_f32(a, b, 0, false); w = __builtin_amdgcn_cvt_pk_fp8_f32(c, d, w, true); return (unsigned)w; }
__device__ __forceinline__ f32x4 fp8x4_f32(unsigned w) { const f32x2 lo = __builtin_amdgcn_cvt_pk_f32_fp8((int)w, false), hi = __builtin_amdgcn_cvt_pk_f32_fp8((int)w, true); return (f32x4){lo[0], lo[1], hi[0], hi[1]}; }
__device__ __forceinline__ float bflo(unsigned w) { return __uint_as_float(w << 16); }
__device__ __forceinline__ float bfhi(unsigned w) { return __uint_as_float(w & 0xffff0000u); }
__device__ __forceinline__ float fast_sigmoid(float z) { return __builtin_amdgcn_rcpf(1.0f + __builtin_amdgcn_exp2f(-z * LOG2E)); }
__device__ __forceinline__ float wave_sum(float v) {
#pragma unroll
    for (int o = 1; o < 64; o <<= 1) v += __shfl_xor(v, o);
    return v;
}

#define XB_TMO      128
#define XB_XCNT(j)  (256  + 64 * (j))
#define XB_XSUB(j)  (1280 + 64 * (j))
#define XB_XGEN(j)  (2304 + 64 * (j))
#define XB_TOP      3328
#define XB_TOPGEN   3392
#define XCD_BAR_WORDS 3456
#define XB_SPIN_CAP (1u << 18)
__device__ __forceinline__ unsigned xb_ld(unsigned* p)              { return __hip_atomic_load(p, __ATOMIC_RELAXED, __HIP_MEMORY_SCOPE_AGENT); }
__device__ __forceinline__ unsigned xb_add(unsigned* p, unsigned v) { return __hip_atomic_fetch_add(p, v, __ATOMIC_RELAXED, __HIP_MEMORY_SCOPE_AGENT); }
__device__ __forceinline__ unsigned xb_xcc_id() { return (unsigned)__builtin_amdgcn_s_getreg((3 << 11) | 20) & 0xFu; }
#define XB_SPIN(cond, bar) do { unsigned _sp = 0; while (cond) { __builtin_amdgcn_s_sleep(1); \
    if ((++_sp & 255u) == 0u) { if (xb_ld(&(bar)[XB_TMO])) break; if (_sp > XB_SPIN_CAP) { atomicAdd(&(bar)[XB_TMO], 1u); break; } } } } while (0)
struct XcdBarrier { unsigned* bar; unsigned x; volatile LAS unsigned* st; };
__device__ __forceinline__ XcdBarrier xcd_barrier_post(unsigned* bar, volatile LAS unsigned* st) {
    XcdBarrier b; b.bar = bar; b.x = xb_xcc_id(); b.st = st;
    if (threadIdx.x == 0) (void)xb_add(&bar[XB_XCNT(b.x)], 1u);
    return b;
}
__device__ __forceinline__ void xcd_barrier_complete(unsigned* bar, unsigned x, unsigned& nloc, unsigned& nx) {
    const unsigned G = gridDim.x * gridDim.y * gridDim.z;
    unsigned sum, cnt, mine, sp = 0u;
    for (;;) {
        sum = 0u; cnt = 0u; mine = 0u;
#pragma unroll
        for (unsigned j = 0; j < 16; ++j) { const unsigned c = xb_ld(&bar[XB_XCNT(j)]); sum += c; cnt += (c > 0u) ? 1u : 0u; mine = (j == x) ? c : mine; }
        if (sum == G) break;
        __builtin_amdgcn_s_sleep(1);
        if ((++sp & 255u) == 0u) { if (xb_ld(&bar[XB_TMO])) break; if (sp > XB_SPIN_CAP) { atomicAdd(&bar[XB_TMO], 1u); break; } }
    }
    nloc = mine > 0u ? mine : 1u; nx = cnt > 0u ? cnt : 1u;
}
__device__ __forceinline__ void xcd_barrier(const XcdBarrier& b) {
    asm volatile("s_waitcnt vmcnt(0)" ::: "memory");
    __syncthreads();
    if (threadIdx.x == 0) {
        unsigned* bar = b.bar;
        __builtin_amdgcn_s_waitcnt(0);
        unsigned nloc = b.st[0], nx = b.st[1];
        if (nloc == 0u) { xcd_barrier_complete(bar, b.x, nloc, nx); b.st[0] = nloc; b.st[1] = nx; }
        const unsigned old = xb_add(&bar[XB_XSUB(b.x)], 1u);
        const unsigned gen = old / nloc;
        if (old + 1u == (gen + 1u) * nloc) {
            __builtin_amdgcn_fence(__ATOMIC_RELEASE, "agent");
            asm volatile("s_waitcnt vmcnt(0)" ::: "memory");
            const unsigned og = xb_add(&bar[XB_TOP], 1u);
            const unsigned tg = og / nx;
            if (og + 1u == (tg + 1u) * nx) xb_add(&bar[XB_TOPGEN], 1u);
            else XB_SPIN(xb_ld(&bar[XB_TOPGEN]) == tg, bar);
            __builtin_amdgcn_fence(__ATOMIC_ACQUIRE, "agent");
            xb_add(&bar[XB_XGEN(b.x)], 1u);
            asm volatile("s_waitcnt vmcnt(0)" ::: "memory");
        } else {
            XB_SPIN(xb_ld(&bar[XB_XGEN(b.x)]) == gen, bar);
            __builtin_amdgcn_fence(__ATOMIC_ACQUIRE, "agent");
            asm volatile("s_waitcnt vmcnt(0)" ::: "memory");
        }
    }
    __syncthreads();
}

namespace pg8 {
constexpr int BM = 256, BK = 64, HALF = 128, HTB = HALF * BK * 2, STAGE_BYTES = 8 * HTB, NXCD = 8;
__host__ __device__ __forceinline__ int lds_byte(int r, int c) { const int st = (r >> 4) * 2 + (c >> 5), rr = r & 15, cc = c & 31, ob = rr * 64 + cc * 2; return st * 1024 + (ob ^ (((ob >> 9) & 1) << 5)); }
__host__ __device__ __forceinline__ void stage_rc(int b, int& R, int& C) { const int st = b / 1024, sb = b % 1024, swz = sb ^ (((sb >> 9) & 1) << 5); R = (st >> 1) * 16 + swz / 64; C = (st & 1) * 32 + (swz % 64) / 2; }
__host__ __device__ __forceinline__ int perm32(int rho) { const int n = rho >> 4, i = rho & 15; return 8 * (i >> 2) + 4 * n + (i & 3); }

struct Unit { int pm, pn; };

struct StaticOrder {
    int nM, nN, nwg, G, c, WGM;
    __device__ void init(int M, int N, int G_, int c_, int wgm = 8) { nM = M / BM; nN = N / BM; nwg = nM * nN; G = G_; c = c_; WGM = wgm; }
    __device__ bool next(int i, Unit& u) const {
        const long L = (long)i * G + c; if (L >= nwg) return false;
        int wgid = (int)L; { const int q = nwg / NXCD, r = nwg % NXCD, xcd = wgid % NXCD, off = wgid / NXCD; wgid = (xcd < r ? xcd * (q + 1) : r * (q + 1) + (xcd - r) * q) + off; }
        const int nig = WGM * nN, gid = wgid / nig, fm = gid * WGM, gsz = (nM - fm) < WGM ? (nM - fm) : WGM;
        u.pm = fm + ((wgid % nig) % gsz); u.pn = (wgid % nig) / gsz; return true;
    }
};
struct MoeOrder {
    const LAS int* tile_e; int NJ, W, r, t0, t1;
    __device__ void init(const LAS int* te, int NT, int NJ_, int G, int c) {
        tile_e = te; NJ = NJ_;
        if (G % 8 == 0) { const int x = c % 8; r = c / 8; W = G / 8; t0 = (int)((long)NT * x / 8); t1 = (int)((long)NT * (x + 1) / 8); }
        else { r = c; W = G; t0 = 0; t1 = NT; }
    }
    __device__ bool next(int i, Unit& u) const {
        const int idx = i * W + r, ntl = t1 - t0; if (idx >= ntl * NJ) return false;
        const int GT = 32 / NJ, per = GT * NJ, grp = idx / per, rem = idx - grp * per, gsz = (ntl - grp * GT) < GT ? (ntl - grp * GT) : GT;
        const int tile = t0 + grp * GT + rem % gsz, j = rem / gsz;
        u.pm = tile; u.pn = tile_e[tile] * NJ + j; return true;
    }
};
constexpr int TOKL_OFF = 135168 + 1024 + 8192;
struct ADense {
    __device__ __forceinline__ void prefetch(const Unit&, LAS unsigned char*, int, int, int) const {}
    __device__ __forceinline__ void rows(const Unit& u, LAS unsigned char*, int, const int (&R)[2], unsigned (&vr)[2][2]) const {
#pragma unroll
        for (int h = 0; h < 2; ++h)
#pragma unroll
            for (int i = 0; i < 2; ++i) vr[h][i] = (unsigned)(u.pm * BM + h * HALF + R[i]);
    }
};
struct AGather {
    const int* tok;
    __device__ __forceinline__ void prefetch(const Unit& u, LAS unsigned char* ldsb, int par, int wid, int lane) const {
        if (wid < 4) __builtin_amdgcn_global_load_lds((const unsigned*)(tok + u.pm * BM + wid * 64 + lane), (LAS unsigned*)(ldsb + TOKL_OFF + par * 1024 + wid * 256), 4, 0, 0);
    }
    __device__ __forceinline__ void rows(const Unit&, LAS unsigned char* ldsb, int par, const int (&R)[2], unsigned (&vr)[2][2]) const {
        const LAS unsigned* t = (const LAS unsigned*)(ldsb + TOKL_OFF + par * 1024);
#pragma unroll
        for (int h = 0; h < 2; ++h)
#pragma unroll
            for (int i = 0; i < 2; ++i) vr[h][i] = t[h * HALF + R[i]];
    }
};
struct NoHook { static constexpr int T = -1; __device__ __forceinline__ void operator()(f32x4 (&)[2][2][4][2], const Unit&, int, int, int, int) const {} };

template <class Epi, class Sched, class AMap, class Hook>
__device__ __forceinline__ void gemm_phase(LAS unsigned char* lds, const bf16_t* A, const bf16_t* Bt, const int K, const Sched& S, const AMap& AM, const Epi& E, const Hook& HK) {
    int tid = threadIdx.x; asm volatile("" : "+v"(tid));
    const int wid = __builtin_amdgcn_readfirstlane(tid >> 6), lane = tid & 63, wr = wid >> 2, wc = wid & 3, fr = lane & 15, fq = lane >> 4;
    const int nt = K / BK;
    int Rr[2], Cc[2]; unsigned voffB[2];
#pragma unroll
    for (int i = 0; i < 2; ++i) { stage_rc(tid * 16 + i * 8192, Rr[i], Cc[i]); const int rho = Epi::PERM ? perm32(Rr[i] & 31) : (Rr[i] & 31);
        const int Rb = (Epi::COLMAP == 2) ? 64 * (Rr[i] >> 5) + rho : (Rr[i] & ~31) + rho; voffB[i] = (unsigned)(Rb * K + Cc[i]) * 2u; }
    const size_t bhalf = (Epi::COLMAP == 2) ? (size_t)32 * K * 2 : (size_t)HALF * K * 2;
    const size_t kstep = (size_t)(BK * 2);
    const size_t hstep = (size_t)HALF * K * 2;
    const size_t tstep = 2 * hstep;
    const unsigned ldsw = (unsigned)wid * 1024u;
    constexpr bool F8 = Epi::FP8; constexpr int KSTR = F8 ? 16 : 1024;
    const int fcol = F8 ? 32 * (fq >> 1) + 16 * (fq & 1) : fq * 8;
    const int aoff = lds_byte(wr * 64 + fr, fcol), boff = lds_byte(wc * 32 + fr, fcol);
#define PG8_SA(b, h) (((b) * 2 + (h)) * HTB)
#define PG8_SB(b, h) ((4 + (b) * 2 + (h)) * HTB)
#define PG8_STAGE(bufoff, gbase, voff) do { _Pragma("unroll") for (int _i = 0; _i < 2; ++_i) \
        __builtin_amdgcn_global_load_lds((const unsigned*)((const char*)(gbase) + (voff)[_i]), (LAS unsigned*)(lds + (bufoff) + ldsw + _i * 8192), 16, 0, 0); } while (0)
#define PG8_LD2(base_) __builtin_shufflevector(*(const LAS v4i32_t*)(base_), *(const LAS v4i32_t*)((base_) + KSTR), 0, 1, 2, 3, 4, 5, 6, 7)
#define PG8_LDA(dst, b, h) do { _Pragma("unroll") for (int m = 0; m < 4; ++m) dst[m] = PG8_LD2(lds + PG8_SA(b, h) + aoff + m * 2048); } while (0)
#define PG8_LDB(dst, b, h) do { _Pragma("unroll") for (int n = 0; n < 2; ++n) dst[n] = PG8_LD2(lds + PG8_SB(b, h) + boff + n * 2048); } while (0)
#define PG8_HALF(x, k) __builtin_bit_cast(bf16x8, __builtin_shufflevector(x, x, 4 * (k), 4 * (k) + 1, 4 * (k) + 2, 4 * (k) + 3))
#define PG8_MMA(ai, bj, At, Bt_) do { __builtin_amdgcn_s_setprio(1); _Pragma("unroll") for (int m = 0; m < 4; ++m) _Pragma("unroll") for (int n = 0; n < 2; ++n) { \
        if constexpr (F8) acc[ai][bj][m][n] = __builtin_amdgcn_mfma_scale_f32_16x16x128_f8f6f4(Bt_[n], At[m], acc[ai][bj][m][n], 0, 0, 0, 0, 0, 0);     \
        else { acc[ai][bj][m][n] = __builtin_amdgcn_mfma_f32_16x16x32_bf16(PG8_HALF(Bt_[n], 0), PG8_HALF(At[m], 0), acc[ai][bj][m][n], 0, 0, 0); \
               acc[ai][bj][m][n] = __builtin_amdgcn_mfma_f32_16x16x32_bf16(PG8_HALF(Bt_[n], 1), PG8_HALF(At[m], 1), acc[ai][bj][m][n], 0, 0, 0); } } \
        __builtin_amdgcn_s_setprio(0); } while (0)
#define PG8_WAIT_V(n) asm volatile("s_waitcnt vmcnt(" #n ")" ::: "memory")
#define PG8_WAIT_L(n) asm volatile("s_waitcnt lgkmcnt(" #n ")" ::: "memory")
#define PG8_BAR __builtin_amdgcn_s_barrier()
#define PG8_SCHED __builtin_amdgcn_sched_barrier(0)
    Unit cur, nxt, nn; int ui = 0;
    if (!S.next(0, cur)) return;
    bool has_next = S.next(1, nxt);
    f32x4 acc[2][2][4][2];
#pragma unroll
    for (int a = 0; a < 2; ++a)
#pragma unroll
        for (int b = 0; b < 2; ++b)
#pragma unroll
            for (int m = 0; m < 4; ++m)
#pragma unroll
                for (int n = 0; n < 2; ++n) acc[a][b][m][n] = (f32x4){0.f, 0.f, 0.f, 0.f};
    v8i32_t At[4], B0[2], B1[2];
    unsigned vC[2][2];
    AM.prefetch(cur, lds, 0, wid, lane);
    if (has_next) AM.prefetch(nxt, lds, 1, wid, lane);
    asm volatile("s_waitcnt vmcnt(0)" ::: "memory"); __builtin_amdgcn_s_barrier(); asm volatile("" ::: "memory");
    AM.rows(cur, lds, 0, Rr, vC);
#pragma unroll
    for (int h = 0; h < 2; ++h)
#pragma unroll
        for (int i = 0; i < 2; ++i) vC[h][i] = (vC[h][i] * (unsigned)K + (unsigned)Cc[i]) * 2u;
    const char* const Ab = (const char*)A;
    const char* cB = (const char*)Bt + (size_t)cur.pn * tstep;
    PG8_STAGE(PG8_SB(0, 0), cB, voffB); PG8_STAGE(PG8_SB(0, 1), cB + bhalf, voffB); PG8_STAGE(PG8_SA(0, 0), Ab, vC[0]); PG8_STAGE(PG8_SA(0, 1), Ab, vC[1]);
    if (wr == 1) PG8_BAR;
    PG8_WAIT_V(2); PG8_BAR;
    PG8_STAGE(PG8_SB(1, 0), cB + kstep, voffB); PG8_STAGE(PG8_SA(1, 0), Ab + kstep, vC[0]); PG8_STAGE(PG8_SB(1, 1), cB + bhalf + kstep, voffB);
    PG8_WAIT_V(0); PG8_BAR;
    for (;;) {
        const bool has_nn = has_next ? S.next(ui + 2, nn) : false;
        if (has_nn) AM.prefetch(nn, lds, ui & 1, wid, lane);
        const char* nB = has_next ? (const char*)Bt + (size_t)nxt.pn * tstep : cB;
#ifdef KLOOP_PROBE
        const unsigned long long kp_t0 = __builtin_amdgcn_s_memtime();
#endif
#define PG8_TRIP(WV) do {   \
            const bool last = (t == nt - 2); \
            if (Hook::T >= 0) { if (t == Hook::T) HK(acc, cur, wr, wc, fr, fq); } \
            const char* a1 = Ab + (size_t)(t + 1) * kstep; \
            const char* a2 = last ? Ab : Ab + (size_t)(t + 2) * kstep; const char* b2 = last ? nB : cB + (size_t)(t + 2) * kstep; \
            const char* a3 = a2 + kstep; const char* b3 = b2 + kstep; \
              \
            PG8_LDB(B0, 0, 0); PG8_LDB(B1, 0, 1); PG8_SCHED; PG8_LDA(At, 0, 0); PG8_STAGE(PG8_SA(1, 1), a1, vC[1]); \
            if (last && has_next) {                         \
                int tq = tid; asm volatile("" : "+v"(tq));           \
                int R2[2], C2[2]; _Pragma("unroll") for (int i = 0; i < 2; ++i) stage_rc(tq * 16 + i * 8192, R2[i], C2[i]); \
                AM.rows(nxt, lds, (ui + 1) & 1, R2, vC); \
                _Pragma("unroll") for (int h = 0; h < 2; ++h) _Pragma("unroll") for (int i = 0; i < 2; ++i) vC[h][i] = (vC[h][i] * (unsigned)K + (unsigned)C2[i]) * 2u; \
            } \
            if (nowait == 0) PG8_WAIT_V(8); \
            PG8_WAIT_L(0); PG8_BAR; PG8_MMA(0, 0, At, B0); PG8_MMA(0, 1, At, B1); PG8_BAR; PG8_SCHED; \
              \
            PG8_LDA(At, 0, 1); PG8_STAGE(PG8_SB(0, 0), b2, voffB); PG8_STAGE(PG8_SB(0, 1), b2 + bhalf, voffB); PG8_STAGE(PG8_SA(0, 0), a2, vC[0]); \
            if (nowait == 0) PG8_WAIT_V(8); \
            asm volatile("s_mov_b32 %0, 0" : "=s"(nowait)); \
            PG8_WAIT_L(0); PG8_BAR; PG8_MMA(1, 0, At, B0); PG8_MMA(1, 1, At, B1); PG8_BAR; PG8_SCHED; \
              \
            PG8_LDB(B0, 1, 0); PG8_LDB(B1, 1, 1); PG8_SCHED; PG8_LDA(At, 1, 0); PG8_STAGE(PG8_SA(0, 1), a2, vC[1]); \
            PG8_WAIT_V(8); PG8_WAIT_L(0); PG8_BAR; PG8_MMA(0, 0, At, B0); PG8_MMA(0, 1, At, B1); PG8_BAR; PG8_SCHED; \
              \
            PG8_LDA(At, 1, 1); PG8_STAGE(PG8_SB(1, 0), b3, voffB); PG8_STAGE(PG8_SB(1, 1), b3 + bhalf, voffB); PG8_STAGE(PG8_SA(1, 0), a3, vC[0]); \
            PG8_WAIT_V(8); PG8_WAIT_L(0); PG8_BAR; PG8_MMA(1, 0, At, B0); PG8_MMA(1, 1, At, B1); PG8_BAR; PG8_SCHED; \
        } while (0)
        int nowait; asm volatile("s_mov_b32 %0, 1" : "=s"(nowait));
#pragma unroll 1
        for (int t = 0; t < nt; t += 2) { PG8_TRIP(8); }
#undef PG8_TRIP
#ifdef KLOOP_PROBE
        if (blockIdx.x == 0 && tid == 0) { volatile LAS unsigned* kp = (volatile LAS unsigned*)(lds + 135168 + 320 + 64); if (kp[1]) kp[0] += (unsigned)((__builtin_amdgcn_s_memtime() - kp_t0) >> 4); }
#endif
        if (wr == 0) PG8_BAR;
        PG8_WAIT_V(0);
#ifdef EPI_PROBE
        const unsigned long long ep_t0 = __builtin_amdgcn_s_memtime();
#endif
        E(acc, cur, wr, wc, fr, fq);
#ifdef EPI_PROBE
        if (blockIdx.x == 0 && tid == 0) { volatile LAS unsigned* kp = (volatile LAS unsigned*)(lds + 135168 + 320 + 64); if (kp[1]) kp[0] += (unsigned)((__builtin_amdgcn_s_memtime() - ep_t0) >> 4); }
#endif
        if (!has_next) break;
#pragma unroll
        for (int a = 0; a < 2; ++a)
#pragma unroll
            for (int b = 0; b < 2; ++b)
#pragma unroll
                for (int m = 0; m < 4; ++m)
#pragma unroll
                    for (int n = 0; n < 2; ++n) acc[a][b][m][n] = (f32x4){0.f, 0.f, 0.f, 0.f};
        cur = nxt; nxt = nn; has_next = has_nn; cB = nB; ++ui;
        if (wr == 1) PG8_BAR;
    }
    PG8_WAIT_V(0);
    PG8_BAR;
#undef PG8_SA
#undef PG8_SB
#undef PG8_STAGE
#undef PG8_LDA
#undef PG8_LDB
#undef PG8_MMA
#undef PG8_HALF
#undef PG8_LD2
#undef PG8_WAIT_V
#undef PG8_WAIT_L
#undef PG8_BAR
#undef PG8_SCHED
}
}
using pg8::Unit;

#if G_FP8
typedef u32x2 gate8_t;
constexpr int GATE_B = 1;
__device__ __forceinline__ void gate_unpack(const gate8_t g, f32x4& lo, f32x4& hi) { lo = fp8x4_f32(g.x); hi = fp8x4_f32(g.y); }
#else
typedef u32x4 gate8_t;
constexpr int GATE_B = 2;
__device__ __forceinline__ void gate_unpack(const gate8_t g, f32x4& lo, f32x4& hi) { lo = (f32x4){bflo(g.x), bfhi(g.x), bflo(g.y), bfhi(g.y)}; hi = (f32x4){bflo(g.z), bfhi(g.z), bflo(g.w), bfhi(g.w)}; }
#endif
#define GATE_LD(G_, row_, col_) (*(const gate8_t*)((const unsigned char*)(G_) + ((size_t)(row_) * 2048 + (col_)) * GATE_B))
#if G_FP8
__device__ __forceinline__ int gate_pair_ofs(int fq) { return (fq & 1) ? 24 + 8 * fq : 8 * fq; }
#define GFRAG_OFS(row16_, span_, fq_, fr_) ((((size_t)(row16_) * 32 + (span_)) * 1024) + (size_t)(gate_pair_ofs(fq_) >> 4) * 256 + (size_t)(fr_) * 16)
__device__ __forceinline__ void gate_ld_pair(const unsigned char* p, u32x4& L) { L = *(const u32x4*)p; }
__device__ __forceinline__ void gate_unswap(const u32x4 L, gate8_t& g0, gate8_t& g1) {
    const auto sx = __builtin_amdgcn_permlane16_swap(L.x, L.z, false, false), sy = __builtin_amdgcn_permlane16_swap(L.y, L.w, false, false);
    g0.x = sx[0]; g0.y = sy[0]; g1.x = sx[1]; g1.y = sy[1];
}
#endif
__device__ __forceinline__ unsigned dpp_ror8(unsigned v) { return (unsigned)__builtin_amdgcn_update_dpp(0, (int)v, 0x128, 0xf, 0xf, true); }
__device__ __forceinline__ u32x4 dpp_ror8(u32x4 v) { u32x4 r; r.x = dpp_ror8(v.x); r.y = dpp_ror8(v.y); r.z = dpp_ror8(v.z); r.w = dpp_ror8(v.w); return r; }
__device__ __forceinline__ void xchg_rows(const u32x4 v0, const u32x4 v1, int fr, u32x4& w_lo, u32x4& w_hi) {
    const bool up = fr >= 8; const u32x4 snd = up ? v0 : v1, rcv = dpp_ror8(snd);
    w_lo = up ? rcv : v0; w_hi = up ? v1 : rcv;
}
__device__ __forceinline__ int pair16_ofs(int fq) { return (fq & 1) ? 24 + 8 * fq : 8 * fq; }
__device__ __forceinline__ void store_pair16(unsigned char* p, const u32x2 a8, const u32x2 b8) {
    const auto sx = __builtin_amdgcn_permlane16_swap(a8.x, b8.x, false, false), sy = __builtin_amdgcn_permlane16_swap(a8.y, b8.y, false, false);
    u32x4 w; w.x = sx[0]; w.y = sy[0]; w.z = sx[1]; w.w = sy[1]; *(u32x4*)p = w;
}
struct EpiInProj {
    static constexpr bool PERM = true, FP8 = (P1_FP8 != 0); static constexpr int COLMAP = 2, NSTORES = 16;
    bf16_t *QA, *KA, *VA, *QB, *KB, *VB, *G; const unsigned* csT; int var;
    __device__ __forceinline__ void operator()(const f32x4 (&acc)[2][2][4][2], const Unit& u, int wr, int wc, int fr, int fq) const {
        const int pn = u.pn, rb0 = (var == 3 ? (u.pm & 3) : u.pm) * 256 + wr * 64;
        asm volatile("" : "+v"(fq), "+v"(fr));
        const int chunk = fq + 4 * (fr >> 3), rl = fr & 7;
        constexpr float WS_ = FP8 ? W8_INV : 1.0f;
        bf16_t* base; int ld, colt; float sc = WS_; int kind;
        constexpr float QS_ = QKV_FP8 ? 1.0f : QSCALE;
        if (pn < 4) { base = QA; ld = 1024; colt = pn * 256; sc = QS_ * WS_; kind = 0; }
        else if (pn == 4) { base = KA; ld = 256; colt = 0; kind = 0; }
        else if (pn == 5) { base = VA; ld = 256; colt = 0; kind = 1; }
        else if (pn < 9) { base = QB; ld = 768; colt = (pn - 6) * 256; sc = QS_ * WS_; kind = 0; }
        else if (pn < 12) { base = KB; ld = 768; colt = (pn - 9) * 256; kind = 0; }
        else if (pn < 15) { base = VB; ld = 768; colt = (pn - 12) * 256; kind = 1; }
        else { base = G; ld = 2048; colt = (pn - 15) * 256; kind = 2; }
        bf16_t* seg = base + colt + 64 * wc + 8 * chunk;
        if (kind == 0) {
            u32x4 cs[2][4][2];
#pragma unroll
            for (int ai = 0; ai < 2; ++ai)
#pragma unroll
                for (int m = 0; m < 4; ++m) { const int pos = (rb0 + ai * 128 + m * 16 + fr) & (SEQ - 1); const unsigned* tp = csT + (((pos >> 4) * 4 + fq) * 16 + (pos & 15)) * 4;
                    cs[ai][m][0] = *(const u32x4*)tp; cs[ai][m][1] = *(const u32x4*)(tp + SEQ * 16); }
            asm volatile("" ::: "memory");
#pragma unroll
            for (int ai = 0; ai < 2; ++ai)
#pragma unroll
                for (int m = 0; m < 4; ++m) {
                    const u32x4 t0 = cs[ai][m][0], t1 = cs[ai][m][1];
                    const f32x4 c0 = {bflo(t0.x), bflo(t0.y), bflo(t0.z), bflo(t0.w)}, s0 = {bfhi(t0.x), bfhi(t0.y), bfhi(t0.z), bfhi(t0.w)};
                    const f32x4 c1 = {bflo(t1.x), bflo(t1.y), bflo(t1.z), bflo(t1.w)}, s1 = {bfhi(t1.x), bfhi(t1.y), bfhi(t1.z), bfhi(t1.w)};
                    const f32x4 x10 = acc[ai][0][m][0], x11 = acc[ai][0][m][1], x20 = acc[ai][1][m][0], x21 = acc[ai][1][m][1];
                    const f32x4 o10 = (x10 * c0 - x20 * s0) * sc, o11 = (x11 * c1 - x21 * s1) * sc;
                    const f32x4 o20 = (x20 * c0 + x10 * s0) * sc, o21 = (x21 * c1 + x11 * s1) * sc;
#if QKV_FP8
                    { unsigned char* rp8 = (unsigned char*)base + (size_t)(rb0 + ai * 128 + m * 16 + fr) * ld + colt + 64 * wc + pair16_ofs(fq); u32x2 a8, b8;
                      a8.x = pk4_fp8(o10[0], o10[1], o10[2], o10[3]); a8.y = pk4_fp8(o11[0], o11[1], o11[2], o11[3]); b8.x = pk4_fp8(o20[0], o20[1], o20[2], o20[3]); b8.y = pk4_fp8(o21[0], o21[1], o21[2], o21[3]);
                      store_pair16(rp8, a8, b8); }
#else
                    u32x4 v0, v1, wl, wh;
                    v0.x = pk2(o10[0], o10[1]); v0.y = pk2(o10[2], o10[3]); v0.z = pk2(o11[0], o11[1]); v0.w = pk2(o11[2], o11[3]);
                    v1.x = pk2(o20[0], o20[1]); v1.y = pk2(o20[2], o20[3]); v1.z = pk2(o21[0], o21[1]); v1.w = pk2(o21[2], o21[3]);
                    xchg_rows(v0, v1, fr, wl, wh);
                    bf16_t* rp = seg + (size_t)(rb0 + ai * 128 + m * 16 + rl) * ld;
                    if (var != 1) { *(u32x4*)rp = wl; *(u32x4*)(rp + (size_t)8 * ld) = wh; }
#endif
                }
        } else if (kind == 1 && QKV_FP8) {
            unsigned char* vp0 = (unsigned char*)base + colt + 64 * wc + pair16_ofs(fq);
#pragma unroll
            for (int ai = 0; ai < 2; ++ai)
#pragma unroll
                for (int m = 0; m < 4; ++m) {
                    unsigned char* vp = vp0 + (size_t)(rb0 + ai * 128 + m * 16 + fr) * ld;
                    u32x2 w8[2];
#pragma unroll
                    for (int bj = 0; bj < 2; ++bj) { const f32x4 a = acc[ai][bj][m][0] * WS_, b = acc[ai][bj][m][1] * WS_;
                        w8[bj].x = pk4_fp8(a[0], a[1], a[2], a[3]); w8[bj].y = pk4_fp8(b[0], b[1], b[2], b[3]); }
                    store_pair16(vp, w8[0], w8[1]);
                }
        } else if (kind == 2 && G_FP8) {
            unsigned char* gp0 = (unsigned char*)G + GFRAG_OFS(rb0 >> 4, (pn - 15) * 4 + wc, fq, fr);
#pragma unroll
            for (int ai = 0; ai < 2; ++ai)
#pragma unroll
                for (int m = 0; m < 4; ++m) {
                    unsigned char* gp = gp0 + (size_t)(ai * 8 + m) * 32 * 1024;
                    u32x2 w8[2];
#pragma unroll
                    for (int bj = 0; bj < 2; ++bj) { const f32x4 a = acc[ai][bj][m][0] * WS_, b = acc[ai][bj][m][1] * WS_;
                        w8[bj].x = pk4_fp8(fast_sigmoid(a[0]), fast_sigmoid(a[1]), fast_sigmoid(a[2]), fast_sigmoid(a[3])); w8[bj].y = pk4_fp8(fast_sigmoid(b[0]), fast_sigmoid(b[1]), fast_sigmoid(b[2]), fast_sigmoid(b[3])); }
                    store_pair16(gp, w8[0], w8[1]);
                }
        } else {
#pragma unroll
            for (int ai = 0; ai < 2; ++ai)
#pragma unroll
                for (int m = 0; m < 4; ++m) {
                    u32x4 v[2], wl, wh;
#pragma unroll
                    for (int bj = 0; bj < 2; ++bj) { f32x4 a = acc[ai][bj][m][0] * WS_, b = acc[ai][bj][m][1] * WS_;
                        if (kind == 2) { a = (f32x4){fast_sigmoid(a[0]), fast_sigmoid(a[1]), fast_sigmoid(a[2]), fast_sigmoid(a[3])}; b = (f32x4){fast_sigmoid(b[0]), fast_sigmoid(b[1]), fast_sigmoid(b[2]), fast_sigmoid(b[3])}; }
                        v[bj].x = pk2(a[0], a[1]); v[bj].y = pk2(a[2], a[3]); v[bj].z = pk2(b[0], b[1]); v[bj].w = pk2(b[2], b[3]); }
                    xchg_rows(v[0], v[1], fr, wl, wh);
                    bf16_t* rp = seg + (size_t)(rb0 + ai * 128 + m * 16 + rl) * ld;
                    if (var != 1) { *(u32x4*)rp = wl; *(u32x4*)(rp + (size_t)8 * ld) = wh; }
                }
        }
    }
};
struct HookGateRatio {
    static constexpr int T = P3_FP8 ? 8 : 16;
    const bf16_t* G;
    __device__ __forceinline__ void operator()(f32x4 (&acc)[2][2][4][2], const Unit& u, int wr, int wc, int fr, int fq) const {
        int loff = (wr * 64 + fr) * 2048 + wc * 64 + 8 * fq;
        asm volatile("" : "+v"(loff));
#if G_FP8
        int fq_o = fq, fr_o = fr; asm volatile("" : "+v"(fq_o), "+v"(fr_o));
        const unsigned char* gfrag = (const unsigned char*)G + GFRAG_OFS(u.pm * 16 + wr * 4, u.pn * 4 + wc, fq_o, fr_o);
#endif
        const unsigned char* gbase = (const unsigned char*)G + ((size_t)u.pm * 256 * 2048 + (size_t)u.pn * 256) * GATE_B;
#pragma unroll
        for (int ai = 0; ai < 2; ++ai) {
            gate8_t ga[4][2], gb[4][2];
#if G_FP8
            { u32x4 La[4], Lb[4];
#pragma unroll
              for (int m = 0; m < 4; ++m) { const unsigned char* gp = gfrag + (size_t)(ai * 8 + m) * 32 * 1024; gate_ld_pair(gp, La[m]); gate_ld_pair(gp + 16 * 1024, Lb[m]); }
              asm volatile("" ::: "memory");
#pragma unroll
              for (int m = 0; m < 4; ++m) { gate_unswap(La[m], ga[m][0], ga[m][1]); gate_unswap(Lb[m], gb[m][0], gb[m][1]); } }
#else
#pragma unroll
            for (int m = 0; m < 4; ++m)
#pragma unroll
                for (int bj = 0; bj < 2; ++bj) { const unsigned char* gp = gbase + (size_t)((ai * 128 + m * 16) * 2048 + bj * 32) * GATE_B + (unsigned)(loff * GATE_B); ga[m][bj] = *(const gate8_t*)gp; gb[m][bj] = *(const gate8_t*)(gp + 1024 * GATE_B); }
            asm volatile("" ::: "memory");
#endif
#pragma unroll
            for (int m = 0; m < 4; ++m)
#pragma unroll
                for (int bj = 0; bj < 2; ++bj) {
                    f32x4 a0, a1, b0, b1; gate_unpack(ga[m][bj], a0, a1); gate_unpack(gb[m][bj], b0, b1);
                    f32x4 r0, r1;
#pragma unroll
                    for (int q = 0; q < 4; ++q) { r0[q] = a0[q] * __builtin_amdgcn_rcpf(b0[q]); r1[q] = a1[q] * __builtin_amdgcn_rcpf(b1[q]); }
                    acc[ai][bj][m][0] *= r0; acc[ai][bj][m][1] *= r1;
                }
            asm volatile("" ::: "memory");
        }
    }
};
struct EpiMerged {
    static constexpr bool PERM = true, FP8 = (P3_FP8 != 0); static constexpr int COLMAP = 2, NSTORES = 16;
    const bf16_t* G; bf16_t* O;
    __device__ __forceinline__ void operator()(const f32x4 (&acc)[2][2][4][2], const Unit& u, int wr, int wc, int fr, int fq) const {
        const int rb0 = u.pm * 256 + wr * 64, col = u.pn * 256 + wc * 64 + 8 * fq;
        gate8_t gb[2][4][2];
#if G_FP8
        { u32x4 Lg[2][4];
#pragma unroll
          for (int ai = 0; ai < 2; ++ai)
#pragma unroll
            for (int m = 0; m < 4; ++m) gate_ld_pair((const unsigned char*)G + GFRAG_OFS((rb0 >> 4) + ai * 8 + m, 16 + u.pn * 4 + wc, fq, fr), Lg[ai][m]);
          asm volatile("" ::: "memory");
#pragma unroll
          for (int ai = 0; ai < 2; ++ai)
#pragma unroll
            for (int m = 0; m < 4; ++m) gate_unswap(Lg[ai][m], gb[ai][m][0], gb[ai][m][1]); }
#else
#pragma unroll
        for (int ai = 0; ai < 2; ++ai)
#pragma unroll
            for (int m = 0; m < 4; ++m)
#pragma unroll
                for (int bj = 0; bj < 2; ++bj) gb[ai][m][bj] = GATE_LD(G, rb0 + ai * 128 + m * 16 + fr, 1024 + col + bj * 32);
        asm volatile("" ::: "memory");
#endif
#pragma unroll
        for (int ai = 0; ai < 2; ++ai)
#pragma unroll
            for (int m = 0; m < 4; ++m) {
                f32x4 o[2][2];
#pragma unroll
                for (int bj = 0; bj < 2; ++bj) { f32x4 g0, g1; gate_unpack(gb[ai][m][bj], g0, g1); constexpr float SC_ = FP8 ? W8_INV * OA_INV : 1.0f; o[bj][0] = acc[ai][bj][m][0] * g0 * SC_; o[bj][1] = acc[ai][bj][m][1] * g1 * SC_; }
#if P4_FP8
                u32x2 w8[2];
#pragma unroll
                for (int bj = 0; bj < 2; ++bj) {
                    const f32x4 v0 = o[bj][0] * MG_SCALE, v1 = o[bj][1] * MG_SCALE;
                    w8[bj].x = pk4_fp8(v0[0], v0[1], v0[2], v0[3]); w8[bj].y = pk4_fp8(v1[0], v1[1], v1[2], v1[3]); }
                store_pair16((unsigned char*)O + (size_t)(rb0 + ai * 128 + m * 16 + fr) * 1024 + col - 8 * fq + pair16_ofs(fq), w8[0], w8[1]);
#else
                u32x4 v[2], wl, wh;
#pragma unroll
                for (int bj = 0; bj < 2; ++bj) { v[bj].x = pk2(o[bj][0][0], o[bj][0][1]); v[bj].y = pk2(o[bj][0][2], o[bj][0][3]); v[bj].z = pk2(o[bj][1][0], o[bj][1][1]); v[bj].w = pk2(o[bj][1][2], o[bj][1][3]); }
                xchg_rows(v[0], v[1], fr, wl, wh);
                bf16_t* rp = O + u.pn * 256 + wc * 64 + 8 * (fq + 4 * (fr >> 3)) + (size_t)(rb0 + ai * 128 + m * 16 + (fr & 7)) * 1024;
                *(u32x4*)rp = wl; *(u32x4*)(rp + 8 * 1024) = wh;
#endif
            }
    }
};
struct EpiPre {
    static constexpr bool PERM = false, FP8 = (P4_FP8 != 0); static constexpr int COLMAP = 2, NSTORES = 32;
    const float* X; float* O; float* ST; bf16_t* P16;
    __device__ __forceinline__ void operator()(f32x4 (&acc)[2][2][4][2], const Unit& u, int wr, int wc, int fr, int fq) const {
        const int rb0 = u.pm * 256 + wr * 64, col = u.pn * 256 + wc * 64 + 4 * fq;
        float* seg = O + u.pn * 256 + wc * 64 + 4 * (fq + 4 * (fr >> 3));
        f32x4 xv[4][2][2];
#define EPIPRE_LOAD(ai) do { _Pragma("unroll") for (int m = 0; m < 4; ++m) { const size_t off = (size_t)(rb0 + (ai) * 128 + m * 16 + fr) * 1024 + col; \
            _Pragma("unroll") for (int bj = 0; bj < 2; ++bj) _Pragma("unroll") for (int n = 0; n < 2; ++n) xv[m][bj][n] = *(const f32x4*)(X + off + bj * 32 + n * 16); } } while (0)
#define EPIPRE_FMA(ai) do { _Pragma("unroll") for (int m = 0; m < 4; ++m) _Pragma("unroll") for (int bj = 0; bj < 2; ++bj) _Pragma("unroll") for (int n = 0; n < 2; ++n) acc[ai][bj][m][n] = xv[m][bj][n] * ALPHA + acc[ai][bj][m][n] * (FP8 ? W8_INV * MG_INV : 1.0f); } while (0)
#if PRE16
        bf16_t* pseg = P16 + u.pn * 256 + wc * 64 + ((fq & 1) ? 16 + 4 * (fq - 1) : 4 * fq);
#define EPIPRE_STORE(ai) do { _Pragma("unroll") for (int m = 0; m < 4; ++m) { bf16_t* rp = pseg + (size_t)(rb0 + (ai) * 128 + m * 16 + fr) * 1024; \
            _Pragma("unroll") for (int bj = 0; bj < 2; ++bj) { const f32x4 a_ = acc[ai][bj][m][0], b_ = acc[ai][bj][m][1]; \
                const auto sx_ = __builtin_amdgcn_permlane16_swap(pk2(a_[0], a_[1]), pk2(b_[0], b_[1]), false, false); const auto sy_ = __builtin_amdgcn_permlane16_swap(pk2(a_[2], a_[3]), pk2(b_[2], b_[3]), false, false); \
                u32x4 w_; w_.x = sx_[0]; w_.y = sy_[0]; w_.z = sx_[1]; w_.w = sy_[1]; *(u32x4*)(rp + bj * 32) = w_; } } } while (0)
#else
#define EPIPRE_STORE(ai) do { _Pragma("unroll") for (int m = 0; m < 4; ++m) { float* rp = seg + (size_t)(rb0 + (ai) * 128 + m * 16 + (fr & 7)) * 1024; \
            _Pragma("unroll") for (int bj = 0; bj < 2; ++bj) { u32x4 wl, wh; xchg_rows(__builtin_bit_cast(u32x4, acc[ai][bj][m][0]), __builtin_bit_cast(u32x4, acc[ai][bj][m][1]), fr, wl, wh); \
                *(u32x4*)(rp + bj * 32) = wl; *(u32x4*)(rp + 8 * 1024 + bj * 32) = wh; } } } while (0)
#endif
#define EPIPRE_STATS(ai) do { if (P5_SINGLE) { _Pragma("unroll") for (int m = 0; m < 4; ++m) { float s1_ = 0.f, s2_ = 0.f; \
            _Pragma("unroll") for (int bj = 0; bj < 2; ++bj) _Pragma("unroll") for (int n = 0; n < 2; ++n) { const f32x4 v_ = acc[ai][bj][m][n]; s1_ += (v_[0] + v_[1]) + (v_[2] + v_[3]); s2_ += (v_[0] * v_[0] + v_[1] * v_[1]) + (v_[2] * v_[2] + v_[3] * v_[3]); } \
            s1_ += __shfl_xor(s1_, 16); s2_ += __shfl_xor(s2_, 16); s1_ += __shfl_xor(s1_, 32); s2_ += __shfl_xor(s2_, 32); \
            if (fq == 0) *(f32x2*)(ST + ((size_t)(rb0 + (ai) * 128 + m * 16 + fr) * 16 + u.pn * 4 + wc) * 2) = (f32x2){s1_, s2_}; } } } while (0)
        EPIPRE_LOAD(0); asm volatile("" ::: "memory");
        EPIPRE_FMA(0);
        EPIPRE_STATS(0);
        asm volatile("" : "+v"(acc[0][0][0][0]), "+v"(acc[0][0][1][0]), "+v"(acc[0][0][2][0]), "+v"(acc[0][0][3][0]) :: "memory");
        EPIPRE_LOAD(1); asm volatile("" ::: "memory");
        EPIPRE_STORE(0); asm volatile("" ::: "memory");
        EPIPRE_FMA(1);
        EPIPRE_STATS(1);
        EPIPRE_STORE(1);
#undef EPIPRE_STATS
#undef EPIPRE_LOAD
#undef EPIPRE_FMA
#undef EPIPRE_STORE
    }
};
struct EpiSwiglu {
    static constexpr bool PERM = true, FP8 = true; static constexpr int COLMAP = 1, NSTORES = 8;
    const float* bgu; unsigned char* H8;
    __device__ __forceinline__ void operator()(const f32x4 (&acc)[2][2][4][2], const Unit& u, int wr, int wc, int fr, int fq) const {
        const int e = u.pn >> 3, j = u.pn & 7, row0 = u.pm * 256 + wr * 64 + fr, col = j * 128 + wc * 32 + 8 * fq;
        const float* bp = bgu + (size_t)e * 2048 + col;
        constexpr float C_ = -1.702f * LOG2E, SG_ = W8_INV * C_, SU_ = W8_INV / C_, T7_ = 7.0f * C_, ULO_ = 8.0f / C_, UHI_ = -6.0f / C_;
        const f32x4 bg0 = *(const f32x4*)bp * C_, bg1 = *(const f32x4*)(bp + 4) * C_, bu0 = (*(const f32x4*)(bp + 1024) + 1.0f) * (1.0f / C_), bu1 = (*(const f32x4*)(bp + 1028) + 1.0f) * (1.0f / C_);
        unsigned char* hp = H8 + (size_t)(row0 + (fq & 1) * 16) * 1024 + col - 8 * (fq & 1);
#pragma unroll
        for (int ai = 0; ai < 2; ++ai)
#pragma unroll
            for (int mp = 0; mp < 2; ++mp) {
                u32x2 w[2];
#pragma unroll
                for (int mm = 0; mm < 2; ++mm) { const int m = 2 * mp + mm;
                    const f32x4 t0 = acc[ai][0][m][0] * SG_ + bg0, t1 = acc[ai][0][m][1] * SG_ + bg1;
                    const f32x4 u0 = acc[ai][1][m][0] * SU_ + bu0, u1 = acc[ai][1][m][1] * SU_ + bu1;
                    f32x4 o0, o1;
#pragma unroll
                    for (int q = 0; q < 4; ++q) {
                        const float ta = __builtin_fmaxf(t0[q], T7_), tb = __builtin_fmaxf(t1[q], T7_);
                        const float ra = __builtin_amdgcn_rcpf(1.0f + __builtin_amdgcn_exp2f(ta)), rb = __builtin_amdgcn_rcpf(1.0f + __builtin_amdgcn_exp2f(tb));
                        o0[q] = __builtin_amdgcn_fmed3f(u0[q], ULO_, UHI_) * ta * ra; o1[q] = __builtin_amdgcn_fmed3f(u1[q], ULO_, UHI_) * tb * rb;
                    }
                    w[mm].x = pk4_fp8(o0[0], o0[1], o0[2], o0[3]); w[mm].y = pk4_fp8(o1[0], o1[1], o1[2], o1[3]); }
                store_pair16(hp + (size_t)(ai * 128 + mp * 32) * 1024, w[0], w[1]);
            }
    }
};
struct EpiDown {
    static constexpr bool PERM = true, FP8 = true; static constexpr int COLMAP = 2, NSTORES = 16;
    const float* bd; const int* dst; bf16_t* Y;
    __device__ __forceinline__ void operator()(const f32x4 (&acc)[2][2][4][2], const Unit& u, int wr, int wc, int fr, int fq) const {
        const int e = u.pn >> 2, j = u.pn & 3, rb0 = u.pm * 256 + wr * 64, col = j * 256 + wc * 64 + 8 * fq;
        const float* bp = bd + (size_t)e * 1024 + col;
        f32x4 bv[2][2];
#pragma unroll
        for (int bj = 0; bj < 2; ++bj) { bv[bj][0] = *(const f32x4*)(bp + bj * 32); bv[bj][1] = *(const f32x4*)(bp + bj * 32 + 4); }
        int dd[2][4];
#pragma unroll
        for (int ai = 0; ai < 2; ++ai)
#pragma unroll
            for (int m = 0; m < 4; ++m) dd[ai][m] = dst[rb0 + ai * 128 + m * 16 + fr];
        asm volatile("" ::: "memory");
        bf16_t* seg = Y + j * 256 + wc * 64 + 8 * (fq + 4 * (fr >> 3));
#pragma unroll
        for (int ai = 0; ai < 2; ++ai)
#pragma unroll
            for (int m = 0; m < 4; ++m) {
                u32x4 v[2], wl, wh;
#pragma unroll
                for (int bj = 0; bj < 2; ++bj) { const f32x4 v0 = acc[ai][bj][m][0] * W8_INV + bv[bj][0], v1 = acc[ai][bj][m][1] * W8_INV + bv[bj][1];
                    v[bj].x = pk2(v0[0], v0[1]); v[bj].y = pk2(v0[2], v0[3]); v[bj].z = pk2(v1[0], v1[1]); v[bj].w = pk2(v1[2], v1[3]); }
#if Y_FP8
                (void)wl; (void)wh; (void)seg;
                { const int dme = dd[ai][m] >= 0 ? dd[ai][m] : HALF_T * 4;
                  unsigned char* rp8 = (unsigned char*)Y + (size_t)dme * 1024 + j * 256 + wc * 64 + pair16_ofs(fq); u32x2 w8[2];
#pragma unroll
                  for (int bj = 0; bj < 2; ++bj) { const f32x4 v0 = acc[ai][bj][m][0] * W8_INV + bv[bj][0], v1 = acc[ai][bj][m][1] * W8_INV + bv[bj][1];
                      w8[bj].x = pk4_fp8(v0[0], v0[1], v0[2], v0[3]); w8[bj].y = pk4_fp8(v1[0], v1[1], v1[2], v1[3]); }
                  store_pair16(rp8, w8[0], w8[1]); }
#else
                xchg_rows(v[0], v[1], fr, wl, wh);
                const int dme = dd[ai][m] >= 0 ? dd[ai][m] : HALF_T * 4, dpt = (int)dpp_ror8((unsigned)dme);
                const int d0 = fr < 8 ? dme : dpt, d1 = fr < 8 ? dpt : dme;
                *(u32x4*)(seg + (size_t)d0 * 1024) = wl; *(u32x4*)(seg + (size_t)d1 * 1024) = wh;
#endif
            }
    }
};

__device__ __forceinline__ int crow(int r, int hi) { return (r & 3) + 8 * (r >> 2) + 4 * hi; }
constexpr float AT_THR = 8.0f;
constexpr int AT_KROW = 144, AT_VROW = 128, AT_MAXT = 12;
constexpr int AT_KOFF = 0, AT_VOFF = AT_MAXT * 32 * AT_KROW;
static_assert(AT_VOFF + AT_MAXT * 32 * AT_VROW <= 131072, "attention LDS images fit the ring region");
#if QKV_FP8
typedef unsigned char qkv_t;
#else
typedef bf16_t qkv_t;
#endif
struct AttnUnit {
    const qkv_t* q; const qkv_t* k; const qkv_t* v; bf16_t* o; float* lse;
    const float* sink;
    int qld, kvld, old, lseld, dil, qt0, NQ, NH, nback, ofp8;
    int pair;
};
__device__ __forceinline__ int attn_ntask(const AttnUnit& u) { return u.pair ? 8 : u.NQ * u.NH; }
__device__ __forceinline__ int attn_task_qi(const AttnUnit& u, int t) { return u.pair ? (t >= 4 ? 7 - t : t) : t / u.NH; }
__device__ __forceinline__ int attn_task_sub(const AttnUnit& u, int t) { return u.pair ? (t >> 2) : 0; }
#define attn_task(u_, t_, qi_, hq_, sub_) do { qi_ = attn_task_qi(u_, t_); sub_ = attn_task_sub(u_, t_); hq_ = (u_).pair ? 0 : (t_) - qi_ * (u_).NH; } while (0)
constexpr int AT_NUNITS = 4096;
__device__ __forceinline__ AttnUnit attn_decode(int id, qkv_t* QA, qkv_t* KA, qkv_t* VA, qkv_t* QB, qkv_t* KB, qkv_t* VB, bf16_t* OAB, bf16_t* OG, float* LSE, const float* sinks) {
    AttnUnit u;
    u.pair = 0;
    if (id < 1024) { const int kvh = id & 3, qb = (id >> 2) & 7, b = id >> 5; const size_t t0 = (size_t)b * SEQ;
        u.q = QA + t0 * 1024 + kvh * 256; u.k = KA + t0 * 256 + kvh * 64; u.v = VA + t0 * 256 + kvh * 64; u.o = P3_FP8 ? (bf16_t*)((unsigned char*)OAB + t0 * 1280 + kvh * 256) : OAB + t0 * 1280 + kvh * 256; u.lse = nullptr; u.sink = sinks + kvh * 4;
        u.qld = 1024; u.kvld = 256; u.old = 1280; u.lseld = 0; u.dil = 1; u.qt0 = 8 * qb; u.NQ = 8; u.NH = 4; u.nback = 127; u.ofp8 = P3_FP8; return u; }
    id -= 1024; int head, res, b; u.ofp8 = 0;
    if (id < 1024) { head = id & 3; u.qt0 = 8 * ((id >> 2) & 7); b = id >> 5; res = 0; u.dil = 1; u.NQ = 8; }
    else if (id < 2048) { id -= 1024; head = 4 + (id & 3); res = (id >> 2) & 3; u.qt0 = 8 * ((id >> 4) & 1); b = id >> 5; u.dil = 4; u.NQ = 8; }
    else { id -= 2048; head = 8 + (id & 3); res = 2 * ((id >> 2) & 7); b = id >> 5; u.qt0 = 0; u.dil = 16; u.NQ = 4; u.pair = 1; }
    const size_t t0 = (size_t)b * SEQ + res;
    u.q = QB + t0 * 768 + head * 64; u.k = KB + t0 * 768 + head * 64; u.v = VB + t0 * 768 + head * 64; u.o = OG + t0 * 768 + head * 64; u.lse = LSE + t0 * 12 + head; u.sink = nullptr;
    u.qld = 768; u.kvld = 768; u.old = 768; u.lseld = 12; u.NH = 1; u.nback = 128; return u;
}
#if QKV_FP8
constexpr int AT_NPRE = AT_MAXT / 2;
__device__ __forceinline__ void attn_prefetch(const AttnUnit& u, u32x4 (&pre)[AT_NPRE], int tid) {
    const int w0 = u.qt0 > 4 ? u.qt0 - 4 : 0, NK = u.pair ? 8 : u.qt0 + u.NQ - w0;
    const int part = tid & 7;
    const qkv_t* src = (part < 4 ? u.k : u.v) + (size_t)(32 * w0 + (tid >> 3)) * u.dil * u.kvld + (part & 3) * 16;
    const size_t step = (size_t)64 * u.dil * u.kvld;
#pragma unroll
    for (int j = 0; j < AT_NPRE; ++j) if (2 * j < NK) pre[j] = *(const u32x4*)(src + (u.pair ? (size_t)(j & 1) * step + (size_t)(j >> 1) * u.kvld : j * step));
}
__device__ __forceinline__ void fp8x16_to_bf16(const u32x4 w, u32x4& o0, u32x4& o1) {
    f32x2 t;
    t = __builtin_amdgcn_cvt_pk_f32_fp8((int)w.x, false); o0.x = pk2(t[0], t[1]); t = __builtin_amdgcn_cvt_pk_f32_fp8((int)w.x, true); o0.y = pk2(t[0], t[1]);
    t = __builtin_amdgcn_cvt_pk_f32_fp8((int)w.y, false); o0.z = pk2(t[0], t[1]); t = __builtin_amdgcn_cvt_pk_f32_fp8((int)w.y, true); o0.w = pk2(t[0], t[1]);
    t = __builtin_amdgcn_cvt_pk_f32_fp8((int)w.z, false); o1.x = pk2(t[0], t[1]); t = __builtin_amdgcn_cvt_pk_f32_fp8((int)w.z, true); o1.y = pk2(t[0], t[1]);
    t = __builtin_amdgcn_cvt_pk_f32_fp8((int)w.w, false); o1.z = pk2(t[0], t[1]); t = __builtin_amdgcn_cvt_pk_f32_fp8((int)w.w, true); o1.w = pk2(t[0], t[1]);
}
__device__ __forceinline__ void attn_stage(const AttnUnit& u, const u32x4 (&pre)[AT_NPRE], LAS unsigned char* lds, int tid) {
    const int w0 = u.qt0 > 4 ? u.qt0 - 4 : 0, NK = u.pair ? 8 : u.qt0 + u.NQ - w0; (void)w0;
    const int part = tid & 7, row0 = tid >> 3;
#pragma unroll
    for (int j = 0; j < AT_NPRE; ++j) if (2 * j < NK) {
        const int row = row0 + 64 * j; u32x4 o0, o1; fp8x16_to_bf16(pre[j], o0, o1);
        LAS unsigned char* dst = part < 4 ? lds + AT_KOFF + row * AT_KROW + part * 32 : lds + AT_VOFF + row * AT_VROW + (((part - 4) * 32) ^ (((row >> 1) & 1) << 6));
        *(LAS u32x4*)dst = o0; *(LAS u32x4*)(dst + 16) = o1;
    }
}
#else
constexpr int AT_NPRE = AT_MAXT;
__device__ __forceinline__ void attn_prefetch(const AttnUnit& u, u32x4 (&pre)[AT_MAXT], int tid) {
    const int w0 = u.qt0 > 4 ? u.qt0 - 4 : 0, NK = u.qt0 + u.NQ - w0;
    const int part = tid & 15;
    const bf16_t* src = (part < 8 ? u.k : u.v) + (size_t)(32 * w0 + (tid >> 4)) * u.dil * u.kvld + (part & 7) * 8;
    const size_t step = (size_t)32 * u.dil * u.kvld;
#pragma unroll
    for (int j = 0; j < AT_MAXT; ++j) if (j < NK) pre[j] = *(const u32x4*)(src + j * step);
}
__device__ __forceinline__ void attn_stage(const AttnUnit& u, const u32x4 (&pre)[AT_MAXT], LAS unsigned char* lds, int tid) {
    const int w0 = u.qt0 > 4 ? u.qt0 - 4 : 0, NK = u.qt0 + u.NQ - w0;
    const int part = tid & 15, row0 = tid >> 4;
#pragma unroll
    for (int j = 0; j < AT_MAXT; ++j) if (j < NK) {
        const int row = row0 + 32 * j;
        if (part < 8) *(LAS u32x4*)(lds + AT_KOFF + row * AT_KROW + part * 16) = pre[j];
        else *(LAS u32x4*)(lds + AT_VOFF + row * AT_VROW + ((((part - 8) * 16)) ^ (((row >> 1) & 1) << 6))) = pre[j];
    }
}
#endif
typedef short v4i16_t __attribute__((ext_vector_type(4)));
__device__ __forceinline__ void attn_load_q_raw(const AttnUnit& u, int t, int lane, u32x2 (&raw)[4]) {
    int qi, hq, sub; attn_task(u, t, qi, hq, sub);
    const unsigned char* qp = (const unsigned char*)u.q + ((size_t)(32 * (u.qt0 + qi) + (lane & 31)) * u.dil + sub) * u.qld + hq * 64 + 32 * (lane >> 5);
    const u32x4 q0 = *(const u32x4*)qp, q1 = *(const u32x4*)(qp + 16);
    raw[0].x = q0.x; raw[0].y = q0.y; raw[1].x = q0.z; raw[1].y = q0.w; raw[2].x = q1.x; raw[2].y = q1.y; raw[3].x = q1.z; raw[3].y = q1.w;
}
__device__ __forceinline__ void attn_cvt_q(const u32x2 (&raw)[4], bf16x8 (&qf)[4]) {
#pragma unroll
    for (int ds = 0; ds < 4; ++ds) { const f32x4 a = fp8x4_f32(raw[ds].x) * QSCALE, b = fp8x4_f32(raw[ds].y) * QSCALE;
        u32x4 p; p.x = pk2(a[0], a[1]); p.y = pk2(a[2], a[3]); p.z = pk2(b[0], b[1]); p.w = pk2(b[2], b[3]); qf[ds] = __builtin_bit_cast(bf16x8, p); }
}
__device__ __forceinline__ void attn_load_q(const AttnUnit& u, int t, int lane, bf16x8 (&qf)[4]) {
    const int qi = t / u.NH, hq = t - qi * u.NH;
    const qkv_t* qp = u.q + (size_t)(32 * (u.qt0 + qi) + (lane & 31)) * u.dil * u.qld + hq * 64 + 8 * (lane >> 5);
#if QKV_FP8
    u32x2 raw[4];
    attn_load_q_raw(u, t, lane, raw); attn_cvt_q(raw, qf); (void)qp;
#else
#pragma unroll
    for (int ds = 0; ds < 4; ++ds) qf[ds] = *(const bf16x8*)(qp + 16 * ds);
#endif
}
__device__ __forceinline__ void attn_compute(const AttnUnit& u, const AttnUnit& nu, bool has_nu, LAS unsigned char* lds, int wave, int lane, bf16x8 (&qf)[4]) {
    const int r = lane & 31, hi = lane >> 5, w0 = u.qt0 > 4 ? u.qt0 - 4 : 0;
    const int ntask = attn_ntask(u);
    const int q4 = (lane & 15) >> 2, p4 = lane & 3, blk = (lane >> 4) & 1;
    const int vlane = (4 * hi + q4) * AT_VROW + 32 * blk + 8 * p4, vsw = ((q4 >> 1) & 1) << 6;
    for (int t = wave; t < ntask; t += 8) {
        int qi, hq, sub; attn_task(u, t, qi, hq, sub);
        const int qt = u.qt0 + qi, c0 = 32 * qt;
        const bool has_sink = u.sink != nullptr;
        float m = has_sink ? u.sink[hq] * LOG2E : -1e30f, l = (has_sink && hi == 0) ? 1.f : 0.f;
        f32x16 O0 = {}, O1 = {};
        u32x2 rawn[4]; const bool nx_here = t + 8 < ntask, nx_unit = !nx_here && has_nu && wave < attn_ntask(nu);
        if (nx_here) attn_load_q_raw(u, t + 8, lane, rawn); else if (nx_unit) attn_load_q_raw(nu, wave, lane, rawn);
        const int kt0 = qt > 4 ? qt - 4 : 0, qpos = c0 + r;
        for (int kt = kt0; kt <= qt; ++kt) {
            const int ti = kt - w0 + 4 * sub;
            const LAS unsigned char* kp = lds + AT_KOFF + (ti * 32 + r) * AT_KROW + 64 * hi;
            bf16x8 kf[4];
#pragma unroll
            for (int ds = 0; ds < 4; ++ds) kf[ds] = *(const LAS bf16x8*)(kp + 16 * ds);
            const LAS unsigned char* vp = lds + AT_VOFF + ti * 32 * AT_VROW + vlane;
            s16x4 va[2][2][2];
#pragma unroll
            for (int dt = 0; dt < 2; ++dt)
#pragma unroll
                for (int sx = 0; sx < 2; ++sx)
#pragma unroll
                    for (int tx = 0; tx < 2; ++tx)
                        va[dt][sx][tx] = __builtin_bit_cast(s16x4, __builtin_amdgcn_ds_read_tr16_b64_v4i16((LAS v4i16_t*)(vp + (16 * sx + 8 * tx) * AT_VROW + ((64 * dt) ^ vsw))));
            f32x16 x = {};
#pragma unroll
            for (int ds = 0; ds < 4; ++ds) x = __builtin_amdgcn_mfma_f32_32x32x16_bf16(kf[ds], qf[ds], x, 0, 0, 0);
            if (kt == qt) {
                const int rr = r - 4 * hi;
#pragma unroll
                for (int i = 0; i < 16; ++i) if (crow(i, 0) > rr) x[i] = -INFINITY;
            } else if (kt == qt - 4) {
                const int thr = r - 4 * hi - (u.nback - 128);
#pragma unroll
                for (int i = 0; i < 16; ++i) if (crow(i, 0) < thr) x[i] = -INFINITY;
            }
            float mx = x[0];
#pragma unroll
            for (int i = 1; i < 16; ++i) mx = __builtin_fmaxf(mx, x[i]);
            { const auto sw = __builtin_amdgcn_permlane32_swap(__float_as_uint(mx), __float_as_uint(mx), false, false);
              mx = __builtin_fmaxf(__uint_as_float(sw[0]), __uint_as_float(sw[1])); }
            if (__builtin_amdgcn_ballot_w64(mx > m + AT_THR) != 0ull) {
                const float mnew = __builtin_fmaxf(m, mx), alpha = __builtin_amdgcn_exp2f(m - mnew);
                m = mnew; l *= alpha;
#pragma unroll
                for (int i = 0; i < 16; ++i) { O0[i] *= alpha; O1[i] *= alpha; }
            }
            float ls = 0.f;
#pragma unroll
            for (int i = 0; i < 16; ++i) { x[i] = __builtin_amdgcn_exp2f(x[i] - m); ls += x[i]; }
            l += ls;
            bf16x8 pf[2];
#pragma unroll
            for (int sx = 0; sx < 2; ++sx) { u32x4 p; p.x = pk2(x[8 * sx], x[8 * sx + 1]); p.y = pk2(x[8 * sx + 2], x[8 * sx + 3]); p.z = pk2(x[8 * sx + 4], x[8 * sx + 5]); p.w = pk2(x[8 * sx + 6], x[8 * sx + 7]); pf[sx] = __builtin_bit_cast(bf16x8, p); }
#pragma unroll
            for (int sx = 0; sx < 2; ++sx) {
                const bf16x8 v0 = __builtin_shufflevector(va[0][sx][0], va[0][sx][1], 0, 1, 2, 3, 4, 5, 6, 7), v1 = __builtin_shufflevector(va[1][sx][0], va[1][sx][1], 0, 1, 2, 3, 4, 5, 6, 7);
                O0 = __builtin_amdgcn_mfma_f32_32x32x16_bf16(v0, pf[sx], O0, 0, 0, 0);
                O1 = __builtin_amdgcn_mfma_f32_32x32x16_bf16(v1, pf[sx], O1, 0, 0, 0);
            }
        }
        l += __shfl_xor(l, 32);
        const float inv = 1.0f / l;
        const size_t oel = ((size_t)(c0 + r) * u.dil + sub) * u.old + hq * 64 + 16 * hi;
        if (u.ofp8) {
            unsigned char* op8 = (unsigned char*)u.o + oel; const float sc8 = inv * OA_SCALE;
            unsigned w0_[4], w1_[4];
#pragma unroll
            for (int g = 0; g < 4; ++g) { w0_[g] = pk4_fp8(O0[4 * g] * sc8, O0[4 * g + 1] * sc8, O0[4 * g + 2] * sc8, O0[4 * g + 3] * sc8); w1_[g] = pk4_fp8(O1[4 * g] * sc8, O1[4 * g + 1] * sc8, O1[4 * g + 2] * sc8, O1[4 * g + 3] * sc8); }
            const auto a02 = __builtin_amdgcn_permlane32_swap(w0_[0], w0_[2], false, false), a13 = __builtin_amdgcn_permlane32_swap(w0_[1], w0_[3], false, false);
            const auto b02 = __builtin_amdgcn_permlane32_swap(w1_[0], w1_[2], false, false), b13 = __builtin_amdgcn_permlane32_swap(w1_[1], w1_[3], false, false);
            u32x4 s0, s1; s0.x = a02[0]; s0.y = a02[1]; s0.z = a13[0]; s0.w = a13[1]; s1.x = b02[0]; s1.y = b02[1]; s1.z = b13[0]; s1.w = b13[1];
            *(u32x4*)op8 = s0; *(u32x4*)(op8 + 32) = s1;
        } else {
            bf16_t* op = u.o + oel;
            u32x2 w0_[4], w1_[4];
#pragma unroll
            for (int g = 0; g < 4; ++g) {
                w0_[g].x = pk2(O0[4 * g] * inv, O0[4 * g + 1] * inv); w0_[g].y = pk2(O0[4 * g + 2] * inv, O0[4 * g + 3] * inv);
                w1_[g].x = pk2(O1[4 * g] * inv, O1[4 * g + 1] * inv); w1_[g].y = pk2(O1[4 * g + 2] * inv, O1[4 * g + 3] * inv);
            }
#define AT_SWAP_STORE(w_, dst_) do { \
                const auto x02_ = __builtin_amdgcn_permlane32_swap(w_[0].x, w_[2].x, false, false), y02_ = __builtin_amdgcn_permlane32_swap(w_[0].y, w_[2].y, false, false); \
                const auto x13_ = __builtin_amdgcn_permlane32_swap(w_[1].x, w_[3].x, false, false), y13_ = __builtin_amdgcn_permlane32_swap(w_[1].y, w_[3].y, false, false); \
                u32x4 s0_, s1_; s0_.x = x02_[0]; s0_.y = y02_[0]; s0_.z = x02_[1]; s0_.w = y02_[1]; s1_.x = x13_[0]; s1_.y = y13_[0]; s1_.z = x13_[1]; s1_.w = y13_[1]; \
                *(u32x4*)(dst_) = s0_; *(u32x4*)((dst_) + 8) = s1_; } while (0)
            AT_SWAP_STORE(w0_, op); AT_SWAP_STORE(w1_, op + 32);
#undef AT_SWAP_STORE
        }
        if (u.lse && hi == 0) u.lse[((size_t)(c0 + r) * u.dil + sub) * u.lseld] = m + __builtin_amdgcn_logf(l);
        if (nx_here || nx_unit) attn_cvt_q(rawn, qf);
    }
    if (wave >= ntask && has_nu && wave < attn_ntask(nu)) attn_load_q(nu, wave, lane, qf);
}

struct Args { const float* in[16]; float* out; unsigned char* ws; int ph_lo, ph_hi, li, var; };
constexpr int NPHASE = 8 + 2 * NHALF;

__device__ __forceinline__ void p0_transpose_item(const float* W, int N, int k0, int n0, bf16_t* WT, size_t ldo, size_t orow0, size_t ocol0, LAS float* scr, int lane) {
#pragma unroll 8
    for (int i = 0; i < 32; ++i) { const int kk = 2 * i + (lane >> 5); scr[kk * 33 + (lane & 31)] = W[(size_t)(k0 + kk) * N + n0 + (lane & 31)]; }
    LDS_WAIT(); asm volatile("" ::: "memory");
    const int c = lane & 7;
#pragma unroll
    for (int j = 0; j < 4; ++j) { const int n = (lane >> 3) + 8 * j; const LAS float* s = scr + (8 * c) * 33 + n;
        u32x4 o; o.x = pk2(s[0 * 33], s[1 * 33]); o.y = pk2(s[2 * 33], s[3 * 33]); o.z = pk2(s[4 * 33], s[5 * 33]); o.w = pk2(s[6 * 33], s[7 * 33]);
        *(u32x4*)(WT + (orow0 + n) * ldo + ocol0 + 8 * c) = o; }
    LDS_WAIT(); asm volatile("" ::: "memory");
}

__device__ __forceinline__ void p0_transpose_item_f8(const float* W, int N, int k0, int n0, unsigned char* WT, size_t ldo, size_t orow0, size_t ocol0, float scale, LAS float* scr, int lane) {
#pragma unroll 8
    for (int i = 0; i < 32; ++i) { const int kk = 2 * i + (lane >> 5); scr[kk * 33 + (lane & 31)] = W[(size_t)(k0 + kk) * N + n0 + (lane & 31)]; }
    LDS_WAIT(); asm volatile("" ::: "memory");
#pragma unroll
    for (int j = 0; j < 2; ++j) { const int id = lane + 64 * j, n = id >> 2, c = id & 3; const LAS float* sp = scr + (16 * c) * 33 + n;
        u32x4 o;
        o.x = pk4_fp8(sp[0 * 33] * scale, sp[1 * 33] * scale, sp[2 * 33] * scale, sp[3 * 33] * scale); o.y = pk4_fp8(sp[4 * 33] * scale, sp[5 * 33] * scale, sp[6 * 33] * scale, sp[7 * 33] * scale);
        o.z = pk4_fp8(sp[8 * 33] * scale, sp[9 * 33] * scale, sp[10 * 33] * scale, sp[11 * 33] * scale); o.w = pk4_fp8(sp[12 * 33] * scale, sp[13 * 33] * scale, sp[14 * 33] * scale, sp[15 * 33] * scale);
        *(u32x4*)(WT + (orow0 + n) * ldo + ocol0 + 16 * c) = o; }
    LDS_WAIT(); asm volatile("" ::: "memory");
}

__device__ __forceinline__ int opaque_tid() { int t = threadIdx.x; asm volatile("" : "+v"(t)); return t; }
__global__ void __launch_bounds__(512, 2) mk_fwd(Args args) {
    extern __shared__ __attribute__((aligned(16))) unsigned char lds_raw[];
    LAS unsigned char* lds = (LAS unsigned char*)lds_raw;
    volatile LAS unsigned* MISC = (volatile LAS unsigned*)(lds + MISC_OFF);
    const int tid = threadIdx.x, lane = tid & 63, wave = __builtin_amdgcn_readfirstlane(tid >> 6);
    const int G = gridDim.x, bx = blockIdx.x;
    const int gw = bx * 8 + wave, NGW = G * 8;
    unsigned char* const ws = args.ws;
    unsigned* const ctl = (unsigned*)(ws + WS_CTL);
#define X_IN     (args.in[0])
#define w_in     (args.in[1])
#define sinks    (args.in[2])
#define w_ba     (args.in[3])
#define w_bb     (args.in[4])
#define w_out    (args.in[5])
#define ln1g     (args.in[6])
#define ln1b     (args.in[7])
#define w_router (args.in[8])
#define b_router (args.in[9])
#define w_gu     (args.in[10])
#define b_gu     (args.in[11])
#define w_dn     (args.in[12])
#define b_dn     (args.in[13])
#define ln2g     (args.in[14])
#define ln2b     (args.in[15])
#define OUTP     (args.out)
#define csT    ((unsigned*)(ws + WS_COS))
#define WIN    ((bf16_t*)(ws + WS_WIN))
#define WAB    ((bf16_t*)(ws + WS_WAB))
#define WOUT   ((bf16_t*)(ws + WS_WOUT))
#define WGU    ((unsigned char*)(ws + WS_WGU))
#define WDN    ((unsigned char*)(ws + WS_WDN))
#define H1F8   ((unsigned char*)(ws + WS_H1F8))
#define STATS  ((float*)(ws + WS_STATS))
#define TOPE   ((int*)(ws + WS_TOPE))
#define TOPW   ((float*)(ws + WS_TOPW))
#define HIST   ((int*)(ws + WS_HIST))
#define ROWTOK ((int*)(ws + WS_ROWTOK))
#define ROWDST ((int*)(ws + WS_ROWDST))
#define TILEE  ((int*)(ws + WS_TILEE))
#define OAB    ((bf16_t*)(ws + WS_OAB))
#define XB     ((bf16_t*)(ws + WS_XB))
#define H1     ((bf16_t*)(ws + WS_H1))
#define Gt     ((bf16_t*)(ws + WS_G))
#define KB     ((bf16_t*)(ws + WS_KB))
#define VAT    ((bf16_t*)(ws + WS_VAT))
#define VBT    ((bf16_t*)(ws + WS_VBT))
#define OG     ((bf16_t*)(ws + WS_OG))
#define LSE    ((float*)(ws + WS_LSE))
#define MERGED ((bf16_t*)(ws + WS_MERGED))
#define Hh     ((unsigned char*)(ws + WS_H))
#define Y      ((bf16_t*)(ws + WS_Y))
#define QA     ((bf16_t*)((unsigned char*)args.out + DO_QA))
#define QB     ((bf16_t*)((unsigned char*)args.out + DO_QB))
#define KA     ((bf16_t*)((unsigned char*)args.out + DO_KA))

    for (int u = tid; u < (LDS_BYTES - LDSCTL_OFF) / 4; u += 512) ((LAS unsigned*)(lds + LDSCTL_OFF))[u] = 0u;
    __syncthreads();
    XcdBarrier bar; bar.bar = ctl + CW_BAR + args.li * XCD_BAR_WORDS; bar.x = 0; bar.st = nullptr;
    if (MK_ONE_LAUNCH) bar = xcd_barrier_post(ctl + CW_BAR + args.li * XCD_BAR_WORDS, MISC + 8);
    const int lo = args.ph_lo, hi = args.ph_hi;
#ifndef PH_MASK
#define PH_MASK 0xFFFF
#endif
#define IN(k) (((PH_MASK >> (k)) & 1) && lo <= (k) && (k) < hi)
#define SEAM(k) do { if (IN(k) && IN((k) + 1)) xcd_barrier(bar); } while (0)
#ifndef REPEAT_MASK
#define REPEAT_MASK 0
#endif
#define REPN(k) ((((REPEAT_MASK) >> (k)) & 1) ? 2 : 1)
#define REP_LOOP(k) for (int rep_ = 0; rep_ < REPN(k); ++rep_)
#define REP_SYNC() do { if (rep_) xcd_barrier(bar); } while (0)

    if (IN(0)) { REP_LOOP(0) { REP_SYNC(); const int tid = opaque_tid(), lane = tid & 63, wave = __builtin_amdgcn_readfirstlane(tid >> 6), gw = bx * 8 + wave; (void)lane; (void)wave; (void)gw;

        LAS float* scr = (LAS float*)(lds + wave * 16384);
        constexpr int I_IN = 16 * 184, I_BA = 16 * 32, I_BB = 4 * 32, I_OUT = 16 * 32, I_GU = 32 * 16 * 64, I_DN = 32 * 16 * 32;
        constexpr int NITEMS = I_IN + I_BA + I_BB + I_OUT + I_GU + I_DN;
        for (int it = gw; it < NITEMS; it += NGW) {
            int r = it;
            if (r < I_IN) { const int kb = r / 184, nb = r % 184, n0 = 32 * nb, tile = n0 >> 8, within = n0 & 255;
                (void)tile; (void)within;
#if P1_FP8
                p0_transpose_item_f8(w_in, INW, 64 * kb, n0, (unsigned char*)WIN, 1024, n0, 64 * kb, W8_SCALE, scr, lane); continue; } r -= I_IN;
#else
                p0_transpose_item(w_in, INW, 64 * kb, n0, WIN, 1024, n0, 64 * kb, scr, lane); continue; } r -= I_IN;
#endif
#if P3_FP8
            if (r < I_BA) { const int kb = r / 32, nb = r % 32; p0_transpose_item_f8(w_ba, 1024, 64 * kb, 32 * nb, (unsigned char*)WAB, 1280, 32 * nb, 64 * kb, W8_SCALE, scr, lane); continue; } r -= I_BA;
            if (r < I_BB) { const int kb = r / 32, nb = r % 32; p0_transpose_item_f8(w_bb, 1024, 64 * kb, 32 * nb, (unsigned char*)WAB, 1280, 32 * nb, 1024 + 64 * kb, W8_SCALE, scr, lane); continue; } r -= I_BB;
#else
            if (r < I_BA) { const int kb = r / 32, nb = r % 32; p0_transpose_item(w_ba, 1024, 64 * kb, 32 * nb, WAB, 1280, 32 * nb, 64 * kb, scr, lane); continue; } r -= I_BA;
            if (r < I_BB) { const int kb = r / 32, nb = r % 32; p0_transpose_item(w_bb, 1024, 64 * kb, 32 * nb, WAB, 1280, 32 * nb, 1024 + 64 * kb, scr, lane); continue; } r -= I_BB;
#endif
#if P4_FP8
            if (r < I_OUT) { const int kb = r / 32, nb = r % 32; p0_transpose_item_f8(w_out, 1024, 64 * kb, 32 * nb, (unsigned char*)WOUT, 1024, 32 * nb, 64 * kb, W8_SCALE, scr, lane); continue; } r -= I_OUT;
#else
            if (r < I_OUT) { const int kb = r / 32, nb = r % 32; p0_transpose_item(w_out, 1024, 64 * kb, 32 * nb, WOUT, 1024, 32 * nb, 64 * kb, scr, lane); continue; } r -= I_OUT;
#endif
            if (r < I_GU) { const int e = r / 1024, q = r % 1024, kb = q / 64, nb = q % 64, n0 = 32 * nb, np = n0 & 1023;
                const int orow = e * 2048 + (np >> 7) * 256 + (n0 >= 1024 ? 128 : 0) + (np & 127);
                p0_transpose_item_f8(w_gu + (size_t)e * 1024 * 2048, 2048, 64 * kb, n0, WGU, 1024, orow, 64 * kb, W8_SCALE, scr, lane); continue; } r -= I_GU;
            { const int e = r / 512, q = r % 512, kb = q / 32, nb = q % 32;
                p0_transpose_item_f8(w_dn + (size_t)e * 1024 * 1024, 1024, 64 * kb, 32 * nb, WDN, 1024, e * 1024 + 32 * nb, 64 * kb, W8_SCALE, scr, lane); }
        }
#if P1_FP8
        for (size_t i = (size_t)bx * 512 + tid; i < (size_t)T * D / 16; i += (size_t)G * 512) {
            const f32x4 a = *(const f32x4*)(X_IN + i * 16), b = *(const f32x4*)(X_IN + i * 16 + 4), c = *(const f32x4*)(X_IN + i * 16 + 8), d = *(const f32x4*)(X_IN + i * 16 + 12);
            u32x4 w; w.x = pk4_fp8(a[0], a[1], a[2], a[3]); w.y = pk4_fp8(b[0], b[1], b[2], b[3]); w.z = pk4_fp8(c[0], c[1], c[2], c[3]); w.w = pk4_fp8(d[0], d[1], d[2], d[3]);
            *(u32x4*)((unsigned char*)XB + i * 16) = w;
        }
#else
        for (size_t i = (size_t)bx * 512 + tid; i < (size_t)T * D / 8; i += (size_t)G * 512) {
            const f32x4 a = *(const f32x4*)(X_IN + i * 8), b = *(const f32x4*)(X_IN + i * 8 + 4);
            u32x4 w; w.x = pk2(a[0], a[1]); w.y = pk2(a[2], a[3]); w.z = pk2(b[0], b[1]); w.w = pk2(b[2], b[3]);
            *(u32x4*)(XB + i * 8) = w;
        }
#endif
        for (int i = bx * 512 + tid; i < SEQ * 32; i += G * 512) {
            const int pos = i >> 5, f = i & 31;
            const double invf = exp2(-(double)f * (13.287712379549449 / 32.0));
            const double ang = (double)pos * invf;
            csT[((f & 7) >> 2) * (SEQ * 16) + ((((pos >> 4) * 4 + (f >> 3)) * 16 + (pos & 15)) * 4) + (f & 3)] = pk2((float)cos(ang), (float)sin(ang));
        }
    }
    }
    SEAM(0);

#define XCD_STAGGER(ticks) do { if ((ticks) > 0) { if (tid == 0) { const unsigned long long te_ = __builtin_amdgcn_s_memrealtime() + (unsigned long long)((STAG_SEL) * (ticks)); \
        while (__builtin_amdgcn_s_memrealtime() < te_) __builtin_amdgcn_s_sleep(4); } __syncthreads(); } } while (0)
#ifndef STAG1
#define STAG1 0
#endif
#ifndef STAG4
#define STAG4 0
#endif
#ifndef STAG7
#define STAG7 0
#endif
#ifndef STAG8
#define STAG8 0
#endif
#ifndef STAG_SEL
#define STAG_SEL ((bx >> 3) & 1)
#endif
#ifdef CLKPROBE
    unsigned long long cp_t0 = 0, cp_r0 = 0, cp_t1 = 0, cp_r1 = 0;
#define CLK_BEGIN(k) do { if ((k) == CLKPROBE) { cp_t0 = __builtin_amdgcn_s_memtime(); cp_r0 = __builtin_amdgcn_s_memrealtime(); } } while (0)
#define CLK_END(k) do { if ((k) == CLKPROBE) { cp_t1 = __builtin_amdgcn_s_memtime(); cp_r1 = __builtin_amdgcn_s_memrealtime(); } } while (0)
#else
#define CLK_BEGIN(k) do {} while (0)
#define CLK_END(k) do {} while (0)
#endif
    if (IN(1)) { REP_LOOP(1) { REP_SYNC(); const int tid = opaque_tid(); (void)tid;
 CLK_BEGIN(1);
#if defined(KLOOP_PROBE) || defined(EPI_PROBE)
        if (tid == 0) MISC[17] = 1;
#endif
#ifndef P1_WGM
#define P1_WGM 8
#endif
        XCD_STAGGER(STAG1);
        pg8::StaticOrder S; S.init(T, INW, G, bx, P1_WGM);
        EpiInProj E{QA, KA, VAT, QB, KB, VBT, Gt, csT, args.var};
        pg8::gemm_phase(lds, XB, WIN, P1_FP8 ? 512 : 1024, S, pg8::ADense{}, E, pg8::NoHook{}); CLK_END(1);
#ifdef KLOOP_PROBE
        if (tid == 0) MISC[17] = 0;
#endif
    }
    }
    SEAM(1);

    if (IN(2)) { REP_LOOP(2) { REP_SYNC(); const int tid = opaque_tid(), lane = tid & 63, wave = __builtin_amdgcn_readfirstlane(tid >> 6), gw = bx * 8 + wave; (void)lane; (void)wave; (void)gw;

        __builtin_amdgcn_s_waitcnt(0x0F70);
        u32x4 pre[AT_NPRE];
        AttnUnit cu = attn_decode(bx, (qkv_t*)QA, (qkv_t*)KA, (qkv_t*)VAT, (qkv_t*)QB, (qkv_t*)KB, (qkv_t*)VBT, OAB, OG, LSE, sinks);
        if (bx < AT_NUNITS) attn_prefetch(cu, pre, tid);
        bf16x8 qf[4];
        if (bx < AT_NUNITS && wave < attn_ntask(cu)) attn_load_q(cu, wave, lane, qf);
        for (int id = bx; id < AT_NUNITS; id += G) {
            attn_stage(cu, pre, lds, tid);
            LDS_WAIT(); __builtin_amdgcn_s_barrier(); asm volatile("" ::: "memory");
            const AttnUnit me = cu;
            const bool has_nu = id + G < AT_NUNITS;
            if (has_nu) { cu = attn_decode(id + G, (qkv_t*)QA, (qkv_t*)KA, (qkv_t*)VAT, (qkv_t*)QB, (qkv_t*)KB, (qkv_t*)VBT, OAB, OG, LSE, sinks); attn_prefetch(cu, pre, tid); }
            attn_compute(me, cu, has_nu, lds, wave, lane, qf);
            LDS_WAIT(); __builtin_amdgcn_s_barrier(); asm volatile("" ::: "memory");
        }
    } }
    SEAM(2);

    if (IN(3)) { REP_LOOP(3) { REP_SYNC(); const int tid = opaque_tid(), lane = tid & 63, wave = __builtin_amdgcn_readfirstlane(tid >> 6), gw = bx * 8 + wave; (void)lane; (void)wave; (void)gw;

        for (size_t i = (size_t)bx * 512 + tid; i < (size_t)T * 32; i += (size_t)G * 512) {
            const size_t tok = i >> 5; const int hh = (int)(i >> 3) & 3, ch = (int)i & 7;
            const float l0 = LSE[tok * 12 + hh], l1 = LSE[tok * 12 + 4 + hh], l2 = LSE[tok * 12 + 8 + hh];
            const float mx = __builtin_fmaxf(l0, __builtin_fmaxf(l1, l2));
            float w0 = __builtin_amdgcn_exp2f(l0 - mx), w1 = __builtin_amdgcn_exp2f(l1 - mx), w2 = __builtin_amdgcn_exp2f(l2 - mx);
            const float inv = 1.0f / (w0 + w1 + w2); w0 *= inv; w1 *= inv; w2 *= inv;
            const u32x4 a = *(const u32x4*)(OG + tok * 768 + hh * 64 + ch * 8), c = *(const u32x4*)(OG + tok * 768 + (4 + hh) * 64 + ch * 8), d = *(const u32x4*)(OG + tok * 768 + (8 + hh) * 64 + ch * 8);
            u32x4 w;
            w.x = pk2(w0 * bflo(a.x) + w1 * bflo(c.x) + w2 * bflo(d.x), w0 * bfhi(a.x) + w1 * bfhi(c.x) + w2 * bfhi(d.x));
            w.y = pk2(w0 * bflo(a.y) + w1 * bflo(c.y) + w2 * bflo(d.y), w0 * bfhi(a.y) + w1 * bfhi(c.y) + w2 * bfhi(d.y));
            w.z = pk2(w0 * bflo(a.z) + w1 * bflo(c.z) + w2 * bflo(d.z), w0 * bfhi(a.z) + w1 * bfhi(c.z) + w2 * bfhi(d.z));
            w.w = pk2(w0 * bflo(a.w) + w1 * bflo(c.w) + w2 * bflo(d.w), w0 * bfhi(a.w) + w1 * bfhi(c.w) + w2 * bfhi(d.w));
#if P3_FP8
            { f32x4 lo, hi; lo = (f32x4){bflo(w.x), bfhi(w.x), bflo(w.y), bfhi(w.y)} * OA_SCALE; hi = (f32x4){bflo(w.z), bfhi(w.z), bflo(w.w), bfhi(w.w)} * OA_SCALE;
              u32x2 w8; w8.x = pk4_fp8(lo[0], lo[1], lo[2], lo[3]); w8.y = pk4_fp8(hi[0], hi[1], hi[2], hi[3]);
              *(u32x2*)((unsigned char*)OAB + tok * 1280 + 1024 + hh * 64 + ch * 8) = w8; }
#else
            *(u32x4*)(OAB + tok * 1280 + 1024 + hh * 64 + ch * 8) = w;
#endif
        }
        xcd_barrier(bar);
        pg8::StaticOrder S; S.init(T, 1024, G, bx);
        EpiMerged E{Gt, MERGED}; HookGateRatio HK{Gt};
        pg8::gemm_phase(lds, OAB, WAB, P3_FP8 ? 640 : 1280, S, pg8::ADense{}, E, HK);
    }
    }
    SEAM(3);

    if (IN(4)) { REP_LOOP(4) { REP_SYNC(); const int tid = opaque_tid(); (void)tid;

        XCD_STAGGER(STAG4);
        pg8::StaticOrder S; S.init(T, 1024, G, bx);
        EpiPre E{X_IN, OUTP, STATS, H1};
        pg8::gemm_phase(lds, MERGED, WOUT, P4_FP8 ? 512 : 1024, S, pg8::ADense{}, E, pg8::NoHook{});
    }
    }
    SEAM(4);

#if P5_SINGLE
    if (IN(5)) { REP_LOOP(5) { REP_SYNC(); const int tid = opaque_tid(), lane = tid & 63, wave = __builtin_amdgcn_readfirstlane(tid >> 6), gw = bx * 8 + wave; (void)gw;
        constexpr int GWROW = 2064;
        LAS unsigned char* GWH = lds; LAS unsigned char* GWL = lds + 32 * GWROW;
        LAS int* histL = (LAS int*)(lds + SCR_OFF); LAS float* brL = (LAS float*)(histL + 32); LAS float* gL = brL + 32; LAS float* bL = gL + 1024;
        { float wv[64];
#pragma unroll
          for (int i = 0; i < 64; ++i) wv[i] = w_router[tid + 512 * i];
#pragma unroll
          for (int i = 0; i < 64; ++i) { const int idx = tid + 512 * i, d = idx >> 5, e = idx & 31;
            const float v = wv[i]; const unsigned hb = pk2(v, 0.f) & 0xffffu; const float vh = __uint_as_float(hb << 16); const unsigned lb = pk2(v - vh, 0.f) & 0xffffu;
            ((LAS bf16_t*)(GWH + e * GWROW))[d] = (bf16_t)hb; ((LAS bf16_t*)(GWL + e * GWROW))[d] = (bf16_t)lb; } }
        for (int d = tid; d < 1024; d += 512) { gL[d] = ln1g[d]; bL[d] = ln1b[d]; }
        if (tid < 32) brL[tid] = b_router[tid];
        __syncthreads();
        const int r32 = lane & 31, hi5 = lane >> 5;
        for (int vw = bx; vw < 256; vw += G) {
            if (tid < 32) histL[tid] = 0;
            __syncthreads();
            const int tok0 = vw * 256 + wave * 32;
            float mean, rstd;
            { const f32x4* sp = (const f32x4*)(STATS + (size_t)(tok0 + r32) * 32); float s1 = 0.f, s2 = 0.f;
#pragma unroll
              for (int i = 0; i < 8; ++i) { const f32x4 t = sp[i]; s1 += t[0] + t[2]; s2 += t[1] + t[3]; }
              mean = s1 * (1.f / 1024.f); const float var = __builtin_fmaxf(s2 * (1.f / 1024.f) - mean * mean, 0.f); rstd = 1.0f / sqrtf(var + LN_EPS); }
            const float cc = -mean * rstd;
            if (hi5 == 0) *(f32x2*)((float*)(ws + WS_MR) + (size_t)(tok0 + r32) * 2) = (f32x2){rstd, cc};
#define P5_EO(kq) (32 * ((kq) >> 1) + 8 * ((kq) & 1))
            const bf16_t* src = H1 + (size_t)(tok0 + r32) * 1024 + 16 * hi5;
            unsigned char* h8p = H1F8 + (size_t)(tok0 + r32) * 1024 + 16 * hi5;
            const LAS unsigned char* ahp = GWH + r32 * GWROW + 32 * hi5; const LAS unsigned char* alp = GWL + r32 * GWROW + 32 * hi5;
            const LAS float* glp = gL + 16 * hi5; const LAS float* blp = bL + 16 * hi5;
            f32x16 acc0 = {}, acc1 = {}, acc2 = {};
            u32x4 xa[4], xb[4];
#define P5_LOAD(buf, ks0) do { _Pragma("unroll") for (int q_ = 0; q_ < 4; ++q_) buf[q_] = *(const u32x4*)(src + P5_EO((ks0) + q_)); } while (0)
#define P5_COMP(buf, ks0) do { u32x2 w8p_ = {0u, 0u}; _Pragma("unroll") for (int q_ = 0; q_ < 4; ++q_) { const int eo_ = 16 * (ks0) + 32 * (q_ >> 1) + 8 * (q_ & 1); \
                const f32x4 g0_ = *(const LAS f32x4*)(glp + eo_), g1_ = *(const LAS f32x4*)(glp + eo_ + 4), b0_ = *(const LAS f32x4*)(blp + eo_), b1_ = *(const LAS f32x4*)(blp + eo_ + 4); \
                const f32x4 p0_ = {bflo(buf[q_].x), bfhi(buf[q_].x), bflo(buf[q_].y), bfhi(buf[q_].y)}, p1_ = {bflo(buf[q_].z), bfhi(buf[q_].z), bflo(buf[q_].w), bfhi(buf[q_].w)}; \
                const f32x4 u0_ = (p0_ * rstd + cc) * g0_ + b0_, u1_ = (p1_ * rstd + cc) * g1_ + b1_; \
                u32x4 wh_, wl_; wh_.x = pk2(u0_[0], u0_[1]); wh_.y = pk2(u0_[2], u0_[3]); wh_.z = pk2(u1_[0], u1_[1]); wh_.w = pk2(u1_[2], u1_[3]); \
                { u32x2 w8_; w8_.x = pk4_fp8(u0_[0], u0_[1], u0_[2], u0_[3]); w8_.y = pk4_fp8(u1_[0], u1_[1], u1_[2], u1_[3]); \
                  if (q_ & 1) { u32x4 w16_; w16_.x = w8p_.x; w16_.y = w8p_.y; w16_.z = w8_.x; w16_.w = w8_.y; *(u32x4*)(h8p + eo_ - 8) = w16_; } else w8p_ = w8_; } \
                wl_.x = pk2(u0_[0] - bflo(wh_.x), u0_[1] - bfhi(wh_.x)); wl_.y = pk2(u0_[2] - bflo(wh_.y), u0_[3] - bfhi(wh_.y)); \
                wl_.z = pk2(u1_[0] - bflo(wh_.z), u1_[1] - bfhi(wh_.z)); wl_.w = pk2(u1_[2] - bflo(wh_.w), u1_[3] - bfhi(wh_.w)); \
                const bf16x8 bh_ = __builtin_bit_cast(bf16x8, wh_), bl_ = __builtin_bit_cast(bf16x8, wl_); \
                const bf16x8 ah_ = *(const LAS bf16x8*)(ahp + 2 * eo_), al_ = *(const LAS bf16x8*)(alp + 2 * eo_); \
                acc0 = __builtin_amdgcn_mfma_f32_32x32x16_bf16(ah_, bh_, acc0, 0, 0, 0); acc1 = __builtin_amdgcn_mfma_f32_32x32x16_bf16(ah_, bl_, acc1, 0, 0, 0); \
                acc2 = __builtin_amdgcn_mfma_f32_32x32x16_bf16(al_, bh_, acc2, 0, 0, 0); } } while (0)
            P5_LOAD(xa, 0);
            for (int it = 0; it < 8; ++it) {
                P5_LOAD(xb, 8 * it + 4);
                P5_COMP(xa, 8 * it);
                if (it < 7) P5_LOAD(xa, 8 * it + 8);
                P5_COMP(xb, 8 * it + 4);
            }
#undef P5_LOAD
#undef P5_COMP
#undef P5_EO
            float v[16];
#pragma unroll
            for (int i = 0; i < 16; ++i) v[i] = (acc0[i] + acc1[i] + acc2[i]) + brL[crow(i, hi5)];
            float cv[8]; int ce[8];
#pragma unroll
            for (int kk = 0; kk < 4; ++kk) {
                float bv = v[0]; int bi = 0;
#pragma unroll
                for (int i = 1; i < 16; ++i) if (v[i] > bv) { bv = v[i]; bi = i; }
                cv[kk] = bv; ce[kk] = crow(bi, hi5);
#pragma unroll
                for (int i = 0; i < 16; ++i) v[i] = (i == bi) ? -INFINITY : v[i];
            }
#pragma unroll
            for (int kk = 0; kk < 4; ++kk) { cv[4 + kk] = __shfl_xor(cv[kk], 32); ce[4 + kk] = __shfl_xor(ce[kk], 32); }
            float tv[4]; int te[4];
#pragma unroll
            for (int kk = 0; kk < 4; ++kk) {
                float bv = cv[0]; int be = ce[0], bi = 0;
#pragma unroll
                for (int i = 1; i < 8; ++i) if (cv[i] > bv || (cv[i] == bv && ce[i] < be)) { bv = cv[i]; be = ce[i]; bi = i; }
                tv[kk] = bv; te[kk] = be;
#pragma unroll
                for (int i = 0; i < 8; ++i) cv[i] = (i == bi) ? -INFINITY : cv[i];
            }
            { const float e1 = __expf(tv[1] - tv[0]), e2 = __expf(tv[2] - tv[0]), e3 = __expf(tv[3] - tv[0]); const float inv = 1.0f / (1.0f + e1 + e2 + e3);
              if (hi5 == 0) { const size_t tk = (size_t)(tok0 + r32) * 4;
                  *(int4*)(TOPE + tk) = make_int4(te[0], te[1], te[2], te[3]); *(f32x4*)(TOPW + tk) = (f32x4){inv, e1 * inv, e2 * inv, e3 * inv};
                  atomicAdd((int*)(histL + te[0]), 1); atomicAdd((int*)(histL + te[1]), 1); atomicAdd((int*)(histL + te[2]), 1); atomicAdd((int*)(histL + te[3]), 1); } }
            __syncthreads();
            if (tid < 32) HIST[vw * 32 + tid] = histL[tid];
            __syncthreads();
        }
    } }
#else
    if (IN(5)) { REP_LOOP(5) { REP_SYNC(); const int tid = opaque_tid(), lane = tid & 63, wave = __builtin_amdgcn_readfirstlane(tid >> 6), gw = bx * 8 + wave; (void)lane; (void)wave; (void)gw;

        constexpr int GWROW = 2064;
        LAS unsigned char* GWH = lds; LAS unsigned char* GWL = lds + 32 * GWROW;
        LAS float* gws = (LAS float*)(lds + SCR_OFF); LAS float* bws = gws + 32; LAS int* histL = (LAS int*)(bws + 32); LAS float* partL = (LAS float*)(histL + 32);
        for (int idx = tid; idx < 32 * 1024; idx += 512) { const int d = idx >> 5, e = idx & 31;
            const float v = w_router[idx] * ln1g[d]; const unsigned hb = pk2(v, 0.f) & 0xffffu; const float vh = __uint_as_float(hb << 16); const unsigned lb = pk2(v - vh, 0.f) & 0xffffu;
            ((LAS bf16_t*)(GWH + e * GWROW))[d] = (bf16_t)hb; ((LAS bf16_t*)(GWL + e * GWROW))[d] = (bf16_t)lb; }
        { const int e = tid & 31, p = tid >> 5; float sg = 0.f, sb = 0.f;
          for (int d = 64 * p; d < 64 * p + 64; ++d) { const float w = w_router[d * 32 + e]; sg += ln1g[d] * w; sb += ln1b[d] * w; }
          partL[(p * 32 + e) * 2] = sg; partL[(p * 32 + e) * 2 + 1] = sb; }
        __syncthreads();
        if (tid < 32) { float sg = 0.f, sb = 0.f; for (int p = 0; p < 16; ++p) { sg += partL[(p * 32 + tid) * 2]; sb += partL[(p * 32 + tid) * 2 + 1]; } gws[tid] = sg; bws[tid] = sb + b_router[tid]; }
        __syncthreads();
        const int r32 = lane & 31, hi5 = lane >> 5;
        for (int vw = bx; vw < 256; vw += G) {
            if (tid < 32) histL[tid] = 0;
            __syncthreads();
            const int tok0 = vw * 256 + wave * 32;
            const float* src = OUTP + (size_t)(tok0 + r32) * 1024 + 8 * hi5;
            const LAS unsigned char* ahp = GWH + r32 * GWROW + 16 * hi5; const LAS unsigned char* alp = GWL + r32 * GWROW + 16 * hi5;
            f32x16 acc0 = {}, acc1 = {}, acc2 = {};
            float s1 = 0.f, s2 = 0.f;
            f32x4 xa[4][2], xb[4][2];
#define P5_LOAD(buf, ks0) do { _Pragma("unroll") for (int q_ = 0; q_ < 4; ++q_) { buf[q_][0] = *(const f32x4*)(src + 16 * ((ks0) + q_)); buf[q_][1] = *(const f32x4*)(src + 16 * ((ks0) + q_) + 4); } } while (0)
#define P5_COMP(buf, ks0) do { _Pragma("unroll") for (int q_ = 0; q_ < 4; ++q_) { const f32x4 u0_ = buf[q_][0], u1_ = buf[q_][1]; \
                s1 += (u0_[0] + u0_[1]) + (u0_[2] + u0_[3]) + (u1_[0] + u1_[1]) + (u1_[2] + u1_[3]); \
                s2 += (u0_[0] * u0_[0] + u0_[1] * u0_[1]) + (u0_[2] * u0_[2] + u0_[3] * u0_[3]) + (u1_[0] * u1_[0] + u1_[1] * u1_[1]) + (u1_[2] * u1_[2] + u1_[3] * u1_[3]); \
                u32x4 wh_, wl_; wh_.x = pk2(u0_[0], u0_[1]); wh_.y = pk2(u0_[2], u0_[3]); wh_.z = pk2(u1_[0], u1_[1]); wh_.w = pk2(u1_[2], u1_[3]); \
                wl_.x = pk2(u0_[0] - bflo(wh_.x), u0_[1] - bfhi(wh_.x)); wl_.y = pk2(u0_[2] - bflo(wh_.y), u0_[3] - bfhi(wh_.y)); \
                wl_.z = pk2(u1_[0] - bflo(wh_.z), u1_[1] - bfhi(wh_.z)); wl_.w = pk2(u1_[2] - bflo(wh_.w), u1_[3] - bfhi(wh_.w)); \
                const bf16x8 bh_ = __builtin_bit_cast(bf16x8, wh_), bl_ = __builtin_bit_cast(bf16x8, wl_); \
                const bf16x8 ah_ = *(const LAS bf16x8*)(ahp + 32 * ((ks0) + q_)), al_ = *(const LAS bf16x8*)(alp + 32 * ((ks0) + q_)); \
                acc0 = __builtin_amdgcn_mfma_f32_32x32x16_bf16(ah_, bh_, acc0, 0, 0, 0); acc1 = __builtin_amdgcn_mfma_f32_32x32x16_bf16(ah_, bl_, acc1, 0, 0, 0); \
                acc2 = __builtin_amdgcn_mfma_f32_32x32x16_bf16(al_, bh_, acc2, 0, 0, 0); } } while (0)
            P5_LOAD(xa, 0);
            for (int it = 0; it < 8; ++it) {
                P5_LOAD(xb, 8 * it + 4);
                P5_COMP(xa, 8 * it);
                if (it < 7) P5_LOAD(xa, 8 * it + 8);
                P5_COMP(xb, 8 * it + 4);
            }
#undef P5_LOAD
#undef P5_COMP
            s1 += __shfl_xor(s1, 32); s2 += __shfl_xor(s2, 32);
            const float mean = s1 * (1.f / 1024.f), var = __builtin_fmaxf(s2 * (1.f / 1024.f) - mean * mean, 0.f), rstd = 1.0f / sqrtf(var + LN_EPS);
            float v[16];
#pragma unroll
            for (int i = 0; i < 16; ++i) v[i] = rstd * ((acc0[i] + acc1[i] + acc2[i]) - mean * gws[crow(i, hi5)]) + bws[crow(i, hi5)];
            float cv[8]; int ce[8];
#pragma unroll
            for (int kk = 0; kk < 4; ++kk) {
                float bv = v[0]; int bi = 0;
#pragma unroll
                for (int i = 1; i < 16; ++i) if (v[i] > bv) { bv = v[i]; bi = i; }
                cv[kk] = bv; ce[kk] = crow(bi, hi5);
#pragma unroll
                for (int i = 0; i < 16; ++i) v[i] = (i == bi) ? -INFINITY : v[i];
            }
#pragma unroll
            for (int kk = 0; kk < 4; ++kk) { cv[4 + kk] = __shfl_xor(cv[kk], 32); ce[4 + kk] = __shfl_xor(ce[kk], 32); }
            float tv[4]; int te[4];
#pragma unroll
            for (int kk = 0; kk < 4; ++kk) {
                float bv = cv[0]; int be = ce[0], bi = 0;
#pragma unroll
                for (int i = 1; i < 8; ++i) if (cv[i] > bv || (cv[i] == bv && ce[i] < be)) { bv = cv[i]; be = ce[i]; bi = i; }
                tv[kk] = bv; te[kk] = be;
#pragma unroll
                for (int i = 0; i < 8; ++i) cv[i] = (i == bi) ? -INFINITY : cv[i];
            }
            { const float e1 = __expf(tv[1] - tv[0]), e2 = __expf(tv[2] - tv[0]), e3 = __expf(tv[3] - tv[0]); const float inv = 1.0f / (1.0f + e1 + e2 + e3);
              if (hi5 == 0) { const size_t tk = (size_t)(tok0 + r32) * 4;
                  *(int4*)(TOPE + tk) = make_int4(te[0], te[1], te[2], te[3]); *(f32x4*)(TOPW + tk) = (f32x4){inv, e1 * inv, e2 * inv, e3 * inv};
                  atomicAdd((int*)(histL + te[0]), 1); atomicAdd((int*)(histL + te[1]), 1); atomicAdd((int*)(histL + te[2]), 1); atomicAdd((int*)(histL + te[3]), 1); } }
            f32x4 gg[4], bb[4];
#pragma unroll
            for (int j = 0; j < 4; ++j) { gg[j] = *(const f32x4*)(ln1g + 4 * lane + 256 * j); bb[j] = *(const f32x4*)(ln1b + 4 * lane + 256 * j); }
#pragma unroll 4
            for (int i = 0; i < 32; ++i) {
                const float mi = __uint_as_float(__builtin_amdgcn_readlane(__float_as_uint(mean), i)), ri = __uint_as_float(__builtin_amdgcn_readlane(__float_as_uint(rstd), i));
                const float* pp = OUTP + (size_t)(tok0 + i) * 1024 + 4 * lane; bf16_t* hp = H1 + (size_t)(tok0 + i) * 1024 + 4 * lane;
#pragma unroll
                for (int j = 0; j < 4; ++j) { const f32x4 xv = (*(const f32x4*)(pp + 256 * j) - mi) * ri * gg[j] + bb[j]; u32x2 w; w.x = pk2(xv[0], xv[1]); w.y = pk2(xv[2], xv[3]); *(u32x2*)(hp + 256 * j) = w;
                    *(unsigned*)(H1F8 + (size_t)(tok0 + i) * 1024 + 4 * lane + 256 * j) = pk4_fp8(xv[0], xv[1], xv[2], xv[3]); }
            }
            __syncthreads();
            if (tid < 32) HIST[vw * 32 + tid] = histL[tid];
            __syncthreads();
        }
    } }
#endif
    SEAM(5);

    if (IN(6)) { REP_LOOP(6) { REP_SYNC(); const int tid = opaque_tid(), lane = tid & 63, wave = __builtin_amdgcn_readfirstlane(tid >> 6), gw = bx * 8 + wave; (void)lane; (void)wave; (void)gw;

        LAS int* part = (LAS int*)(lds + SCR_OFF);
        LAS int* cntL = part + 512; LAS int* befL = cntL + 32; LAS int* tstL = befL + 32; LAS int* baseL = tstL + 40; LAS int* curL = baseL + 32;
        for (int vw = bx; vw < 256; vw += G) {
            constexpr int WH = 256 / NHALF, GP = WH / 16;
            const int hf = vw / WH, wl = vw % WH;
            { const int e = tid & 31, p = tid >> 5; int s = 0;
              for (int i = 0; i < GP; ++i) s += HIST[(WH * hf + GP * p + i) * 32 + e];
              part[p * 32 + e] = s; }
            __syncthreads();
            if (tid < 32) { int tot = 0, bef = 0; const int pw = wl / GP, iw = wl % GP;
                for (int p = 0; p < 16; ++p) { const int v = part[p * 32 + tid]; tot += v; if (p < pw) bef += v; }
                for (int i = 0; i < iw; ++i) bef += HIST[(WH * hf + GP * pw + i) * 32 + tid];
                cntL[tid] = tot; befL[tid] = bef; curL[tid] = 0; }
            __syncthreads();
            if (tid == 0) { int run = 0; for (int e = 0; e < 32; ++e) { tstL[e] = run; run += (cntL[e] + 255) >> 8; } tstL[32] = run; }
            __syncthreads();
            if (tid < 32) baseL[tid] = tstL[tid] * 256 + befL[tid];
            __syncthreads();
            int* rt = ROWTOK + (size_t)hf * HROWS; int* rd = ROWDST + (size_t)hf * HROWS;
            for (int idx = tid; idx < 1024; idx += 512) {
                const int tok = vw * 256 + (idx >> 2), kk = idx & 3, e = TOPE[(size_t)tok * 4 + kk];
                const int pos = baseL[e] + atomicAdd((int*)(curL + e), 1);
                rt[pos] = tok; rd[pos] = (tok - hf * HALF_T) * 4 + kk;
            }
            if (wl < 32) { const int e = wl, r0 = tstL[e] * 256 + cntL[e], r1 = tstL[e + 1] * 256;
                for (int r = r0 + tid; r < r1; r += 512) { rt[r] = hf * HALF_T; rd[r] = -1; } }
            if (wl == 32) { int* te = TILEE + hf * 2048; const int nt = tstL[32];
                for (int t = tid; t < nt; t += 512) { int e = 0; for (int q = 1; q < 32; ++q) if (t >= tstL[q]) e = q; te[t] = e; }
                if (tid == 0) te[2040] = nt; }
            __syncthreads();
        }
    }
    }
    SEAM(6);

#pragma unroll
    for (int hf = 0; hf < NHALF; ++hf) {
        const int p_gu = 7 + 2 * hf, p_dn = 8 + 2 * hf, p_cb = 9 + 2 * hf;
        const int* te = TILEE + hf * 2048; const int* rt = ROWTOK + (size_t)hf * HROWS; const int* rd = ROWDST + (size_t)hf * HROWS;
        if (IN(p_gu)) { REP_LOOP(p_gu) { REP_SYNC(); const int tid = opaque_tid();
            const int NT = te[2040];
            LAS int* teL = (LAS int*)(lds + SCR_OFF);
            for (int t = tid; t < NT; t += 512) teL[t] = te[t];
            __syncthreads();
            XCD_STAGGER(STAG7);
            pg8::MoeOrder S; S.init(teL, NT, 8, G, bx);
            EpiSwiglu E{b_gu, Hh};
#ifdef KLOOP_PROBE
            if (tid == 0) MISC[17] = (KLOOP_PROBE == p_gu);
#endif
            CLK_BEGIN(p_gu); pg8::gemm_phase(lds, (const bf16_t*)H1F8, (const bf16_t*)WGU, 512, S, pg8::AGather{rt}, E, pg8::NoHook{});
#ifdef KLOOP_PROBE
            if (tid == 0) MISC[17] = 0;
#endif
        } }
        SEAM(p_gu);
        if (IN(p_dn)) { REP_LOOP(p_dn) { REP_SYNC(); const int tid = opaque_tid();
            const int NT = te[2040];
            LAS int* teL = (LAS int*)(lds + SCR_OFF);
            for (int t = tid; t < NT; t += 512) teL[t] = te[t];
            __syncthreads();
            XCD_STAGGER(STAG8);
            pg8::MoeOrder S; S.init(teL, NT, 4, G, bx);
            EpiDown E{b_dn, rd, Y};
            pg8::gemm_phase(lds, (const bf16_t*)Hh, (const bf16_t*)WDN, 512, S, pg8::ADense{}, E, pg8::NoHook{});
        } }
        SEAM(p_dn);
        if (IN(p_cb)) { REP_LOOP(p_cb + 3) { REP_SYNC();
            f32x4 g2[4], b2[4];
            int lq = threadIdx.x & 63; asm volatile("" : "+v"(lq));
#define lane lq
#pragma unroll
            for (int j = 0; j < 2; ++j) { g2[2 * j] = *(const f32x4*)(ln2g + 8 * lane + 512 * j); g2[2 * j + 1] = *(const f32x4*)(ln2g + 8 * lane + 512 * j + 4);
                b2[2 * j] = *(const f32x4*)(ln2b + 8 * lane + 512 * j); b2[2 * j + 1] = *(const f32x4*)(ln2b + 8 * lane + 512 * j + 4); }
            f32x4 g1a[4], b1a[4];
#pragma unroll
            for (int j = 0; j < 2; ++j) { g1a[2 * j] = *(const f32x4*)(ln1g + 8 * lane + 512 * j) * ALPHA; g1a[2 * j + 1] = *(const f32x4*)(ln1g + 8 * lane + 512 * j + 4) * ALPHA;
                b1a[2 * j] = *(const f32x4*)(ln1b + 8 * lane + 512 * j) * ALPHA; b1a[2 * j + 1] = *(const f32x4*)(ln1b + 8 * lane + 512 * j + 4) * ALPHA; }
            for (int tl = gw; tl < HALF_T; tl += NGW) {
                const int tok = hf * HALF_T + tl;
                const f32x4 wv = *(const f32x4*)(TOPW + (size_t)tok * 4);
                const f32x2 mr = *(const f32x2*)((const float*)(ws + WS_MR) + (size_t)tok * 2);
                f32x4 v[4]; float s = 0.f;
#pragma unroll
                for (int j = 0; j < 2; ++j) {
                    const int c = 8 * lane + 512 * j;
                    const u32x4 hh = *(const u32x4*)(H1 + (size_t)tok * 1024 + c);
                    f32x4 a = ((f32x4){bflo(hh.x), bfhi(hh.x), bflo(hh.y), bfhi(hh.y)} * mr[0] + mr[1]) * g1a[2 * j] + b1a[2 * j], b = ((f32x4){bflo(hh.z), bfhi(hh.z), bflo(hh.w), bfhi(hh.w)} * mr[0] + mr[1]) * g1a[2 * j + 1] + b1a[2 * j + 1];
#pragma unroll
#if Y_FP8
                    for (int kk = 0; kk < 4; ++kk) { const u32x2 yy = *(const u32x2*)((const unsigned char*)Y + ((size_t)tl * 4 + kk) * 1024 + c); const float w = wv[kk];
                        a += fp8x4_f32(yy.x) * w; b += fp8x4_f32(yy.y) * w; }
#else
                    for (int kk = 0; kk < 4; ++kk) { const u32x4 yy = *(const u32x4*)(Y + ((size_t)tl * 4 + kk) * 1024 + c); const float w = wv[kk];
                        a += (f32x4){bflo(yy.x), bfhi(yy.x), bflo(yy.y), bfhi(yy.y)} * w; b += (f32x4){bflo(yy.z), bfhi(yy.z), bflo(yy.w), bfhi(yy.w)} * w; }
#endif
                    v[2 * j] = a; v[2 * j + 1] = b; s += (a[0] + a[1]) + (a[2] + a[3]) + (b[0] + b[1]) + (b[2] + b[3]);
                }
                const float mean = wave_sum(s) * (1.f / 1024.f); float s2 = 0.f;
#pragma unroll
                for (int j = 0; j < 4; ++j) { v[j] = v[j] - mean; s2 += (v[j][0] * v[j][0] + v[j][1] * v[j][1]) + (v[j][2] * v[j][2] + v[j][3] * v[j][3]); }
                const float rstd = 1.0f / sqrtf(wave_sum(s2) * (1.f / 1024.f) + LN_EPS);
                float* op = OUTP + (size_t)tok * 1024 + 8 * lane;
#pragma unroll
                for (int j = 0; j < 2; ++j) { *(f32x4*)(op + 512 * j) = v[2 * j] * rstd * g2[2 * j] + b2[2 * j]; *(f32x4*)(op + 512 * j + 4) = v[2 * j + 1] * rstd * g2[2 * j + 1] + b2[2 * j + 1]; }
            }
#undef lane
        } }
    }
#if defined(KLOOP_PROBE) || defined(EPI_PROBE)
    if (bx == 0 && tid == 0) {
        const unsigned long long tend = __builtin_amdgcn_s_memrealtime() + (unsigned long long)MISC[16] * 16ull / 10ull;
        while (__builtin_amdgcn_s_memrealtime() < tend) __builtin_amdgcn_s_sleep(8);
    }
#endif
#ifdef CLKPROBE
    if (bx == 0 && tid == 0 && cp_r1 > cp_r0) {
        const unsigned long long mhz = (cp_t1 - cp_t0) * 100ull / (cp_r1 - cp_r0);
        const unsigned long long tend = __builtin_amdgcn_s_memrealtime() + mhz * 100ull;
        while (__builtin_amdgcn_s_memrealtime() < tend) __builtin_amdgcn_s_sleep(8);
    }
#endif
#undef IN
#undef SEAM
}

extern "C" void kernel_launch(void* const* d_in, const int* in_sizes, int n_in, void* d_out, int out_size, void* d_ws, size_t ws_size, hipStream_t stream) {
    static int grid = 0;
    if (grid == 0) {
        if (n_in != 16 || in_sizes[0] != T * D || out_size != T * D || ws_size < WS_END) { fprintf(stderr, "kernel_launch: unexpected shapes / workspace (%d inputs, ws %zu)\n", n_in, ws_size); grid = -1; return; }
        int dev = 0, cus = 0, per_cu = 0;
        if (hipGetDevice(&dev) != hipSuccess || hipDeviceGetAttribute(&cus, hipDeviceAttributeMultiprocessorCount, dev) != hipSuccess) { grid = -1; return; }
        if (hipFuncSetAttribute((const void*)mk_fwd, hipFuncAttributeMaxDynamicSharedMemorySize, LDS_BYTES) != hipSuccess) { fprintf(stderr, "kernel_launch: hipFuncSetAttribute failed\n"); grid = -1; return; }
        if (hipOccupancyMaxActiveBlocksPerMultiprocessor(&per_cu, (const void*)mk_fwd, 512, LDS_BYTES) != hipSuccess || per_cu < 1) { fprintf(stderr, "kernel_launch: occupancy query says %d\n", per_cu); }
        (void)hipGetLastError();
        grid = cus;
    }
    if (grid < 0) return;
    if (hipMemsetAsync((char*)d_ws + WS_CTL, 0, CTL_ZERO_BYTES, stream) != hipSuccess) return;
    Args a{};
    for (int i = 0; i < 16; ++i) a.in[i] = (const float*)d_in[i];
    a.out = (float*)d_out; a.ws = (unsigned char*)d_ws;
#if MK_ONE_LAUNCH && defined(PROBE_SPLIT)
    a.ph_lo = 0; a.ph_hi = PROBE_SPLIT + 1; a.li = 0;
#ifdef PROBE_VAR
    a.var = PROBE_VAR;
#endif
    hipLaunchKernelGGL(mk_fwd, dim3(grid), dim3(512), LDS_BYTES, stream, a);
    a.ph_lo = PROBE_SPLIT; a.ph_hi = NPHASE; a.li = 1; a.var = 0;
    hipLaunchKernelGGL(mk_fwd, dim3(grid), dim3(512), LDS_BYTES, stream, a);
#elif MK_ONE_LAUNCH
    a.ph_lo = 0; a.ph_hi = NPHASE;
    hipLaunchKernelGGL(mk_fwd, dim3(grid), dim3(512), LDS_BYTES, stream, a);
#else
    for (int p = 0; p < NPHASE; ++p) { a.ph_lo = p; a.ph_hi = p + 1; hipLaunchKernelGGL(mk_fwd, dim3(grid), dim3(512), LDS_BYTES, stream, a); }
#endif
}
```

```cpp
#include <hip/hip_runtime.h>
#include <cstdio>
#include <cstdint>

#ifndef MK_ONE_LAUNCH
#define MK_ONE_LAUNCH 1
#endif
#ifndef P5_SINGLE
#define ATT_QK8 1
#define PRE16 1
#define P5_SINGLE 1
#endif
#ifndef QKV_FP8
#define QKV_FP8 1
#endif
#ifndef P3_FP8
#define P3_FP8 1
#endif
#ifndef G_FP8
#define G_FP8 1
#endif
#ifndef Y_FP8
#define Y_FP8 1
#endif
#ifndef P4_FP8
#define P4_FP8 1
#endif
#ifndef P1_FP8
#define P1_FP8 1
#endif

#define LAS __attribute__((address_space(3)))
#define GAS __attribute__((address_space(1)))
typedef unsigned short bf16_t;
typedef short bf16x8 __attribute__((ext_vector_type(8)));
typedef short s16x4 __attribute__((ext_vector_type(4)));
typedef float f32x4 __attribute__((ext_vector_type(4)));
typedef float f32x2 __attribute__((ext_vector_type(2)));
typedef float f32x16 __attribute__((ext_vector_type(16)));
typedef unsigned u32x4 __attribute__((ext_vector_type(4)));
typedef unsigned u32x2 __attribute__((ext_vector_type(2)));
typedef __bf16 bf16x2_t __attribute__((ext_vector_type(2)));
typedef int v4i32_t __attribute__((ext_vector_type(4)));
typedef int v8i32_t __attribute__((ext_vector_type(8)));

constexpr int SEQ = 2048, NB = 32, T = NB * SEQ, D = 1024, INW = 5888, NE = 32, TOPK = 4;
constexpr float LN_EPS = 1e-5f;
constexpr float ALPHA = 1.189207115002721f;
constexpr float LOG2E = 1.4426950408889634f;
constexpr float QSCALE = 0.125f * LOG2E;
constexpr float W8_SCALE = 32.0f, W8_INV = 1.0f / 32.0f, MG_SCALE = 16.0f, MG_INV = 1.0f / 16.0f, OA_SCALE = 16.0f, OA_INV = 1.0f / 16.0f;
#ifndef NHALF
#define NHALF 1
#endif
constexpr int HALF_T = T / NHALF;
constexpr int HROWS = HALF_T * TOPK + NE * 256;
constexpr int HTILES = HROWS / 256;

constexpr size_t MiB = 1u << 20;
constexpr size_t WS_CTL = 0, CTL_ZERO_BYTES = 1 * MiB;
constexpr size_t WS_COS = 1 * MiB;
constexpr size_t WS_WIN = 2 * MiB;
constexpr size_t WS_WAB = 14 * MiB;
constexpr size_t WS_WOUT = 17 * MiB;
constexpr size_t WS_TOPE = 19 * MiB, WS_TOPW = 20 * MiB, WS_HIST = 21 * MiB;
constexpr size_t WS_ROWTOK = 22 * MiB, WS_ROWDST = 24 * MiB, WS_TILEE = 26 * MiB;
constexpr size_t WS_WGU = 32 * MiB;
constexpr size_t WS_WDN = 96 * MiB;
constexpr size_t WS_H1F8 = 352 * MiB;
constexpr size_t WS_OAB = 224 * MiB;
constexpr size_t WS_XB = 224 * MiB;
constexpr size_t WS_H1 = 224 * MiB;
constexpr size_t WS_G = 384 * MiB;
constexpr size_t WS_KB = 640 * MiB;
constexpr size_t WS_VAT = 736 * MiB;
constexpr size_t WS_VBT = 768 * MiB;
constexpr size_t WS_OG = 864 * MiB;
constexpr size_t WS_STATS = 964 * MiB;
constexpr size_t WS_LSE = 960 * MiB;
constexpr size_t WS_MERGED = 640 * MiB;
constexpr size_t WS_H = 416 * MiB;
constexpr size_t WS_Y = 680 * MiB;
constexpr size_t WS_MR = 973 * MiB;
constexpr size_t WS_END = 1024 * MiB;
static_assert(WS_H1F8 + (size_t)T * 1024 <= WS_H && WS_H + (size_t)HROWS * 1024 <= WS_Y && WS_Y + ((size_t)HALF_T * 4 + 1) * 1024 * 2 <= WS_END + (size_t)HALF_T * 4 * 1024, "ws map");
static_assert(WS_Y + ((size_t)HALF_T * 4 + 1) * 1024 <= WS_END && (size_t)NHALF * HROWS * 4 <= 2 * MiB && HTILES * 4 + 256 <= 8192, "ws / LDS tables");
static_assert(WS_LSE + (size_t)T * 12 * 4 <= WS_END && WS_OG + (size_t)T * 768 * 2 <= WS_LSE && WS_VBT + (size_t)T * 768 * 2 <= WS_OG, "ws map");
constexpr size_t DO_QA = 0, DO_QB = 128 * MiB, DO_KA = 224 * MiB;

constexpr int CW_TMO = 0, CW_CODE = 1, CW_BAR = 4096;

constexpr int RING_BYTES = 131072;
constexpr int LDSCTL_OFF = 135168, MISC_OFF = LDSCTL_OFF + 320, SCR_OFF = LDSCTL_OFF + 1024;
constexpr int LDS_BYTES = 151552;

#define RLX_AGENT __ATOMIC_RELAXED, __HIP_MEMORY_SCOPE_AGENT
#define LDS_WAIT() asm volatile("s_waitcnt lgkmcnt(0)" ::: "memory")
#define VM_WAIT() asm volatile("s_waitcnt vmcnt(0)" ::: "memory")
__device__ __forceinline__ unsigned pk2(float lo, float hi) { f32x2 v = {lo, hi}; bf16x2_t b = __builtin_convertvector(v, bf16x2_t); return __builtin_bit_cast(unsigned, b); }
__device__ __forceinline__ unsigned pk4_fp8(float a, float b, float c, float d) { int w = __builtin_amdgcn_cvt_pk_fp8_f32(a, b, 0, false); w = __builtin_amdgcn_cvt_pk_fp8_f32(c, d, w, true); return (unsigned)w; }
__device__ __forceinline__ f32x4 fp8x4_f32(unsigned w) { const f32x2 lo = __builtin_amdgcn_cvt_pk_f32_fp8((int)w, false), hi = __builtin_amdgcn_cvt_pk_f32_fp8((int)w, true); return (f32x4){lo[0], lo[1], hi[0], hi[1]}; }
__device__ __forceinline__ float bflo(unsigned w) { return __uint_as_float(w << 16); }
__device__ __forceinline__ float bfhi(unsigned w) { return __uint_as_float(w & 0xffff0000u); }
__device__ __forceinline__ float fast_sigmoid(float z) { return __builtin_amdgcn_rcpf(1.0f + __builtin_amdgcn_exp2f(-z * LOG2E)); }
__device__ __forceinline__ float wave_sum(float v) {
#pragma unroll
    for (int o = 1; o < 64; o <<= 1) v += __shfl_xor(v, o);
    return v;
}

#define XB_TMO      128
#define XB_XCNT(j)  (256  + 64 * (j))
#define XB_XSUB(j)  (1280 + 64 * (j))
#define XB_XGEN(j)  (2304 + 64 * (j))
#define XB_TOP      3328
#define XB_TOPGEN   3392
#define XCD_BAR_WORDS 3456
#define XB_SPIN_CAP (1u << 18)
__device__ __forceinline__ unsigned xb_ld(unsigned* p)              { return __hip_atomic_load(p, __ATOMIC_RELAXED, __HIP_MEMORY_SCOPE_AGENT); }
__device__ __forceinline__ unsigned xb_add(unsigned* p, unsigned v) { return __hip_atomic_fetch_add(p, v, __ATOMIC_RELAXED, __HIP_MEMORY_SCOPE_AGENT); }
__device__ __forceinline__ unsigned xb_xcc_id() { return (unsigned)__builtin_amdgcn_s_getreg((3 << 11) | 20) & 0xFu; }
#define XB_SPIN(cond, bar) do { unsigned _sp = 0; while (cond) { __builtin_amdgcn_s_sleep(1); \
    if ((++_sp & 255u) == 0u) { if (xb_ld(&(bar)[XB_TMO])) break; if (_sp > XB_SPIN_CAP) { atomicAdd(&(bar)[XB_TMO], 1u); break; } } } } while (0)
struct XcdBarrier { unsigned* bar; unsigned x; volatile LAS unsigned* st; };
__device__ __forceinline__ XcdBarrier xcd_barrier_post(unsigned* bar, volatile LAS unsigned* st) {
    XcdBarrier b; b.bar = bar; b.x = xb_xcc_id(); b.st = st;
    if (threadIdx.x == 0) (void)xb_add(&bar[XB_XCNT(b.x)], 1u);
    return b;
}
__device__ __forceinline__ void xcd_barrier_complete(unsigned* bar, unsigned x, unsigned& nloc, unsigned& nx) {
    const unsigned G = gridDim.x * gridDim.y * gridDim.z;
    unsigned sum, cnt, mine, sp = 0u;
    for (;;) {
        sum = 0u; cnt = 0u; mine = 0u;
#pragma unroll
        for (unsigned j = 0; j < 16; ++j) { const unsigned c = xb_ld(&bar[XB_XCNT(j)]); sum += c; cnt += (c > 0u) ? 1u : 0u; mine = (j == x) ? c : mine; }
        if (sum == G) break;
        __builtin_amdgcn_s_sleep(1);
        if ((++sp & 255u) == 0u) { if (xb_ld(&bar[XB_TMO])) break; if (sp > XB_SPIN_CAP) { atomicAdd(&bar[XB_TMO], 1u); break; } }
    }
    nloc = mine > 0u ? mine : 1u; nx = cnt > 0u ? cnt : 1u;
}
__device__ __forceinline__ void xcd_barrier(const XcdBarrier& b) {
    asm volatile("s_waitcnt vmcnt(0)" ::: "memory");
    __syncthreads();
    if (threadIdx.x == 0) {
        unsigned* bar = b.bar;
        __builtin_amdgcn_s_waitcnt(0);
        unsigned nloc = b.st[0], nx = b.st[1];
        if (nloc == 0u) { xcd_barrier_complete(bar, b.x, nloc, nx); b.st[0] = nloc; b.st[1] = nx; }
        const unsigned old = xb_add(&bar[XB_XSUB(b.x)], 1u);
        const unsigned gen = old / nloc;
        if (old + 1u == (gen + 1u) * nloc) {
            __builtin_amdgcn_fence(__ATOMIC_RELEASE, "agent");
            asm volatile("s_waitcnt vmcnt(0)" ::: "memory");
            const unsigned og = xb_add(&bar[XB_TOP], 1u);
            const unsigned tg = og / nx;
            if (og + 1u == (tg + 1u) * nx) xb_add(&bar[XB_TOPGEN], 1u);
            else XB_SPIN(xb_ld(&bar[XB_TOPGEN]) == tg, bar);
            __builtin_amdgcn_fence(__ATOMIC_ACQUIRE, "agent");
            xb_add(&bar[XB_XGEN(b.x)], 1u);
            asm volatile("s_waitcnt vmcnt(0)" ::: "memory");
        } else {
            XB_SPIN(xb_ld(&bar[XB_XGEN(b.x)]) == gen, bar);
            __builtin_amdgcn_fence(__ATOMIC_ACQUIRE, "agent");
            asm volatile("s_waitcnt vmcnt(0)" ::: "memory");
        }
    }
    __syncthreads();
}

namespace pg8 {
constexpr int BM = 256, BK = 64, HALF = 128, HTB = HALF * BK * 2, STAGE_BYTES = 8 * HTB, NXCD = 8;
__host__ __device__ __forceinline__ int lds_byte(int r, int c) { const int st = (r >> 4) * 2 + (c >> 5), rr = r & 15, cc = c & 31, ob = rr * 64 + cc * 2; return st * 1024 + (ob ^ (((ob >> 9) & 1) << 5)); }
__host__ __device__ __forceinline__ void stage_rc(int b, int& R, int& C) { const int st = b / 1024, sb = b % 1024, swz = sb ^ (((sb >> 9) & 1) << 5); R = (st >> 1) * 16 + swz / 64; C = (st & 1) * 32 + (swz % 64) / 2; }
__host__ __device__ __forceinline__ int perm32(int rho) { const int n = rho >> 4, i = rho & 15; return 8 * (i >> 2) + 4 * n + (i & 3); }

struct Unit { int pm, pn; };

struct StaticOrder {
    int nM, nN, nwg, G, c, WGM;
    __device__ void init(int M, int N, int G_, int c_, int wgm = 8) { nM = M / BM; nN = N / BM; nwg = nM * nN; G = G_; c = c_; WGM = wgm; }
    __device__ bool next(int i, Unit& u) const {
        const long L = (long)i * G + c; if (L >= nwg) return false;
        int wgid = (int)L; { const int q = nwg / NXCD, r = nwg % NXCD, xcd = wgid % NXCD, off = wgid / NXCD; wgid = (xcd < r ? xcd * (q + 1) : r * (q + 1) + (xcd - r) * q) + off; }
        const int nig = WGM * nN, gid = wgid / nig, fm = gid * WGM, gsz = (nM - fm) < WGM ? (nM - fm) : WGM;
        u.pm = fm + ((wgid % nig) % gsz); u.pn = (wgid % nig) / gsz; return true;
    }
};
struct MoeOrder {
    const LAS int* tile_e; int NJ, W, r, t0, t1;
    __device__ void init(const LAS int* te, int NT, int NJ_, int G, int c) {
        tile_e = te; NJ = NJ_;
        if (G % 8 == 0) { const int x = c % 8; r = c / 8; W = G / 8; t0 = (int)((long)NT * x / 8); t1 = (int)((long)NT * (x + 1) / 8); }
        else { r = c; W = G; t0 = 0; t1 = NT; }
    }
    __device__ bool next(int i, Unit& u) const {
        const int idx = i * W + r, ntl = t1 - t0; if (idx >= ntl * NJ) return false;
        const int GT = 32 / NJ, per = GT * NJ, grp = idx / per, rem = idx - grp * per, gsz = (ntl - grp * GT) < GT ? (ntl - grp * GT) : GT;
        const int tile = t0 + grp * GT + rem % gsz, j = rem / gsz;
        u.pm = tile; u.pn = tile_e[tile] * NJ + j; return true;
    }
};
constexpr int TOKL_OFF = 135168 + 1024 + 8192;
struct ADense {
    __device__ __forceinline__ void prefetch(const Unit&, LAS unsigned char*, int, int, int) const {}
    __device__ __forceinline__ void rows(const Unit& u, LAS unsigned char*, int, const int (&R)[2], unsigned (&vr)[2][2]) const {
#pragma unroll
        for (int h = 0; h < 2; ++h)
#pragma unroll
            for (int i = 0; i < 2; ++i) vr[h][i] = (unsigned)(u.pm * BM + h * HALF + R[i]);
    }
};
struct AGather {
    const int* tok;
    __device__ __forceinline__ void prefetch(const Unit& u, LAS unsigned char* ldsb, int par, int wid, int lane) const {
        if (wid < 4) __builtin_amdgcn_global_load_lds((const unsigned*)(tok + u.pm * BM + wid * 64 + lane), (LAS unsigned*)(ldsb + TOKL_OFF + par * 1024 + wid * 256), 4, 0, 0);
    }
    __device__ __forceinline__ void rows(const Unit&, LAS unsigned char* ldsb, int par, const int (&R)[2], unsigned (&vr)[2][2]) const {
        const LAS unsigned* t = (const LAS unsigned*)(ldsb + TOKL_OFF + par * 1024);
#pragma unroll
        for (int h = 0; h < 2; ++h)
#pragma unroll
            for (int i = 0; i < 2; ++i) vr[h][i] = t[h * HALF + R[i]];
    }
};
struct NoHook { static constexpr int T = -1; __device__ __forceinline__ void operator()(f32x4 (&)[2][2][4][2], const Unit&, int, int, int, int) const {} };

template <class Epi, class Sched, class AMap, class Hook>
__device__ __forceinline__ void gemm_phase(LAS unsigned char* lds, const bf16_t* A, const bf16_t* Bt, const int K, const Sched& S, const AMap& AM, const Epi& E, const Hook& HK) {
    int tid = threadIdx.x; asm volatile("" : "+v"(tid));
    const int wid = __builtin_amdgcn_readfirstlane(tid >> 6), lane = tid & 63, wr = wid >> 2, wc = wid & 3, fr = lane & 15, fq = lane >> 4;
    const int nt = K / BK;
    int Rr[2], Cc[2]; unsigned voffB[2];
#pragma unroll
    for (int i = 0; i < 2; ++i) { stage_rc(tid * 16 + i * 8192, Rr[i], Cc[i]); const int rho = Epi::PERM ? perm32(Rr[i] & 31) : (Rr[i] & 31);
        const int Rb = (Epi::COLMAP == 2) ? 64 * (Rr[i] >> 5) + rho : (Rr[i] & ~31) + rho; voffB[i] = (unsigned)(Rb * K + Cc[i]) * 2u; }
    const size_t bhalf = (Epi::COLMAP == 2) ? (size_t)32 * K * 2 : (size_t)HALF * K * 2;
    const size_t kstep = (size_t)(BK * 2);
    const size_t hstep = (size_t)HALF * K * 2;
    const size_t tstep = 2 * hstep;
    const unsigned ldsw = (unsigned)wid * 1024u;
    constexpr bool F8 = Epi::FP8; constexpr int KSTR = F8 ? 16 : 1024;
    const int fcol = F8 ? 32 * (fq >> 1) + 16 * (fq & 1) : fq * 8;
    const int aoff = lds_byte(wr * 64 + fr, fcol), boff = lds_byte(wc * 32 + fr, fcol);
#define PG8_SA(b, h) (((b) * 2 + (h)) * HTB)
#define PG8_SB(b, h) ((4 + (b) * 2 + (h)) * HTB)
#define PG8_STAGE(bufoff, gbase, voff) do { _Pragma("unroll") for (int _i = 0; _i < 2; ++_i) \
        __builtin_amdgcn_global_load_lds((const unsigned*)((const char*)(gbase) + (voff)[_i]), (LAS unsigned*)(lds + (bufoff) + ldsw + _i * 8192), 16, 0, 0); } while (0)
#define PG8_LD2(base_) __builtin_shufflevector(*(const LAS v4i32_t*)(base_), *(const LAS v4i32_t*)((base_) + KSTR), 0, 1, 2, 3, 4, 5, 6, 7)
#define PG8_LDA(dst, b, h) do { _Pragma("unroll") for (int m = 0; m < 4; ++m) dst[m] = PG8_LD2(lds + PG8_SA(b, h) + aoff + m * 2048); } while (0)
#define PG8_LDB(dst, b, h) do { _Pragma("unroll") for (int n = 0; n < 2; ++n) dst[n] = PG8_LD2(lds + PG8_SB(b, h) + boff + n * 2048); } while (0)
#define PG8_HALF(x, k) __builtin_bit_cast(bf16x8, __builtin_shufflevector(x, x, 4 * (k), 4 * (k) + 1, 4 * (k) + 2, 4 * (k) + 3))
#define PG8_MMA(ai, bj, At, Bt_) do { __builtin_amdgcn_s_setprio(1); _Pragma("unroll") for (int m = 0; m < 4; ++m) _Pragma("unroll") for (int n = 0; n < 2; ++n) { \
        if constexpr (F8) acc[ai][bj][m][n] = __builtin_amdgcn_mfma_scale_f32_16x16x128_f8f6f4(Bt_[n], At[m], acc[ai][bj][m][n], 0, 0, 0, 0, 0, 0);     \
        else { acc[ai][bj][m][n] = __builtin_amdgcn_mfma_f32_16x16x32_bf16(PG8_HALF(Bt_[n], 0), PG8_HALF(At[m], 0), acc[ai][bj][m][n], 0, 0, 0); \
               acc[ai][bj][m][n] = __builtin_amdgcn_mfma_f32_16x16x32_bf16(PG8_HALF(Bt_[n], 1), PG8_HALF(At[m], 1), acc[ai][bj][m][n], 0, 0, 0); } } \
        __builtin_amdgcn_s_setprio(0); } while (0)
#define PG8_WAIT_V(n) asm volatile("s_waitcnt vmcnt(" #n ")" ::: "memory")
#define PG8_WAIT_L(n) asm volatile("s_waitcnt lgkmcnt(" #n ")" ::: "memory")
#define PG8_BAR __builtin_amdgcn_s_barrier()
#define PG8_SCHED __builtin_amdgcn_sched_barrier(0)
    Unit cur, nxt, nn; int ui = 0;
    if (!S.next(0, cur)) return;
    bool has_next = S.next(1, nxt);
    f32x4 acc[2][2][4][2];
#pragma unroll
    for (int a = 0; a < 2; ++a)
#pragma unroll
        for (int b = 0; b < 2; ++b)
#pragma unroll
            for (int m = 0; m < 4; ++m)
#pragma unroll
                for (int n = 0; n < 2; ++n) acc[a][b][m][n] = (f32x4){0.f, 0.f, 0.f, 0.f};
    v8i32_t At[4], B0[2], B1[2];
    unsigned vC[2][2];
    AM.prefetch(cur, lds, 0, wid, lane);
    if (has_next) AM.prefetch(nxt, lds, 1, wid, lane);
    asm volatile("s_waitcnt vmcnt(0)" ::: "memory"); __builtin_amdgcn_s_barrier(); asm volatile("" ::: "memory");
    AM.rows(cur, lds, 0, Rr, vC);
#pragma unroll
    for (int h = 0; h < 2; ++h)
#pragma unroll
        for (int i = 0; i < 2; ++i) vC[h][i] = (vC[h][i] * (unsigned)K + (unsigned)Cc[i]) * 2u;
    const char* const Ab = (const char*)A;
    const char* cB = (const char*)Bt + (size_t)cur.pn * tstep;
    PG8_STAGE(PG8_SB(0, 0), cB, voffB); PG8_STAGE(PG8_SB(0, 1), cB + bhalf, voffB); PG8_STAGE(PG8_SA(0, 0), Ab, vC[0]); PG8_STAGE(PG8_SA(0, 1), Ab, vC[1]);
    if (wr == 1) PG8_BAR;
    PG8_WAIT_V(2); PG8_BAR;
    PG8_STAGE(PG8_SB(1, 0), cB + kstep, voffB); PG8_STAGE(PG8_SA(1, 0), Ab + kstep, vC[0]); PG8_STAGE(PG8_SB(1, 1), cB + bhalf + kstep, voffB);
    PG8_WAIT_V(0); PG8_BAR;
    for (;;) {
        const bool has_nn = has_next ? S.next(ui + 2, nn) : false;
        if (has_nn) AM.prefetch(nn, lds, ui & 1, wid, lane);
        const char* nB = has_next ? (const char*)Bt + (size_t)nxt.pn * tstep : cB;
#ifdef KLOOP_PROBE
        const unsigned long long kp_t0 = __builtin_amdgcn_s_memtime();
#endif
#define PG8_TRIP(WV) do {   \
            const bool last = (t == nt - 2); \
            if (Hook::T >= 0) { if (t == Hook::T) HK(acc, cur, wr, wc, fr, fq); } \
            const char* a1 = Ab + (size_t)(t + 1) * kstep; \
            const char* a2 = last ? Ab : Ab + (size_t)(t + 2) * kstep; const char* b2 = last ? nB : cB + (size_t)(t + 2) * kstep; \
            const char* a3 = a2 + kstep; const char* b3 = b2 + kstep; \
              \
            PG8_LDB(B0, 0, 0); PG8_LDB(B1, 0, 1); PG8_SCHED; PG8_LDA(At, 0, 0); PG8_STAGE(PG8_SA(1, 1), a1, vC[1]); \
            if (last && has_next) {                         \
                int tq = tid; asm volatile("" : "+v"(tq));           \
                int R2[2], C2[2]; _Pragma("unroll") for (int i = 0; i < 2; ++i) stage_rc(tq * 16 + i * 8192, R2[i], C2[i]); \
                AM.rows(nxt, lds, (ui + 1) & 1, R2, vC); \
                _Pragma("unroll") for (int h = 0; h < 2; ++h) _Pragma("unroll") for (int i = 0; i < 2; ++i) vC[h][i] = (vC[h][i] * (unsigned)K + (unsigned)C2[i]) * 2u; \
            } \
            if (nowait == 0) PG8_WAIT_V(8); \
            PG8_WAIT_L(0); PG8_BAR; PG8_MMA(0, 0, At, B0); PG8_MMA(0, 1, At, B1); PG8_BAR; PG8_SCHED; \
              \
            PG8_LDA(At, 0, 1); PG8_STAGE(PG8_SB(0, 0), b2, voffB); PG8_STAGE(PG8_SB(0, 1), b2 + bhalf, voffB); PG8_STAGE(PG8_SA(0, 0), a2, vC[0]); \
            if (nowait == 0) PG8_WAIT_V(8); \
            asm volatile("s_mov_b32 %0, 0" : "=s"(nowait)); \
            PG8_WAIT_L(0); PG8_BAR; PG8_MMA(1, 0, At, B0); PG8_MMA(1, 1, At, B1); PG8_BAR; PG8_SCHED; \
              \
            PG8_LDB(B0, 1, 0); PG8_LDB(B1, 1, 1); PG8_SCHED; PG8_LDA(At, 1, 0); PG8_STAGE(PG8_SA(0, 1), a2, vC[1]); \
            PG8_WAIT_V(8); PG8_WAIT_L(0); PG8_BAR; PG8_MMA(0, 0, At, B0); PG8_MMA(0, 1, At, B1); PG8_BAR; PG8_SCHED; \
              \
            PG8_LDA(At, 1, 1); PG8_STAGE(PG8_SB(1, 0), b3, voffB); PG8_STAGE(PG8_SB(1, 1), b3 + bhalf, voffB); PG8_STAGE(PG8_SA(1, 0), a3, vC[0]); \
            PG8_WAIT_V(8); PG8_WAIT_L(0); PG8_BAR; PG8_MMA(1, 0, At, B0); PG8_MMA(1, 1, At, B1); PG8_BAR; PG8_SCHED; \
        } while (0)
        int nowait; asm volatile("s_mov_b32 %0, 1" : "=s"(nowait));
#pragma unroll 1
        for (int t = 0; t < nt; t += 2) { PG8_TRIP(8); }
#undef PG8_TRIP
#ifdef KLOOP_PROBE
        if (blockIdx.x == 0 && tid == 0) { volatile LAS unsigned* kp = (volatile LAS unsigned*)(lds + 135168 + 320 + 64); if (kp[1]) kp[0] += (unsigned)((__builtin_amdgcn_s_memtime() - kp_t0) >> 4); }
#endif
        if (wr == 0) PG8_BAR;
        PG8_WAIT_V(0);
#ifdef EPI_PROBE
        const unsigned long long ep_t0 = __builtin_amdgcn_s_memtime();
#endif
        E(acc, cur, wr, wc, fr, fq);
#ifdef EPI_PROBE
        if (blockIdx.x == 0 && tid == 0) { volatile LAS unsigned* kp = (volatile LAS unsigned*)(lds + 135168 + 320 + 64); if (kp[1]) kp[0] += (unsigned)((__builtin_amdgcn_s_memtime() - ep_t0) >> 4); }
#endif
        if (!has_next) break;
#pragma unroll
        for (int a = 0; a < 2; ++a)
#pragma unroll
            for (int b = 0; b < 2; ++b)
#pragma unroll
                for (int m = 0; m < 4; ++m)
#pragma unroll
                    for (int n = 0; n < 2; ++n) acc[a][b][m][n] = (f32x4){0.f, 0.f, 0.f, 0.f};
        cur = nxt; nxt = nn; has_next = has_nn; cB = nB; ++ui;
        if (wr == 1) PG8_BAR;
    }
    PG8_WAIT_V(0);
    PG8_BAR;
#undef PG8_SA
#undef PG8_SB
#undef PG8_STAGE
#undef PG8_LDA
#undef PG8_LDB
#undef PG8_MMA
#undef PG8_HALF
#undef PG8_LD2
#undef PG8_WAIT_V
#undef PG8_WAIT_L
#undef PG8_BAR
#undef PG8_SCHED
}
}
using pg8::Unit;

#if G_FP8
typedef u32x2 gate8_t;
constexpr int GATE_B = 1;
__device__ __forceinline__ void gate_unpack(const gate8_t g, f32x4& lo, f32x4& hi) { lo = fp8x4_f32(g.x); hi = fp8x4_f32(g.y); }
#else
typedef u32x4 gate8_t;
constexpr int GATE_B = 2;
__device__ __forceinline__ void gate_unpack(const gate8_t g, f32x4& lo, f32x4& hi) { lo = (f32x4){bflo(g.x), bfhi(g.x), bflo(g.y), bfhi(g.y)}; hi = (f32x4){bflo(g.z), bfhi(g.z), bflo(g.w), bfhi(g.w)}; }
#endif
#define GATE_LD(G_, row_, col_) (*(const gate8_t*)((const unsigned char*)(G_) + ((size_t)(row_) * 2048 + (col_)) * GATE_B))
#if G_FP8
__device__ __forceinline__ int gate_pair_ofs(int fq) { return (fq & 1) ? 24 + 8 * fq : 8 * fq; }
#define GFRAG_OFS(row16_, span_, fq_, fr_) ((((size_t)(row16_) * 32 + (span_)) * 1024) + (size_t)(gate_pair_ofs(fq_) >> 4) * 256 + (size_t)(fr_) * 16)
__device__ __forceinline__ void gate_ld_pair(const unsigned char* p, u32x4& L) { L = *(const u32x4*)p; }
__device__ __forceinline__ void gate_unswap(const u32x4 L, gate8_t& g0, gate8_t& g1) {
    const auto sx = __builtin_amdgcn_permlane16_swap(L.x, L.z, false, false), sy = __builtin_amdgcn_permlane16_swap(L.y, L.w, false, false);
    g0.x = sx[0]; g0.y = sy[0]; g1.x = sx[1]; g1.y = sy[1];
}
#endif
__device__ __forceinline__ unsigned dpp_ror8(unsigned v) { return (unsigned)__builtin_amdgcn_update_dpp(0, (int)v, 0x128, 0xf, 0xf, true); }
__device__ __forceinline__ u32x4 dpp_ror8(u32x4 v) { u32x4 r; r.x = dpp_ror8(v.x); r.y = dpp_ror8(v.y); r.z = dpp_ror8(v.z); r.w = dpp_ror8(v.w); return r; }
__device__ __forceinline__ void xchg_rows(const u32x4 v0, const u32x4 v1, int fr, u32x4& w_lo, u32x4& w_hi) {
    const bool up = fr >= 8; const u32x4 snd = up ? v0 : v1, rcv = dpp_ror8(snd);
    w_lo = up ? rcv : v0; w_hi = up ? v1 : rcv;
}
__device__ __forceinline__ int pair16_ofs(int fq) { return (fq & 1) ? 24 + 8 * fq : 8 * fq; }
__device__ __forceinline__ void store_pair16(unsigned char* p, const u32x2 a8, const u32x2 b8) {
    const auto sx = __builtin_amdgcn_permlane16_swap(a8.x, b8.x, false, false), sy = __builtin_amdgcn_permlane16_swap(a8.y, b8.y, false, false);
    u32x4 w; w.x = sx[0]; w.y = sy[0]; w.z = sx[1]; w.w = sy[1]; *(u32x4*)p = w;
}
struct EpiInProj {
    static constexpr bool PERM = true, FP8 = (P1_FP8 != 0); static constexpr int COLMAP = 2, NSTORES = 16;
    bf16_t *QA, *KA, *VA, *QB, *KB, *VB, *G; const unsigned* csT; int var;
    __device__ __forceinline__ void operator()(const f32x4 (&acc)[2][2][4][2], const Unit& u, int wr, int wc, int fr, int fq) const {
        const int pn = u.pn, rb0 = (var == 3 ? (u.pm & 3) : u.pm) * 256 + wr * 64;
        asm volatile("" : "+v"(fq), "+v"(fr));
        const int chunk = fq + 4 * (fr >> 3), rl = fr & 7;
        constexpr float WS_ = FP8 ? W8_INV : 1.0f;
        bf16_t* base; int ld, colt; float sc = WS_; int kind;
        constexpr float QS_ = QKV_FP8 ? 1.0f : QSCALE;
        if (pn < 4) { base = QA; ld = 1024; colt = pn * 256; sc = QS_ * WS_; kind = 0; }
        else if (pn == 4) { base = KA; ld = 256; colt = 0; kind = 0; }
        else if (pn == 5) { base = VA; ld = 256; colt = 0; kind = 1; }
        else if (pn < 9) { base = QB; ld = 768; colt = (pn - 6) * 256; sc = QS_ * WS_; kind = 0; }
        else if (pn < 12) { base = KB; ld = 768; colt = (pn - 9) * 256; kind = 0; }
        else if (pn < 15) { base = VB; ld = 768; colt = (pn - 12) * 256; kind = 1; }
        else { base = G; ld = 2048; colt = (pn - 15) * 256; kind = 2; }
        bf16_t* seg = base + colt + 64 * wc + 8 * chunk;
        if (kind == 0) {
            u32x4 cs[2][4][2];
#pragma unroll
            for (int ai = 0; ai < 2; ++ai)
#pragma unroll
                for (int m = 0; m < 4; ++m) { const int pos = (rb0 + ai * 128 + m * 16 + fr) & (SEQ - 1); const unsigned* tp = csT + (((pos >> 4) * 4 + fq) * 16 + (pos & 15)) * 4;
                    cs[ai][m][0] = *(const u32x4*)tp; cs[ai][m][1] = *(const u32x4*)(tp + SEQ * 16); }
            asm volatile("" ::: "memory");
#pragma unroll
            for (int ai = 0; ai < 2; ++ai)
#pragma unroll
                for (int m = 0; m < 4; ++m) {
                    const u32x4 t0 = cs[ai][m][0], t1 = cs[ai][m][1];
                    const f32x4 c0 = {bflo(t0.x), bflo(t0.y), bflo(t0.z), bflo(t0.w)}, s0 = {bfhi(t0.x), bfhi(t0.y), bfhi(t0.z), bfhi(t0.w)};
                    const f32x4 c1 = {bflo(t1.x), bflo(t1.y), bflo(t1.z), bflo(t1.w)}, s1 = {bfhi(t1.x), bfhi(t1.y), bfhi(t1.z), bfhi(t1.w)};
                    const f32x4 x10 = acc[ai][0][m][0], x11 = acc[ai][0][m][1], x20 = acc[ai][1][m][0], x21 = acc[ai][1][m][1];
                    const f32x4 o10 = (x10 * c0 - x20 * s0) * sc, o11 = (x11 * c1 - x21 * s1) * sc;
                    const f32x4 o20 = (x20 * c0 + x10 * s0) * sc, o21 = (x21 * c1 + x11 * s1) * sc;
#if QKV_FP8
                    { unsigned char* rp8 = (unsigned char*)base + (size_t)(rb0 + ai * 128 + m * 16 + fr) * ld + colt + 64 * wc + pair16_ofs(fq); u32x2 a8, b8;
                      a8.x = pk4_fp8(o10[0], o10[1], o10[2], o10[3]); a8.y = pk4_fp8(o11[0], o11[1], o11[2], o11[3]); b8.x = pk4_fp8(o20[0], o20[1], o20[2], o20[3]); b8.y = pk4_fp8(o21[0], o21[1], o21[2], o21[3]);
                      store_pair16(rp8, a8, b8); }
#else
                    u32x4 v0, v1, wl, wh;
                    v0.x = pk2(o10[0], o10[1]); v0.y = pk2(o10[2], o10[3]); v0.z = pk2(o11[0], o11[1]); v0.w = pk2(o11[2], o11[3]);
                    v1.x = pk2(o20[0], o20[1]); v1.y = pk2(o20[2], o20[3]); v1.z = pk2(o21[0], o21[1]); v1.w = pk2(o21[2], o21[3]);
                    xchg_rows(v0, v1, fr, wl, wh);
                    bf16_t* rp = seg + (size_t)(rb0 + ai * 128 + m * 16 + rl) * ld;
                    if (var != 1) { *(u32x4*)rp = wl; *(u32x4*)(rp + (size_t)8 * ld) = wh; }
#endif
                }
        } else if (kind == 1 && QKV_FP8) {
            unsigned char* vp0 = (unsigned char*)base + colt + 64 * wc + pair16_ofs(fq);
#pragma unroll
            for (int ai = 0; ai < 2; ++ai)
#pragma unroll
                for (int m = 0; m < 4; ++m) {
                    unsigned char* vp = vp0 + (size_t)(rb0 + ai * 128 + m * 16 + fr) * ld;
                    u32x2 w8[2];
#pragma unroll
                    for (int bj = 0; bj < 2; ++bj) { const f32x4 a = acc[ai][bj][m][0] * WS_, b = acc[ai][bj][m][1] * WS_;
                        w8[bj].x = pk4_fp8(a[0], a[1], a[2], a[3]); w8[bj].y = pk4_fp8(b[0], b[1], b[2], b[3]); }
                    store_pair16(vp, w8[0], w8[1]);
                }
        } else if (kind == 2 && G_FP8) {
            unsigned char* gp0 = (unsigned char*)G + GFRAG_OFS(rb0 >> 4, (pn - 15) * 4 + wc, fq, fr);
#pragma unroll
            for (int ai = 0; ai < 2; ++ai)
#pragma unroll
                for (int m = 0; m < 4; ++m) {
                    unsigned char* gp = gp0 + (size_t)(ai * 8 + m) * 32 * 1024;
                    u32x2 w8[2];
#pragma unroll
                    for (int bj = 0; bj < 2; ++bj) { const f32x4 a = acc[ai][bj][m][0] * WS_, b = acc[ai][bj][m][1] * WS_;
                        w8[bj].x = pk4_fp8(fast_sigmoid(a[0]), fast_sigmoid(a[1]), fast_sigmoid(a[2]), fast_sigmoid(a[3])); w8[bj].y = pk4_fp8(fast_sigmoid(b[0]), fast_sigmoid(b[1]), fast_sigmoid(b[2]), fast_sigmoid(b[3])); }
                    store_pair16(gp, w8[0], w8[1]);
                }
        } else {
#pragma unroll
            for (int ai = 0; ai < 2; ++ai)
#pragma unroll
                for (int m = 0; m < 4; ++m) {
                    u32x4 v[2], wl, wh;
#pragma unroll
                    for (int bj = 0; bj < 2; ++bj) { f32x4 a = acc[ai][bj][m][0] * WS_, b = acc[ai][bj][m][1] * WS_;
                        if (kind == 2) { a = (f32x4){fast_sigmoid(a[0]), fast_sigmoid(a[1]), fast_sigmoid(a[2]), fast_sigmoid(a[3])}; b = (f32x4){fast_sigmoid(b[0]), fast_sigmoid(b[1]), fast_sigmoid(b[2]), fast_sigmoid(b[3])}; }
                        v[bj].x = pk2(a[0], a[1]); v[bj].y = pk2(a[2], a[3]); v[bj].z = pk2(b[0], b[1]); v[bj].w = pk2(b[2], b[3]); }
                    xchg_rows(v[0], v[1], fr, wl, wh);
                    bf16_t* rp = seg + (size_t)(rb0 + ai * 128 + m * 16 + rl) * ld;
                    if (var != 1) { *(u32x4*)rp = wl; *(u32x4*)(rp + (size_t)8 * ld) = wh; }
                }
        }
    }
};
struct HookGateRatio {
    static constexpr int T = P3_FP8 ? 8 : 16;
    const bf16_t* G;
    __device__ __forceinline__ void operator()(f32x4 (&acc)[2][2][4][2], const Unit& u, int wr, int wc, int fr, int fq) const {
        int loff = (wr * 64 + fr) * 2048 + wc * 64 + 8 * fq;
        asm volatile("" : "+v"(loff));
#if G_FP8
        int fq_o = fq, fr_o = fr; asm volatile("" : "+v"(fq_o), "+v"(fr_o));
        const unsigned char* gfrag = (const unsigned char*)G + GFRAG_OFS(u.pm * 16 + wr * 4, u.pn * 4 + wc, fq_o, fr_o);
#endif
        const unsigned char* gbase = (const unsigned char*)G + ((size_t)u.pm * 256 * 2048 + (size_t)u.pn * 256) * GATE_B;
#pragma unroll
        for (int ai = 0; ai < 2; ++ai) {
            gate8_t ga[4][2], gb[4][2];
#if G_FP8
            { u32x4 La[4], Lb[4];
#pragma unroll
              for (int m = 0; m < 4; ++m) { const unsigned char* gp = gfrag + (size_t)(ai * 8 + m) * 32 * 1024; gate_ld_pair(gp, La[m]); gate_ld_pair(gp + 16 * 1024, Lb[m]); }
              asm volatile("" ::: "memory");
#pragma unroll
              for (int m = 0; m < 4; ++m) { gate_unswap(La[m], ga[m][0], ga[m][1]); gate_unswap(Lb[m], gb[m][0], gb[m][1]); } }
#else
#pragma unroll
            for (int m = 0; m < 4; ++m)
#pragma unroll
                for (int bj = 0; bj < 2; ++bj) { const unsigned char* gp = gbase + (size_t)((ai * 128 + m * 16) * 2048 + bj * 32) * GATE_B + (unsigned)(loff * GATE_B); ga[m][bj] = *(const gate8_t*)gp; gb[m][bj] = *(const gate8_t*)(gp + 1024 * GATE_B); }
            asm volatile("" ::: "memory");
#endif
#pragma unroll
            for (int m = 0; m < 4; ++m)
#pragma unroll
                for (int bj = 0; bj < 2; ++bj) {
                    f32x4 a0, a1, b0, b1; gate_unpack(ga[m][bj], a0, a1); gate_unpack(gb[m][bj], b0, b1);
                    f32x4 r0, r1;
#pragma unroll
                    for (int q = 0; q < 4; ++q) { r0[q] = a0[q] * __builtin_amdgcn_rcpf(b0[q]); r1[q] = a1[q] * __builtin_amdgcn_rcpf(b1[q]); }
                    acc[ai][bj][m][0] *= r0; acc[ai][bj][m][1] *= r1;
                }
            asm volatile("" ::: "memory");
        }
    }
};
struct EpiMerged {
    static constexpr bool PERM = true, FP8 = (P3_FP8 != 0); static constexpr int COLMAP = 2, NSTORES = 16;
    const bf16_t* G; bf16_t* O;
    __device__ __forceinline__ void operator()(const f32x4 (&acc)[2][2][4][2], const Unit& u, int wr, int wc, int fr, int fq) const {
        const int rb0 = u.pm * 256 + wr * 64, col = u.pn * 256 + wc * 64 + 8 * fq;
        gate8_t gb[2][4][2];
#if G_FP8
        { u32x4 Lg[2][4];
#pragma unroll
          for (int ai = 0; ai < 2; ++ai)
#pragma unroll
            for (int m = 0; m < 4; ++m) gate_ld_pair((const unsigned char*)G + GFRAG_OFS((rb0 >> 4) + ai * 8 + m, 16 + u.pn * 4 + wc, fq, fr), Lg[ai][m]);
          asm volatile("" ::: "memory");
#pragma unroll
          for (int ai = 0; ai < 2; ++ai)
#pragma unroll
            for (int m = 0; m < 4; ++m) gate_unswap(Lg[ai][m], gb[ai][m][0], gb[ai][m][1]); }
#else
#pragma unroll
        for (int ai = 0; ai < 2; ++ai)
#pragma unroll
            for (int m = 0; m < 4; ++m)
#pragma unroll
                for (int bj = 0; bj < 2; ++bj) gb[ai][m][bj] = GATE_LD(G, rb0 + ai * 128 + m * 16 + fr, 1024 + col + bj * 32);
        asm volatile("" ::: "memory");
#endif
#pragma unroll
        for (int ai = 0; ai < 2; ++ai)
#pragma unroll
            for (int m = 0; m < 4; ++m) {
                f32x4 o[2][2];
#pragma unroll
                for (int bj = 0; bj < 2; ++bj) { f32x4 g0, g1; gate_unpack(gb[ai][m][bj], g0, g1); constexpr float SC_ = FP8 ? W8_INV * OA_INV : 1.0f; o[bj][0] = acc[ai][bj][m][0] * g0 * SC_; o[bj][1] = acc[ai][bj][m][1] * g1 * SC_; }
#if P4_FP8
                u32x2 w8[2];
#pragma unroll
                for (int bj = 0; bj < 2; ++bj) {
                    const f32x4 v0 = o[bj][0] * MG_SCALE, v1 = o[bj][1] * MG_SCALE;
                    w8[bj].x = pk4_fp8(v0[0], v0[1], v0[2], v0[3]); w8[bj].y = pk4_fp8(v1[0], v1[1], v1[2], v1[3]); }
                store_pair16((unsigned char*)O + (size_t)(rb0 + ai * 128 + m * 16 + fr) * 1024 + col - 8 * fq + pair16_ofs(fq), w8[0], w8[1]);
#else
                u32x4 v[2], wl, wh;
#pragma unroll
                for (int bj = 0; bj < 2; ++bj) { v[bj].x = pk2(o[bj][0][0], o[bj][0][1]); v[bj].y = pk2(o[bj][0][2], o[bj][0][3]); v[bj].z = pk2(o[bj][1][0], o[bj][1][1]); v[bj].w = pk2(o[bj][1][2], o[bj][1][3]); }
                xchg_rows(v[0], v[1], fr, wl, wh);
                bf16_t* rp = O + u.pn * 256 + wc * 64 + 8 * (fq + 4 * (fr >> 3)) + (size_t)(rb0 + ai * 128 + m * 16 + (fr & 7)) * 1024;
                *(u32x4*)rp = wl; *(u32x4*)(rp + 8 * 1024) = wh;
#endif
            }
    }
};
struct EpiPre {
    static constexpr bool PERM = false, FP8 = (P4_FP8 != 0); static constexpr int COLMAP = 2, NSTORES = 32;
    const float* X; float* O; float* ST; bf16_t* P16;
    __device__ __forceinline__ void operator()(f32x4 (&acc)[2][2][4][2], const Unit& u, int wr, int wc, int fr, int fq) const {
        const int rb0 = u.pm * 256 + wr * 64, col = u.pn * 256 + wc * 64 + 4 * fq;
        float* seg = O + u.pn * 256 + wc * 64 + 4 * (fq + 4 * (fr >> 3));
        f32x4 xv[4][2][2];
#define EPIPRE_LOAD(ai) do { _Pragma("unroll") for (int m = 0; m < 4; ++m) { const size_t off = (size_t)(rb0 + (ai) * 128 + m * 16 + fr) * 1024 + col; \
            _Pragma("unroll") for (int bj = 0; bj < 2; ++bj) _Pragma("unroll") for (int n = 0; n < 2; ++n) xv[m][bj][n] = *(const f32x4*)(X + off + bj * 32 + n * 16); } } while (0)
#define EPIPRE_FMA(ai) do { _Pragma("unroll") for (int m = 0; m < 4; ++m) _Pragma("unroll") for (int bj = 0; bj < 2; ++bj) _Pragma("unroll") for (int n = 0; n < 2; ++n) acc[ai][bj][m][n] = xv[m][bj][n] * ALPHA + acc[ai][bj][m][n] * (FP8 ? W8_INV * MG_INV : 1.0f); } while (0)
#if PRE16
        bf16_t* pseg = P16 + u.pn * 256 + wc * 64 + ((fq & 1) ? 16 + 4 * (fq - 1) : 4 * fq);
#define EPIPRE_STORE(ai) do { _Pragma("unroll") for (int m = 0; m < 4; ++m) { bf16_t* rp = pseg + (size_t)(rb0 + (ai) * 128 + m * 16 + fr) * 1024; \
            _Pragma("unroll") for (int bj = 0; bj < 2; ++bj) { const f32x4 a_ = acc[ai][bj][m][0], b_ = acc[ai][bj][m][1]; \
                const auto sx_ = __builtin_amdgcn_permlane16_swap(pk2(a_[0], a_[1]), pk2(b_[0], b_[1]), false, false); const auto sy_ = __builtin_amdgcn_permlane16_swap(pk2(a_[2], a_[3]), pk2(b_[2], b_[3]), false, false); \
                u32x4 w_; w_.x = sx_[0]; w_.y = sy_[0]; w_.z = sx_[1]; w_.w = sy_[1]; *(u32x4*)(rp + bj * 32) = w_; } } } while (0)
#else
#define EPIPRE_STORE(ai) do { _Pragma("unroll") for (int m = 0; m < 4; ++m) { float* rp = seg + (size_t)(rb0 + (ai) * 128 + m * 16 + (fr & 7)) * 1024; \
            _Pragma("unroll") for (int bj = 0; bj < 2; ++bj) { u32x4 wl, wh; xchg_rows(__builtin_bit_cast(u32x4, acc[ai][bj][m][0]), __builtin_bit_cast(u32x4, acc[ai][bj][m][1]), fr, wl, wh); \
                *(u32x4*)(rp + bj * 32) = wl; *(u32x4*)(rp + 8 * 1024 + bj * 32) = wh; } } } while (0)
#endif
#define EPIPRE_STATS(ai) do { if (P5_SINGLE) { _Pragma("unroll") for (int m = 0; m < 4; ++m) { float s1_ = 0.f, s2_ = 0.f; \
            _Pragma("unroll") for (int bj = 0; bj < 2; ++bj) _Pragma("unroll") for (int n = 0; n < 2; ++n) { const f32x4 v_ = acc[ai][bj][m][n]; s1_ += (v_[0] + v_[1]) + (v_[2] + v_[3]); s2_ += (v_[0] * v_[0] + v_[1] * v_[1]) + (v_[2] * v_[2] + v_[3] * v_[3]); } \
            s1_ += __shfl_xor(s1_, 16); s2_ += __shfl_xor(s2_, 16); s1_ += __shfl_xor(s1_, 32); s2_ += __shfl_xor(s2_, 32); \
            if (fq == 0) *(f32x2*)(ST + ((size_t)(rb0 + (ai) * 128 + m * 16 + fr) * 16 + u.pn * 4 + wc) * 2) = (f32x2){s1_, s2_}; } } } while (0)
        EPIPRE_LOAD(0); asm volatile("" ::: "memory");
        EPIPRE_FMA(0);
        EPIPRE_STATS(0);
        asm volatile("" : "+v"(acc[0][0][0][0]), "+v"(acc[0][0][1][0]), "+v"(acc[0][0][2][0]), "+v"(acc[0][0][3][0]) :: "memory");
        EPIPRE_LOAD(1); asm volatile("" ::: "memory");
        EPIPRE_STORE(0); asm volatile("" ::: "memory");
        EPIPRE_FMA(1);
        EPIPRE_STATS(1);
        EPIPRE_STORE(1);
#undef EPIPRE_STATS
#undef EPIPRE_LOAD
#undef EPIPRE_FMA
#undef EPIPRE_STORE
    }
};
struct EpiSwiglu {
    static constexpr bool PERM = true, FP8 = true; static constexpr int COLMAP = 1, NSTORES = 8;
    const float* bgu; unsigned char* H8;
    __device__ __forceinline__ void operator()(const f32x4 (&acc)[2][2][4][2], const Unit& u, int wr, int wc, int fr, int fq) const {
        const int e = u.pn >> 3, j = u.pn & 7, row0 = u.pm * 256 + wr * 64 + fr, col = j * 128 + wc * 32 + 8 * fq;
        const float* bp = bgu + (size_t)e * 2048 + col;
        constexpr float C_ = -1.702f * LOG2E, SG_ = W8_INV * C_, SU_ = W8_INV / C_, T7_ = 7.0f * C_, ULO_ = 8.0f / C_, UHI_ = -6.0f / C_;
        const f32x4 bg0 = *(const f32x4*)bp * C_, bg1 = *(const f32x4*)(bp + 4) * C_, bu0 = (*(const f32x4*)(bp + 1024) + 1.0f) * (1.0f / C_), bu1 = (*(const f32x4*)(bp + 1028) + 1.0f) * (1.0f / C_);
        unsigned char* hp = H8 + (size_t)(row0 + (fq & 1) * 16) * 1024 + col - 8 * (fq & 1);
#pragma unroll
        for (int ai = 0; ai < 2; ++ai)
#pragma unroll
            for (int mp = 0; mp < 2; ++mp) {
                u32x2 w[2];
#pragma unroll
                for (int mm = 0; mm < 2; ++mm) { const int m = 2 * mp + mm;
                    const f32x4 t0 = acc[ai][0][m][0] * SG_ + bg0, t1 = acc[ai][0][m][1] * SG_ + bg1;
                    const f32x4 u0 = acc[ai][1][m][0] * SU_ + bu0, u1 = acc[ai][1][m][1] * SU_ + bu1;
                    f32x4 o0, o1;
#pragma unroll
                    for (int q = 0; q < 4; ++q) {
                        const float ta = __builtin_fmaxf(t0[q], T7_), tb = __builtin_fmaxf(t1[q], T7_);
                        const float ra = __builtin_amdgcn_rcpf(1.0f + __builtin_amdgcn_exp2f(ta)), rb = __builtin_amdgcn_rcpf(1.0f + __builtin_amdgcn_exp2f(tb));
                        o0[q] = __builtin_amdgcn_fmed3f(u0[q], ULO_, UHI_) * ta * ra; o1[q] = __builtin_amdgcn_fmed3f(u1[q], ULO_, UHI_) * tb * rb;
                    }
                    w[mm].x = pk4_fp8(o0[0], o0[1], o0[2], o0[3]); w[mm].y = pk4_fp8(o1[0], o1[1], o1[2], o1[3]); }
                store_pair16(hp + (size_t)(ai * 128 + mp * 32) * 1024, w[0], w[1]);
            }
    }
};
struct EpiDown {
    static constexpr bool PERM = true, FP8 = true; static constexpr int COLMAP = 2, NSTORES = 16;
    const float* bd; const int* dst; bf16_t* Y;
    __device__ __forceinline__ void operator()(const f32x4 (&acc)[2][2][4][2], const Unit& u, int wr, int wc, int fr, int fq) const {
        const int e = u.pn >> 2, j = u.pn & 3, rb0 = u.pm * 256 + wr * 64, col = j * 256 + wc * 64 + 8 * fq;
        const float* bp = bd + (size_t)e * 1024 + col;
        f32x4 bv[2][2];
#pragma unroll
        for (int bj = 0; bj < 2; ++bj) { bv[bj][0] = *(const f32x4*)(bp + bj * 32); bv[bj][1] = *(const f32x4*)(bp + bj * 32 + 4); }
        int dd[2][4];
#pragma unroll
        for (int ai = 0; ai < 2; ++ai)
#pragma unroll
            for (int m = 0; m < 4; ++m) dd[ai][m] = dst[rb0 + ai * 128 + m * 16 + fr];
        asm volatile("" ::: "memory");
        bf16_t* seg = Y + j * 256 + wc * 64 + 8 * (fq + 4 * (fr >> 3));
#pragma unroll
        for (int ai = 0; ai < 2; ++ai)
#pragma unroll
            for (int m = 0; m < 4; ++m) {
                u32x4 v[2], wl, wh;
#pragma unroll
                for (int bj = 0; bj < 2; ++bj) { const f32x4 v0 = acc[ai][bj][m][0] * W8_INV + bv[bj][0], v1 = acc[ai][bj][m][1] * W8_INV + bv[bj][1];
                    v[bj].x = pk2(v0[0], v0[1]); v[bj].y = pk2(v0[2], v0[3]); v[bj].z = pk2(v1[0], v1[1]); v[bj].w = pk2(v1[2], v1[3]); }
#if Y_FP8
                (void)wl; (void)wh; (void)seg;
                { const int dme = dd[ai][m] >= 0 ? dd[ai][m] : HALF_T * 4;
                  unsigned char* rp8 = (unsigned char*)Y + (size_t)dme * 1024 + j * 256 + wc * 64 + pair16_ofs(fq); u32x2 w8[2];
#pragma unroll
                  for (int bj = 0; bj < 2; ++bj) { const f32x4 v0 = acc[ai][bj][m][0] * W8_INV + bv[bj][0], v1 = acc[ai][bj][m][1] * W8_INV + bv[bj][1];
                      w8[bj].x = pk4_fp8(v0[0], v0[1], v0[2], v0[3]); w8[bj].y = pk4_fp8(v1[0], v1[1], v1[2], v1[3]); }
                  store_pair16(rp8, w8[0], w8[1]); }
#else
                xchg_rows(v[0], v[1], fr, wl, wh);
                const int dme = dd[ai][m] >= 0 ? dd[ai][m] : HALF_T * 4, dpt = (int)dpp_ror8((unsigned)dme);
                const int d0 = fr < 8 ? dme : dpt, d1 = fr < 8 ? dpt : dme;
                *(u32x4*)(seg + (size_t)d0 * 1024) = wl; *(u32x4*)(seg + (size_t)d1 * 1024) = wh;
#endif
            }
    }
};

__device__ __forceinline__ int crow(int r, int hi) { return (r & 3) + 8 * (r >> 2) + 4 * hi; }
constexpr float AT_THR = 8.0f;
constexpr int AT_KROW = 144, AT_VROW = 128, AT_MAXT = 12;
constexpr int AT_KROW8 = 80;
constexpr int AT_KOFF = 0, AT_VOFF = AT_MAXT * 32 * AT_KROW;
static_assert(AT_VOFF + AT_MAXT * 32 * AT_VROW <= 131072, "attention LDS images fit the ring region");
#if QKV_FP8
typedef unsigned char qkv_t;
#else
typedef bf16_t qkv_t;
#endif
struct AttnUnit {
    const qkv_t* q; const qkv_t* k; const qkv_t* v; bf16_t* o; float* lse;
    const float* sink;
    int qld, kvld, old, lseld, dil, qt0, NQ, NH, nback, ofp8;
    int pair;
};
__device__ __forceinline__ int attn_ntask(const AttnUnit& u) { return u.pair ? 8 : u.NQ * u.NH; }
__device__ __forceinline__ int attn_task_qi(const AttnUnit& u, int t) { return u.pair ? (t >= 4 ? 7 - t : t) : t / u.NH; }
__device__ __forceinline__ int attn_task_sub(const AttnUnit& u, int t) { return u.pair ? (t >> 2) : 0; }
#define attn_task(u_, t_, qi_, hq_, sub_) do { qi_ = attn_task_qi(u_, t_); sub_ = attn_task_sub(u_, t_); hq_ = (u_).pair ? 0 : (t_) - qi_ * (u_).NH; } while (0)
constexpr int AT_NUNITS = 4096;
__device__ __forceinline__ AttnUnit attn_decode(int id, qkv_t* QA, qkv_t* KA, qkv_t* VA, qkv_t* QB, qkv_t* KB, qkv_t* VB, bf16_t* OAB, bf16_t* OG, float* LSE, const float* sinks) {
    AttnUnit u;
    u.pair = 0;
    if (id < 1024) { const int kvh = id & 3, qb = (id >> 2) & 7, b = id >> 5; const size_t t0 = (size_t)b * SEQ;
        u.q = QA + t0 * 1024 + kvh * 256; u.k = KA + t0 * 256 + kvh * 64; u.v = VA + t0 * 256 + kvh * 64; u.o = P3_FP8 ? (bf16_t*)((unsigned char*)OAB + t0 * 1280 + kvh * 256) : OAB + t0 * 1280 + kvh * 256; u.lse = nullptr; u.sink = sinks + kvh * 4;
        u.qld = 1024; u.kvld = 256; u.old = 1280; u.lseld = 0; u.dil = 1; u.qt0 = 8 * qb; u.NQ = 8; u.NH = 4; u.nback = 127; u.ofp8 = P3_FP8; return u; }
    id -= 1024; int head, res, b; u.ofp8 = 0;
    if (id < 1024) { head = id & 3; u.qt0 = 8 * ((id >> 2) & 7); b = id >> 5; res = 0; u.dil = 1; u.NQ = 8; }
    else if (id < 2048) { id -= 1024; head = 4 + (id & 3); res = (id >> 2) & 3; u.qt0 = 8 * ((id >> 4) & 1); b = id >> 5; u.dil = 4; u.NQ = 8; }
    else { id -= 2048; head = 8 + (id & 3); res = 2 * ((id >> 2) & 7); b = id >> 5; u.qt0 = 0; u.dil = 16; u.NQ = 4; u.pair = 1; }
    const size_t t0 = (size_t)b * SEQ + res;
    u.q = QB + t0 * 768 + head * 64; u.k = KB + t0 * 768 + head * 64; u.v = VB + t0 * 768 + head * 64; u.o = OG + t0 * 768 + head * 64; u.lse = LSE + t0 * 12 + head; u.sink = nullptr;
    u.qld = 768; u.kvld = 768; u.old = 768; u.lseld = 12; u.NH = 1; u.nback = 128; return u;
}
#if QKV_FP8
constexpr int AT_NPRE = AT_MAXT / 2;
__device__ __forceinline__ void attn_prefetch(const AttnUnit& u, u32x4 (&pre)[AT_NPRE], int tid) {
    const int w0 = u.qt0 > 4 ? u.qt0 - 4 : 0, NK = u.pair ? 8 : u.qt0 + u.NQ - w0;
    const int part = tid & 7;
    const qkv_t* src = (part < 4 ? u.k : u.v) + (size_t)(32 * w0 + (tid >> 3)) * u.dil * u.kvld + (part & 3) * 16;
    const size_t step = (size_t)64 * u.dil * u.kvld;
#pragma unroll
    for (int j = 0; j < AT_NPRE; ++j) if (2 * j < NK) pre[j] = *(const u32x4*)(src + (u.pair ? (size_t)(j & 1) * step + (size_t)(j >> 1) * u.kvld : j * step));
}
__device__ __forceinline__ void fp8x16_to_bf16(const u32x4 w, u32x4& o0, u32x4& o1) {
    f32x2 t;
    t = __builtin_amdgcn_cvt_pk_f32_fp8((int)w.x, false); o0.x = pk2(t[0], t[1]); t = __builtin_amdgcn_cvt_pk_f32_fp8((int)w.x, true); o0.y = pk2(t[0], t[1]);
    t = __builtin_amdgcn_cvt_pk_f32_fp8((int)w.y, false); o0.z = pk2(t[0], t[1]); t = __builtin_amdgcn_cvt_pk_f32_fp8((int)w.y, true); o0.w = pk2(t[0], t[1]);
    t = __builtin_amdgcn_cvt_pk_f32_fp8((int)w.z, false); o1.x = pk2(t[0], t[1]); t = __builtin_amdgcn_cvt_pk_f32_fp8((int)w.z, true); o1.y = pk2(t[0], t[1]);
    t = __builtin_amdgcn_cvt_pk_f32_fp8((int)w.w, false); o1.z = pk2(t[0], t[1]); t = __builtin_amdgcn_cvt_pk_f32_fp8((int)w.w, true); o1.w = pk2(t[0], t[1]);
}
__device__ __forceinline__ void attn_stage(const AttnUnit& u, const u32x4 (&pre)[AT_NPRE], LAS unsigned char* lds, int tid) {
    const int w0 = u.qt0 > 4 ? u.qt0 - 4 : 0, NK = u.pair ? 8 : u.qt0 + u.NQ - w0; (void)w0;
    const int part = tid & 7, row0 = tid >> 3;
#pragma unroll
    for (int j = 0; j < AT_NPRE; ++j) if (2 * j < NK) {
        const int row = row0 + 64 * j;
#if ATT_QK8
        if (part < 4) { *(LAS u32x4*)(lds + AT_KOFF + row * AT_KROW8 + part * 16) = pre[j]; continue; }
#endif
        u32x4 o0, o1; fp8x16_to_bf16(pre[j], o0, o1);
        LAS unsigned char* dst = part < 4 ? lds + AT_KOFF + row * AT_KROW + part * 32 : lds + AT_VOFF + row * AT_VROW + (((part - 4) * 32) ^ (((row >> 1) & 1) << 6));
        *(LAS u32x4*)dst = o0; *(LAS u32x4*)(dst + 16) = o1;
    }
}
#else
constexpr int AT_NPRE = AT_MAXT;
__device__ __forceinline__ void attn_prefetch(const AttnUnit& u, u32x4 (&pre)[AT_MAXT], int tid) {
    const int w0 = u.qt0 > 4 ? u.qt0 - 4 : 0, NK = u.qt0 + u.NQ - w0;
    const int part = tid & 15;
    const bf16_t* src = (part < 8 ? u.k : u.v) + (size_t)(32 * w0 + (tid >> 4)) * u.dil * u.kvld + (part & 7) * 8;
    const size_t step = (size_t)32 * u.dil * u.kvld;
#pragma unroll
    for (int j = 0; j < AT_MAXT; ++j) if (j < NK) pre[j] = *(const u32x4*)(src + j * step);
}
__device__ __forceinline__ void attn_stage(const AttnUnit& u, const u32x4 (&pre)[AT_MAXT], LAS unsigned char* lds, int tid) {
    const int w0 = u.qt0 > 4 ? u.qt0 - 4 : 0, NK = u.qt0 + u.NQ - w0;
    const int part = tid & 15, row0 = tid >> 4;
#pragma unroll
    for (int j = 0; j < AT_MAXT; ++j) if (j < NK) {
        const int row = row0 + 32 * j;
        if (part < 8) *(LAS u32x4*)(lds + AT_KOFF + row * AT_KROW + part * 16) = pre[j];
        else *(LAS u32x4*)(lds + AT_VOFF + row * AT_VROW + ((((part - 8) * 16)) ^ (((row >> 1) & 1) << 6))) = pre[j];
    }
}
#endif
typedef short v4i16_t __attribute__((ext_vector_type(4)));
__device__ __forceinline__ void attn_load_q_raw(const AttnUnit& u, int t, int lane, u32x2 (&raw)[4]) {
    int qi, hq, sub; attn_task(u, t, qi, hq, sub);
    const unsigned char* qp = (const unsigned char*)u.q + ((size_t)(32 * (u.qt0 + qi) + (lane & 31)) * u.dil + sub) * u.qld + hq * 64 + 32 * (lane >> 5);
    const u32x4 q0 = *(const u32x4*)qp, q1 = *(const u32x4*)(qp + 16);
    raw[0].x = q0.x; raw[0].y = q0.y; raw[1].x = q0.z; raw[1].y = q0.w; raw[2].x = q1.x; raw[2].y = q1.y; raw[3].x = q1.z; raw[3].y = q1.w;
}
__device__ __forceinline__ void attn_cvt_q(const u32x2 (&raw)[4], bf16x8 (&qf)[4]) {
#if ATT_QK8
    { u32x4 a, b; a.x = raw[0].x; a.y = raw[0].y; a.z = raw[1].x; a.w = raw[1].y; b.x = raw[2].x; b.y = raw[2].y; b.z = raw[3].x; b.w = raw[3].y;
      qf[0] = __builtin_bit_cast(bf16x8, a); qf[1] = __builtin_bit_cast(bf16x8, b); return; }
#endif
#pragma unroll
    for (int ds = 0; ds < 4; ++ds) { const f32x4 a = fp8x4_f32(raw[ds].x) * QSCALE, b = fp8x4_f32(raw[ds].y) * QSCALE;
        u32x4 p; p.x = pk2(a[0], a[1]); p.y = pk2(a[2], a[3]); p.z = pk2(b[0], b[1]); p.w = pk2(b[2], b[3]); qf[ds] = __builtin_bit_cast(bf16x8, p); }
}
__device__ __forceinline__ void attn_load_q(const AttnUnit& u, int t, int lane, bf16x8 (&qf)[4]) {
    const int qi = t / u.NH, hq = t - qi * u.NH;
    const qkv_t* qp = u.q + (size_t)(32 * (u.qt0 + qi) + (lane & 31)) * u.dil * u.qld + hq * 64 + 8 * (lane >> 5);
#if QKV_FP8
    u32x2 raw[4];
    attn_load_q_raw(u, t, lane, raw); attn_cvt_q(raw, qf); (void)qp;
#else
#pragma unroll
    for (int ds = 0; ds < 4; ++ds) qf[ds] = *(const bf16x8*)(qp + 16 * ds);
#endif
}
__device__ __forceinline__ void attn_compute(const AttnUnit& u, const AttnUnit& nu, bool has_nu, LAS unsigned char* lds, int wave, int lane, bf16x8 (&qf)[4]) {
    const int r = lane & 31, hi = lane >> 5, w0 = u.qt0 > 4 ? u.qt0 - 4 : 0;
    const int ntask = attn_ntask(u);
    const int q4 = (lane & 15) >> 2, p4 = lane & 3, blk = (lane >> 4) & 1;
    const int vlane = (4 * hi + q4) * AT_VROW + 32 * blk + 8 * p4, vsw = ((q4 >> 1) & 1) << 6;
    for (int t = wave; t < ntask; t += 8) {
        int qi, hq, sub; attn_task(u, t, qi, hq, sub);
        const int qt = u.qt0 + qi, c0 = 32 * qt;
        const bool has_sink = u.sink != nullptr;
        float m = has_sink ? u.sink[hq] * LOG2E : -1e30f, l = (has_sink && hi == 0) ? 1.f : 0.f;
        f32x16 O0 = {}, O1 = {};
        u32x2 rawn[4]; const bool nx_here = t + 8 < ntask, nx_unit = !nx_here && has_nu && wave < attn_ntask(nu);
        if (nx_here) attn_load_q_raw(u, t + 8, lane, rawn); else if (nx_unit) attn_load_q_raw(nu, wave, lane, rawn);
        const int kt0 = qt > 4 ? qt - 4 : 0, qpos = c0 + r;
        for (int kt = kt0; kt <= qt; ++kt) {
            const int ti = kt - w0 + 4 * sub;
#if ATT_QK8
            const LAS unsigned char* kp = lds + AT_KOFF + (ti * 32 + r) * AT_KROW8 + 32 * hi;
            const v8i32_t kf8 = __builtin_shufflevector(*(const LAS v4i32_t*)kp, *(const LAS v4i32_t*)(kp + 16), 0, 1, 2, 3, 4, 5, 6, 7);
#else
            const LAS unsigned char* kp = lds + AT_KOFF + (ti * 32 + r) * AT_KROW + 64 * hi;
            bf16x8 kf[4];
#pragma unroll
            for (int ds = 0; ds < 4; ++ds) kf[ds] = *(const LAS bf16x8*)(kp + 16 * ds);
#endif
            const LAS unsigned char* vp = lds + AT_VOFF + ti * 32 * AT_VROW + vlane;
            s16x4 va[2][2][2];
#pragma unroll
            for (int dt = 0; dt < 2; ++dt)
#pragma unroll
                for (int sx = 0; sx < 2; ++sx)
#pragma unroll
                    for (int tx = 0; tx < 2; ++tx)
                        va[dt][sx][tx] = __builtin_bit_cast(s16x4, __builtin_amdgcn_ds_read_tr16_b64_v4i16((LAS v4i16_t*)(vp + (16 * sx + 8 * tx) * AT_VROW + ((64 * dt) ^ vsw))));
            f32x16 x = {};
#if ATT_QK8
            { const v8i32_t q8 = __builtin_shufflevector(__builtin_bit_cast(v4i32_t, qf[0]), __builtin_bit_cast(v4i32_t, qf[1]), 0, 1, 2, 3, 4, 5, 6, 7);
              x = __builtin_amdgcn_mfma_scale_f32_32x32x64_f8f6f4(kf8, q8, x, 0, 0, 0, 0, 0, 0); }
#else
#pragma unroll
            for (int ds = 0; ds < 4; ++ds) x = __builtin_amdgcn_mfma_f32_32x32x16_bf16(kf[ds], qf[ds], x, 0, 0, 0);
#endif
            if (kt == qt) {
                const int rr = r - 4 * hi;
#pragma unroll
                for (int i = 0; i < 16; ++i) if (crow(i, 0) > rr) x[i] = -INFINITY;
            } else if (kt == qt - 4) {
                const int thr = r - 4 * hi - (u.nback - 128);
#pragma unroll
                for (int i = 0; i < 16; ++i) if (crow(i, 0) < thr) x[i] = -INFINITY;
            }
            float mx = x[0];
#pragma unroll
            for (int i = 1; i < 16; ++i) mx = __builtin_fmaxf(mx, x[i]);
            { const auto sw = __builtin_amdgcn_permlane32_swap(__float_as_uint(mx), __float_as_uint(mx), false, false);
              mx = __builtin_fmaxf(__uint_as_float(sw[0]), __uint_as_float(sw[1])); }
#if ATT_QK8
            mx *= QSCALE;
#endif
            if (__builtin_amdgcn_ballot_w64(mx > m + AT_THR) != 0ull) {
                const float mnew = __builtin_fmaxf(m, mx), alpha = __builtin_amdgcn_exp2f(m - mnew);
                m = mnew; l *= alpha;
#pragma unroll
                for (int i = 0; i < 16; ++i) { O0[i] *= alpha; O1[i] *= alpha; }
            }
            float ls = 0.f;
#pragma unroll
#if ATT_QK8
            for (int i = 0; i < 16; ++i) { x[i] = __builtin_amdgcn_exp2f(__builtin_fmaf(x[i], QSCALE, -m)); ls += x[i]; }
#else
            for (int i = 0; i < 16; ++i) { x[i] = __builtin_amdgcn_exp2f(x[i] - m); ls += x[i]; }
#endif
            l += ls;
            bf16x8 pf[2];
#pragma unroll
            for (int sx = 0; sx < 2; ++sx) { u32x4 p; p.x = pk2(x[8 * sx], x[8 * sx + 1]); p.y = pk2(x[8 * sx + 2], x[8 * sx + 3]); p.z = pk2(x[8 * sx + 4], x[8 * sx + 5]); p.w = pk2(x[8 * sx + 6], x[8 * sx + 7]); pf[sx] = __builtin_bit_cast(bf16x8, p); }
#pragma unroll
            for (int sx = 0; sx < 2; ++sx) {
                const bf16x8 v0 = __builtin_shufflevector(va[0][sx][0], va[0][sx][1], 0, 1, 2, 3, 4, 5, 6, 7), v1 = __builtin_shufflevector(va[1][sx][0], va[1][sx][1], 0, 1, 2, 3, 4, 5, 6, 7);
                O0 = __builtin_amdgcn_mfma_f32_32x32x16_bf16(v0, pf[sx], O0, 0, 0, 0);
                O1 = __builtin_amdgcn_mfma_f32_32x32x16_bf16(v1, pf[sx], O1, 0, 0, 0);
            }
        }
        l += __shfl_xor(l, 32);
        const float inv = 1.0f / l;
        const size_t oel = ((size_t)(c0 + r) * u.dil + sub) * u.old + hq * 64 + 16 * hi;
        if (u.ofp8) {
            unsigned char* op8 = (unsigned char*)u.o + oel; const float sc8 = inv * OA_SCALE;
            unsigned w0_[4], w1_[4];
#pragma unroll
            for (int g = 0; g < 4; ++g) { w0_[g] = pk4_fp8(O0[4 * g] * sc8, O0[4 * g + 1] * sc8, O0[4 * g + 2] * sc8, O0[4 * g + 3] * sc8); w1_[g] = pk4_fp8(O1[4 * g] * sc8, O1[4 * g + 1] * sc8, O1[4 * g + 2] * sc8, O1[4 * g + 3] * sc8); }
            const auto a02 = __builtin_amdgcn_permlane32_swap(w0_[0], w0_[2], false, false), a13 = __builtin_amdgcn_permlane32_swap(w0_[1], w0_[3], false, false);
            const auto b02 = __builtin_amdgcn_permlane32_swap(w1_[0], w1_[2], false, false), b13 = __builtin_amdgcn_permlane32_swap(w1_[1], w1_[3], false, false);
            u32x4 s0, s1; s0.x = a02[0]; s0.y = a02[1]; s0.z = a13[0]; s0.w = a13[1]; s1.x = b02[0]; s1.y = b02[1]; s1.z = b13[0]; s1.w = b13[1];
            *(u32x4*)op8 = s0; *(u32x4*)(op8 + 32) = s1;
        } else {
            bf16_t* op = u.o + oel;
            u32x2 w0_[4], w1_[4];
#pragma unroll
            for (int g = 0; g < 4; ++g) {
                w0_[g].x = pk2(O0[4 * g] * inv, O0[4 * g + 1] * inv); w0_[g].y = pk2(O0[4 * g + 2] * inv, O0[4 * g + 3] * inv);
                w1_[g].x = pk2(O1[4 * g] * inv, O1[4 * g + 1] * inv); w1_[g].y = pk2(O1[4 * g + 2] * inv, O1[4 * g + 3] * inv);
            }
#define AT_SWAP_STORE(w_, dst_) do { \
                const auto x02_ = __builtin_amdgcn_permlane32_swap(w_[0].x, w_[2].x, false, false), y02_ = __builtin_amdgcn_permlane32_swap(w_[0].y, w_[2].y, false, false); \
                const auto x13_ = __builtin_amdgcn_permlane32_swap(w_[1].x, w_[3].x, false, false), y13_ = __builtin_amdgcn_permlane32_swap(w_[1].y, w_[3].y, false, false); \
                u32x4 s0_, s1_; s0_.x = x02_[0]; s0_.y = y02_[0]; s0_.z = x02_[1]; s0_.w = y02_[1]; s1_.x = x13_[0]; s1_.y = y13_[0]; s1_.z = x13_[1]; s1_.w = y13_[1]; \
                *(u32x4*)(dst_) = s0_; *(u32x4*)((dst_) + 8) = s1_; } while (0)
            AT_SWAP_STORE(w0_, op); AT_SWAP_STORE(w1_, op + 32);
#undef AT_SWAP_STORE
        }
        if (u.lse && hi == 0) u.lse[((size_t)(c0 + r) * u.dil + sub) * u.lseld] = m + __builtin_amdgcn_logf(l);
        if (nx_here || nx_unit) attn_cvt_q(rawn, qf);
    }
    if (wave >= ntask && has_nu && wave < attn_ntask(nu)) attn_load_q(nu, wave, lane, qf);
}

struct Args { const float* in[16]; float* out; unsigned char* ws; int ph_lo, ph_hi, li, var; };
constexpr int NPHASE = 8 + 2 * NHALF;

__device__ __forceinline__ void p0_transpose_item(const float* W, int N, int k0, int n0, bf16_t* WT, size_t ldo, size_t orow0, size_t ocol0, LAS float* scr, int lane) {
#pragma unroll 8
    for (int i = 0; i < 32; ++i) { const int kk = 2 * i + (lane >> 5); scr[kk * 33 + (lane & 31)] = W[(size_t)(k0 + kk) * N + n0 + (lane & 31)]; }
    LDS_WAIT(); asm volatile("" ::: "memory");
    const int c = lane & 7;
#pragma unroll
    for (int j = 0; j < 4; ++j) { const int n = (lane >> 3) + 8 * j; const LAS float* s = scr + (8 * c) * 33 + n;
        u32x4 o; o.x = pk2(s[0 * 33], s[1 * 33]); o.y = pk2(s[2 * 33], s[3 * 33]); o.z = pk2(s[4 * 33], s[5 * 33]); o.w = pk2(s[6 * 33], s[7 * 33]);
        *(u32x4*)(WT + (orow0 + n) * ldo + ocol0 + 8 * c) = o; }
    LDS_WAIT(); asm volatile("" ::: "memory");
}

__device__ __forceinline__ void p0_transpose_item_f8(const float* W, int N, int k0, int n0, unsigned char* WT, size_t ldo, size_t orow0, size_t ocol0, float scale, LAS float* scr, int lane) {
#pragma unroll 8
    for (int i = 0; i < 32; ++i) { const int kk = 2 * i + (lane >> 5); scr[kk * 33 + (lane & 31)] = W[(size_t)(k0 + kk) * N + n0 + (lane & 31)]; }
    LDS_WAIT(); asm volatile("" ::: "memory");
#pragma unroll
    for (int j = 0; j < 2; ++j) { const int id = lane + 64 * j, n = id >> 2, c = id & 3; const LAS float* sp = scr + (16 * c) * 33 + n;
        u32x4 o;
        o.x = pk4_fp8(sp[0 * 33] * scale, sp[1 * 33] * scale, sp[2 * 33] * scale, sp[3 * 33] * scale); o.y = pk4_fp8(sp[4 * 33] * scale, sp[5 * 33] * scale, sp[6 * 33] * scale, sp[7 * 33] * scale);
        o.z = pk4_fp8(sp[8 * 33] * scale, sp[9 * 33] * scale, sp[10 * 33] * scale, sp[11 * 33] * scale); o.w = pk4_fp8(sp[12 * 33] * scale, sp[13 * 33] * scale, sp[14 * 33] * scale, sp[15 * 33] * scale);
        *(u32x4*)(WT + (orow0 + n) * ldo + ocol0 + 16 * c) = o; }
    LDS_WAIT(); asm volatile("" ::: "memory");
}

__device__ __forceinline__ int opaque_tid() { int t = threadIdx.x; asm volatile("" : "+v"(t)); return t; }
__global__ void __launch_bounds__(512, 2) mk_fwd(Args args) {
    extern __shared__ __attribute__((aligned(16))) unsigned char lds_raw[];
    LAS unsigned char* lds = (LAS unsigned char*)lds_raw;
    volatile LAS unsigned* MISC = (volatile LAS unsigned*)(lds + MISC_OFF);
    const int tid = threadIdx.x, lane = tid & 63, wave = __builtin_amdgcn_readfirstlane(tid >> 6);
    const int G = gridDim.x, bx = blockIdx.x;
    const int gw = bx * 8 + wave, NGW = G * 8;
    unsigned char* const ws = args.ws;
    unsigned* const ctl = (unsigned*)(ws + WS_CTL);
#define X_IN     (args.in[0])
#define w_in     (args.in[1])
#define sinks    (args.in[2])
#define w_ba     (args.in[3])
#define w_bb     (args.in[4])
#define w_out    (args.in[5])
#define ln1g     (args.in[6])
#define ln1b     (args.in[7])
#define w_router (args.in[8])
#define b_router (args.in[9])
#define w_gu     (args.in[10])
#define b_gu     (args.in[11])
#define w_dn     (args.in[12])
#define b_dn     (args.in[13])
#define ln2g     (args.in[14])
#define ln2b     (args.in[15])
#define OUTP     (args.out)
#define csT    ((unsigned*)(ws + WS_COS))
#define WIN    ((bf16_t*)(ws + WS_WIN))
#define WAB    ((bf16_t*)(ws + WS_WAB))
#define WOUT   ((bf16_t*)(ws + WS_WOUT))
#define WGU    ((unsigned char*)(ws + WS_WGU))
#define WDN    ((unsigned char*)(ws + WS_WDN))
#define H1F8   ((unsigned char*)(ws + WS_H1F8))
#define STATS  ((float*)(ws + WS_STATS))
#define TOPE   ((int*)(ws + WS_TOPE))
#define TOPW   ((float*)(ws + WS_TOPW))
#define HIST   ((int*)(ws + WS_HIST))
#define ROWTOK ((int*)(ws + WS_ROWTOK))
#define ROWDST ((int*)(ws + WS_ROWDST))
#define TILEE  ((int*)(ws + WS_TILEE))
#define OAB    ((bf16_t*)(ws + WS_OAB))
#define XB     ((bf16_t*)(ws + WS_XB))
#define H1     ((bf16_t*)(ws + WS_H1))
#define Gt     ((bf16_t*)(ws + WS_G))
#define KB     ((bf16_t*)(ws + WS_KB))
#define VAT    ((bf16_t*)(ws + WS_VAT))
#define VBT    ((bf16_t*)(ws + WS_VBT))
#define OG     ((bf16_t*)(ws + WS_OG))
#define LSE    ((float*)(ws + WS_LSE))
#define MERGED ((bf16_t*)(ws + WS_MERGED))
#define Hh     ((unsigned char*)(ws + WS_H))
#define Y      ((bf16_t*)(ws + WS_Y))
#define QA     ((bf16_t*)((unsigned char*)args.out + DO_QA))
#define QB     ((bf16_t*)((unsigned char*)args.out + DO_QB))
#define KA     ((bf16_t*)((unsigned char*)args.out + DO_KA))

    for (int u = tid; u < (LDS_BYTES - LDSCTL_OFF) / 4; u += 512) ((LAS unsigned*)(lds + LDSCTL_OFF))[u] = 0u;
    __syncthreads();
    XcdBarrier bar; bar.bar = ctl + CW_BAR + args.li * XCD_BAR_WORDS; bar.x = 0; bar.st = nullptr;
    if (MK_ONE_LAUNCH) bar = xcd_barrier_post(ctl + CW_BAR + args.li * XCD_BAR_WORDS, MISC + 8);
    const int lo = args.ph_lo, hi = args.ph_hi;
#ifndef PH_MASK
#define PH_MASK 0xFFFF
#endif
#define IN(k) (((PH_MASK >> (k)) & 1) && lo <= (k) && (k) < hi)
#define SEAM(k) do { if (IN(k) && IN((k) + 1)) xcd_barrier(bar); } while (0)
#ifndef REPEAT_MASK
#define REPEAT_MASK 0
#endif
#define REPN(k) ((((REPEAT_MASK) >> (k)) & 1) ? 2 : 1)
#define REP_LOOP(k) for (int rep_ = 0; rep_ < REPN(k); ++rep_)
#define REP_SYNC() do { if (rep_) xcd_barrier(bar); } while (0)

    if (IN(0)) { REP_LOOP(0) { REP_SYNC(); const int tid = opaque_tid(), lane = tid & 63, wave = __builtin_amdgcn_readfirstlane(tid >> 6), gw = bx * 8 + wave; (void)lane; (void)wave; (void)gw;

        LAS float* scr = (LAS float*)(lds + wave * 16384);
        constexpr int I_IN = 16 * 184, I_BA = 16 * 32, I_BB = 4 * 32, I_OUT = 16 * 32, I_GU = 32 * 16 * 64, I_DN = 32 * 16 * 32;
        constexpr int NITEMS = I_IN + I_BA + I_BB + I_OUT + I_GU + I_DN;
        for (int it = gw; it < NITEMS; it += NGW) {
            int r = it;
            if (r < I_IN) { const int kb = r / 184, nb = r % 184, n0 = 32 * nb, tile = n0 >> 8, within = n0 & 255;
                (void)tile; (void)within;
#if P1_FP8
                p0_transpose_item_f8(w_in, INW, 64 * kb, n0, (unsigned char*)WIN, 1024, n0, 64 * kb, W8_SCALE, scr, lane); continue; } r -= I_IN;
#else
                p0_transpose_item(w_in, INW, 64 * kb, n0, WIN, 1024, n0, 64 * kb, scr, lane); continue; } r -= I_IN;
#endif
#if P3_FP8
            if (r < I_BA) { const int kb = r / 32, nb = r % 32; p0_transpose_item_f8(w_ba, 1024, 64 * kb, 32 * nb, (unsigned char*)WAB, 1280, 32 * nb, 64 * kb, W8_SCALE, scr, lane); continue; } r -= I_BA;
            if (r < I_BB) { const int kb = r / 32, nb = r % 32; p0_transpose_item_f8(w_bb, 1024, 64 * kb, 32 * nb, (unsigned char*)WAB, 1280, 32 * nb, 1024 + 64 * kb, W8_SCALE, scr, lane); continue; } r -= I_BB;
#else
            if (r < I_BA) { const int kb = r / 32, nb = r % 32; p0_transpose_item(w_ba, 1024, 64 * kb, 32 * nb, WAB, 1280, 32 * nb, 64 * kb, scr, lane); continue; } r -= I_BA;
            if (r < I_BB) { const int kb = r / 32, nb = r % 32; p0_transpose_item(w_bb, 1024, 64 * kb, 32 * nb, WAB, 1280, 32 * nb, 1024 + 64 * kb, scr, lane); continue; } r -= I_BB;
#endif
#if P4_FP8
            if (r < I_OUT) { const int kb = r / 32, nb = r % 32; p0_transpose_item_f8(w_out, 1024, 64 * kb, 32 * nb, (unsigned char*)WOUT, 1024, 32 * nb, 64 * kb, W8_SCALE, scr, lane); continue; } r -= I_OUT;
#else
            if (r < I_OUT) { const int kb = r / 32, nb = r % 32; p0_transpose_item(w_out, 1024, 64 * kb, 32 * nb, WOUT, 1024, 32 * nb, 64 * kb, scr, lane); continue; } r -= I_OUT;
#endif
            if (r < I_GU) { const int e = r / 1024, q = r % 1024, kb = q / 64, nb = q % 64, n0 = 32 * nb, np = n0 & 1023;
                const int orow = e * 2048 + (np >> 7) * 256 + (n0 >= 1024 ? 128 : 0) + (np & 127);
                p0_transpose_item_f8(w_gu + (size_t)e * 1024 * 2048, 2048, 64 * kb, n0, WGU, 1024, orow, 64 * kb, W8_SCALE, scr, lane); continue; } r -= I_GU;
            { const int e = r / 512, q = r % 512, kb = q / 32, nb = q % 32;
                p0_transpose_item_f8(w_dn + (size_t)e * 1024 * 1024, 1024, 64 * kb, 32 * nb, WDN, 1024, e * 1024 + 32 * nb, 64 * kb, W8_SCALE, scr, lane); }
        }
#if P1_FP8
        for (size_t i = (size_t)bx * 512 + tid; i < (size_t)T * D / 16; i += (size_t)G * 512) {
            const f32x4 a = *(const f32x4*)(X_IN + i * 16), b = *(const f32x4*)(X_IN + i * 16 + 4), c = *(const f32x4*)(X_IN + i * 16 + 8), d = *(const f32x4*)(X_IN + i * 16 + 12);
            u32x4 w; w.x = pk4_fp8(a[0], a[1], a[2], a[3]); w.y = pk4_fp8(b[0], b[1], b[2], b[3]); w.z = pk4_fp8(c[0], c[1], c[2], c[3]); w.w = pk4_fp8(d[0], d[1], d[2], d[3]);
            *(u32x4*)((unsigned char*)XB + i * 16) = w;
        }
#else
        for (size_t i = (size_t)bx * 512 + tid; i < (size_t)T * D / 8; i += (size_t)G * 512) {
            const f32x4 a = *(const f32x4*)(X_IN + i * 8), b = *(const f32x4*)(X_IN + i * 8 + 4);
            u32x4 w; w.x = pk2(a[0], a[1]); w.y = pk2(a[2], a[3]); w.z = pk2(b[0], b[1]); w.w = pk2(b[2], b[3]);
            *(u32x4*)(XB + i * 8) = w;
        }
#endif
        for (int i = bx * 512 + tid; i < SEQ * 32; i += G * 512) {
            const int pos = i >> 5, f = i & 31;
            const double invf = exp2(-(double)f * (13.287712379549449 / 32.0));
            const double ang = (double)pos * invf;
            csT[((f & 7) >> 2) * (SEQ * 16) + ((((pos >> 4) * 4 + (f >> 3)) * 16 + (pos & 15)) * 4) + (f & 3)] = pk2((float)cos(ang), (float)sin(ang));
        }
    }
    }
    SEAM(0);

#define XCD_STAGGER(ticks) do { if ((ticks) > 0) { if (tid == 0) { const unsigned long long te_ = __builtin_amdgcn_s_memrealtime() + (unsigned long long)((STAG_SEL) * (ticks)); \
        while (__builtin_amdgcn_s_memrealtime() < te_) __builtin_amdgcn_s_sleep(4); } __syncthreads(); } } while (0)
#ifndef STAG1
#define STAG1 0
#endif
#ifndef STAG4
#define STAG4 0
#endif
#ifndef STAG7
#define STAG7 0
#endif
#ifndef STAG8
#define STAG8 0
#endif
#ifndef STAG_SEL
#define STAG_SEL ((bx >> 3) & 1)
#endif
#ifdef CLKPROBE
    unsigned long long cp_t0 = 0, cp_r0 = 0, cp_t1 = 0, cp_r1 = 0;
#define CLK_BEGIN(k) do { if ((k) == CLKPROBE) { cp_t0 = __builtin_amdgcn_s_memtime(); cp_r0 = __builtin_amdgcn_s_memrealtime(); } } while (0)
#define CLK_END(k) do { if ((k) == CLKPROBE) { cp_t1 = __builtin_amdgcn_s_memtime(); cp_r1 = __builtin_amdgcn_s_memrealtime(); } } while (0)
#else
#define CLK_BEGIN(k) do {} while (0)
#define CLK_END(k) do {} while (0)
#endif
    if (IN(1)) { REP_LOOP(1) { REP_SYNC(); const int tid = opaque_tid(); (void)tid;
 CLK_BEGIN(1);
#if defined(KLOOP_PROBE) || defined(EPI_PROBE)
        if (tid == 0) MISC[17] = 1;
#endif
#ifndef P1_WGM
#define P1_WGM 8
#endif
        XCD_STAGGER(STAG1);
        pg8::StaticOrder S; S.init(T, INW, G, bx, P1_WGM);
        EpiInProj E{QA, KA, VAT, QB, KB, VBT, Gt, csT, args.var};
        pg8::gemm_phase(lds, XB, WIN, P1_FP8 ? 512 : 1024, S, pg8::ADense{}, E, pg8::NoHook{}); CLK_END(1);
#ifdef KLOOP_PROBE
        if (tid == 0) MISC[17] = 0;
#endif
    }
    }
    SEAM(1);

    if (IN(2)) { REP_LOOP(2) { REP_SYNC(); const int tid = opaque_tid(), lane = tid & 63, wave = __builtin_amdgcn_readfirstlane(tid >> 6), gw = bx * 8 + wave; (void)lane; (void)wave; (void)gw;

        __builtin_amdgcn_s_waitcnt(0x0F70);
        u32x4 pre[AT_NPRE];
        AttnUnit cu = attn_decode(bx, (qkv_t*)QA, (qkv_t*)KA, (qkv_t*)VAT, (qkv_t*)QB, (qkv_t*)KB, (qkv_t*)VBT, OAB, OG, LSE, sinks);
        if (bx < AT_NUNITS) attn_prefetch(cu, pre, tid);
        bf16x8 qf[4];
        if (bx < AT_NUNITS && wave < attn_ntask(cu)) attn_load_q(cu, wave, lane, qf);
        for (int id = bx; id < AT_NUNITS; id += G) {
            attn_stage(cu, pre, lds, tid);
            LDS_WAIT(); __builtin_amdgcn_s_barrier(); asm volatile("" ::: "memory");
            const AttnUnit me = cu;
            const bool has_nu = id + G < AT_NUNITS;
            if (has_nu) { cu = attn_decode(id + G, (qkv_t*)QA, (qkv_t*)KA, (qkv_t*)VAT, (qkv_t*)QB, (qkv_t*)KB, (qkv_t*)VBT, OAB, OG, LSE, sinks); attn_prefetch(cu, pre, tid); }
            attn_compute(me, cu, has_nu, lds, wave, lane, qf);
            LDS_WAIT(); __builtin_amdgcn_s_barrier(); asm volatile("" ::: "memory");
        }
    } }
    SEAM(2);

    if (IN(3)) { REP_LOOP(3) { REP_SYNC(); const int tid = opaque_tid(), lane = tid & 63, wave = __builtin_amdgcn_readfirstlane(tid >> 6), gw = bx * 8 + wave; (void)lane; (void)wave; (void)gw;

        for (size_t i = (size_t)bx * 512 + tid; i < (size_t)T * 32; i += (size_t)G * 512) {
            const size_t tok = i >> 5; const int hh = (int)(i >> 3) & 3, ch = (int)i & 7;
            const float l0 = LSE[tok * 12 + hh], l1 = LSE[tok * 12 + 4 + hh], l2 = LSE[tok * 12 + 8 + hh];
            const float mx = __builtin_fmaxf(l0, __builtin_fmaxf(l1, l2));
            float w0 = __builtin_amdgcn_exp2f(l0 - mx), w1 = __builtin_amdgcn_exp2f(l1 - mx), w2 = __builtin_amdgcn_exp2f(l2 - mx);
            const float inv = 1.0f / (w0 + w1 + w2); w0 *= inv; w1 *= inv; w2 *= inv;
            const u32x4 a = *(const u32x4*)(OG + tok * 768 + hh * 64 + ch * 8), c = *(const u32x4*)(OG + tok * 768 + (4 + hh) * 64 + ch * 8), d = *(const u32x4*)(OG + tok * 768 + (8 + hh) * 64 + ch * 8);
            u32x4 w;
            w.x = pk2(w0 * bflo(a.x) + w1 * bflo(c.x) + w2 * bflo(d.x), w0 * bfhi(a.x) + w1 * bfhi(c.x) + w2 * bfhi(d.x));
            w.y = pk2(w0 * bflo(a.y) + w1 * bflo(c.y) + w2 * bflo(d.y), w0 * bfhi(a.y) + w1 * bfhi(c.y) + w2 * bfhi(d.y));
            w.z = pk2(w0 * bflo(a.z) + w1 * bflo(c.z) + w2 * bflo(d.z), w0 * bfhi(a.z) + w1 * bfhi(c.z) + w2 * bfhi(d.z));
            w.w = pk2(w0 * bflo(a.w) + w1 * bflo(c.w) + w2 * bflo(d.w), w0 * bfhi(a.w) + w1 * bfhi(c.w) + w2 * bfhi(d.w));
#if P3_FP8
            { f32x4 lo, hi; lo = (f32x4){bflo(w.x), bfhi(w.x), bflo(w.y), bfhi(w.y)} * OA_SCALE; hi = (f32x4){bflo(w.z), bfhi(w.z), bflo(w.w), bfhi(w.w)} * OA_SCALE;
              u32x2 w8; w8.x = pk4_fp8(lo[0], lo[1], lo[2], lo[3]); w8.y = pk4_fp8(hi[0], hi[1], hi[2], hi[3]);
              *(u32x2*)((unsigned char*)OAB + tok * 1280 + 1024 + hh * 64 + ch * 8) = w8; }
#else
            *(u32x4*)(OAB + tok * 1280 + 1024 + hh * 64 + ch * 8) = w;
#endif
        }
        xcd_barrier(bar);
        pg8::StaticOrder S; S.init(T, 1024, G, bx);
        EpiMerged E{Gt, MERGED}; HookGateRatio HK{Gt};
        pg8::gemm_phase(lds, OAB, WAB, P3_FP8 ? 640 : 1280, S, pg8::ADense{}, E, HK);
    }
    }
    SEAM(3);

    if (IN(4)) { REP_LOOP(4) { REP_SYNC(); const int tid = opaque_tid(); (void)tid;

        XCD_STAGGER(STAG4);
        pg8::StaticOrder S; S.init(T, 1024, G, bx);
        EpiPre E{X_IN, OUTP, STATS, H1};
        pg8::gemm_phase(lds, MERGED, WOUT, P4_FP8 ? 512 : 1024, S, pg8::ADense{}, E, pg8::NoHook{});
    }
    }
    SEAM(4);

#if P5_SINGLE
    if (IN(5)) { REP_LOOP(5) { REP_SYNC(); const int tid = opaque_tid(), lane = tid & 63, wave = __builtin_amdgcn_readfirstlane(tid >> 6), gw = bx * 8 + wave; (void)gw;
        constexpr int GWROW = 2064;
        LAS unsigned char* GWH = lds; LAS unsigned char* GWL = lds + 32 * GWROW;
        LAS int* histL = (LAS int*)(lds + SCR_OFF); LAS float* brL = (LAS float*)(histL + 32); LAS float* gL = brL + 32; LAS float* bL = gL + 1024;
        { float wv[64];
#pragma unroll
          for (int i = 0; i < 64; ++i) wv[i] = w_router[tid + 512 * i];
#pragma unroll
          for (int i = 0; i < 64; ++i) { const int idx = tid + 512 * i, d = idx >> 5, e = idx & 31;
            const float v = wv[i]; const unsigned hb = pk2(v, 0.f) & 0xffffu; const float vh = __uint_as_float(hb << 16); const unsigned lb = pk2(v - vh, 0.f) & 0xffffu;
            ((LAS bf16_t*)(GWH + e * GWROW))[d] = (bf16_t)hb; ((LAS bf16_t*)(GWL + e * GWROW))[d] = (bf16_t)lb; } }
        for (int d = tid; d < 1024; d += 512) { gL[d] = ln1g[d]; bL[d] = ln1b[d]; }
        if (tid < 32) brL[tid] = b_router[tid];
        __syncthreads();
        const int r32 = lane & 31, hi5 = lane >> 5;
        for (int vw = bx; vw < 256; vw += G) {
            if (tid < 32) histL[tid] = 0;
            __syncthreads();
            const int tok0 = vw * 256 + wave * 32;
            float mean, rstd;
            { const f32x4* sp = (const f32x4*)(STATS + (size_t)(tok0 + r32) * 32); float s1 = 0.f, s2 = 0.f;
#pragma unroll
              for (int i = 0; i < 8; ++i) { const f32x4 t = sp[i]; s1 += t[0] + t[2]; s2 += t[1] + t[3]; }
              mean = s1 * (1.f / 1024.f); const float var = __builtin_fmaxf(s2 * (1.f / 1024.f) - mean * mean, 0.f); rstd = 1.0f / sqrtf(var + LN_EPS); }
            const float cc = -mean * rstd;
            if (hi5 == 0) *(f32x2*)((float*)(ws + WS_MR) + (size_t)(tok0 + r32) * 2) = (f32x2){rstd, cc};
#define P5_EO(kq) (32 * ((kq) >> 1) + 8 * ((kq) & 1))
            const bf16_t* src = H1 + (size_t)(tok0 + r32) * 1024 + 16 * hi5;
            unsigned char* h8p = H1F8 + (size_t)(tok0 + r32) * 1024 + 16 * hi5;
            const LAS unsigned char* ahp = GWH + r32 * GWROW + 32 * hi5; const LAS unsigned char* alp = GWL + r32 * GWROW + 32 * hi5;
            const LAS float* glp = gL + 16 * hi5; const LAS float* blp = bL + 16 * hi5;
            f32x16 acc0 = {}, acc1 = {}, acc2 = {};
            u32x4 xa[4], xb[4];
#define P5_LOAD(buf, ks0) do { _Pragma("unroll") for (int q_ = 0; q_ < 4; ++q_) buf[q_] = *(const u32x4*)(src + P5_EO((ks0) + q_)); } while (0)
#define P5_COMP(buf, ks0) do { u32x2 w8p_ = {0u, 0u}; _Pragma("unroll") for (int q_ = 0; q_ < 4; ++q_) { const int eo_ = 16 * (ks0) + 32 * (q_ >> 1) + 8 * (q_ & 1); \
                const f32x4 g0_ = *(const LAS f32x4*)(glp + eo_), g1_ = *(const LAS f32x4*)(glp + eo_ + 4), b0_ = *(const LAS f32x4*)(blp + eo_), b1_ = *(const LAS f32x4*)(blp + eo_ + 4); \
                const f32x4 p0_ = {bflo(buf[q_].x), bfhi(buf[q_].x), bflo(buf[q_].y), bfhi(buf[q_].y)}, p1_ = {bflo(buf[q_].z), bfhi(buf[q_].z), bflo(buf[q_].w), bfhi(buf[q_].w)}; \
                const f32x4 u0_ = (p0_ * rstd + cc) * g0_ + b0_, u1_ = (p1_ * rstd + cc) * g1_ + b1_; \
                u32x4 wh_, wl_; wh_.x = pk2(u0_[0], u0_[1]); wh_.y = pk2(u0_[2], u0_[3]); wh_.z = pk2(u1_[0], u1_[1]); wh_.w = pk2(u1_[2], u1_[3]); \
                { u32x2 w8_; w8_.x = pk4_fp8(u0_[0], u0_[1], u0_[2], u0_[3]); w8_.y = pk4_fp8(u1_[0], u1_[1], u1_[2], u1_[3]); \
                  if (q_ & 1) { u32x4 w16_; w16_.x = w8p_.x; w16_.y = w8p_.y; w16_.z = w8_.x; w16_.w = w8_.y; *(u32x4*)(h8p + eo_ - 8) = w16_; } else w8p_ = w8_; } \
                wl_.x = pk2(u0_[0] - bflo(wh_.x), u0_[1] - bfhi(wh_.x)); wl_.y = pk2(u0_[2] - bflo(wh_.y), u0_[3] - bfhi(wh_.y)); \
                wl_.z = pk2(u1_[0] - bflo(wh_.z), u1_[1] - bfhi(wh_.z)); wl_.w = pk2(u1_[2] - bflo(wh_.w), u1_[3] - bfhi(wh_.w)); \
                const bf16x8 bh_ = __builtin_bit_cast(bf16x8, wh_), bl_ = __builtin_bit_cast(bf16x8, wl_); \
                const bf16x8 ah_ = *(const LAS bf16x8*)(ahp + 2 * eo_), al_ = *(const LAS bf16x8*)(alp + 2 * eo_); \
                acc0 = __builtin_amdgcn_mfma_f32_32x32x16_bf16(ah_, bh_, acc0, 0, 0, 0); acc1 = __builtin_amdgcn_mfma_f32_32x32x16_bf16(ah_, bl_, acc1, 0, 0, 0); \
                acc2 = __builtin_amdgcn_mfma_f32_32x32x16_bf16(al_, bh_, acc2, 0, 0, 0); } } while (0)
            P5_LOAD(xa, 0);
            for (int it = 0; it < 8; ++it) {
                P5_LOAD(xb, 8 * it + 4);
                P5_COMP(xa, 8 * it);
                if (it < 7) P5_LOAD(xa, 8 * it + 8);
                P5_COMP(xb, 8 * it + 4);
            }
#undef P5_LOAD
#undef P5_COMP
#undef P5_EO
            float v[16];
#pragma unroll
            for (int i = 0; i < 16; ++i) v[i] = (acc0[i] + acc1[i] + acc2[i]) + brL[crow(i, hi5)];
            float cv[8]; int ce[8];
#pragma unroll
            for (int kk = 0; kk < 4; ++kk) {
                float bv = v[0]; int bi = 0;
#pragma unroll
                for (int i = 1; i < 16; ++i) if (v[i] > bv) { bv = v[i]; bi = i; }
                cv[kk] = bv; ce[kk] = crow(bi, hi5);
#pragma unroll
                for (int i = 0; i < 16; ++i) v[i] = (i == bi) ? -INFINITY : v[i];
            }
#pragma unroll
            for (int kk = 0; kk < 4; ++kk) { cv[4 + kk] = __shfl_xor(cv[kk], 32); ce[4 + kk] = __shfl_xor(ce[kk], 32); }
            float tv[4]; int te[4];
#pragma unroll
            for (int kk = 0; kk < 4; ++kk) {
                float bv = cv[0]; int be = ce[0], bi = 0;
#pragma unroll
                for (int i = 1; i < 8; ++i) if (cv[i] > bv || (cv[i] == bv && ce[i] < be)) { bv = cv[i]; be = ce[i]; bi = i; }
                tv[kk] = bv; te[kk] = be;
#pragma unroll
                for (int i = 0; i < 8; ++i) cv[i] = (i == bi) ? -INFINITY : cv[i];
            }
            { const float e1 = __expf(tv[1] - tv[0]), e2 = __expf(tv[2] - tv[0]), e3 = __expf(tv[3] - tv[0]); const float inv = 1.0f / (1.0f + e1 + e2 + e3);
              if (hi5 == 0) { const size_t tk = (size_t)(tok0 + r32) * 4;
                  *(int4*)(TOPE + tk) = make_int4(te[0], te[1], te[2], te[3]); *(f32x4*)(TOPW + tk) = (f32x4){inv, e1 * inv, e2 * inv, e3 * inv};
                  atomicAdd((int*)(histL + te[0]), 1); atomicAdd((int*)(histL + te[1]), 1); atomicAdd((int*)(histL + te[2]), 1); atomicAdd((int*)(histL + te[3]), 1); } }
            __syncthreads();
            if (tid < 32) HIST[vw * 32 + tid] = histL[tid];
            __syncthreads();
        }
    } }
#else
    if (IN(5)) { REP_LOOP(5) { REP_SYNC(); const int tid = opaque_tid(), lane = tid & 63, wave = __builtin_amdgcn_readfirstlane(tid >> 6), gw = bx * 8 + wave; (void)lane; (void)wave; (void)gw;

        constexpr int GWROW = 2064;
        LAS unsigned char* GWH = lds; LAS unsigned char* GWL = lds + 32 * GWROW;
        LAS float* gws = (LAS float*)(lds + SCR_OFF); LAS float* bws = gws + 32; LAS int* histL = (LAS int*)(bws + 32); LAS float* partL = (LAS float*)(histL + 32);
        for (int idx = tid; idx < 32 * 1024; idx += 512) { const int d = idx >> 5, e = idx & 31;
            const float v = w_router[idx] * ln1g[d]; const unsigned hb = pk2(v, 0.f) & 0xffffu; const float vh = __uint_as_float(hb << 16); const unsigned lb = pk2(v - vh, 0.f) & 0xffffu;
            ((LAS bf16_t*)(GWH + e * GWROW))[d] = (bf16_t)hb; ((LAS bf16_t*)(GWL + e * GWROW))[d] = (bf16_t)lb; }
        { const int e = tid & 31, p = tid >> 5; float sg = 0.f, sb = 0.f;
          for (int d = 64 * p; d < 64 * p + 64; ++d) { const float w = w_router[d * 32 + e]; sg += ln1g[d] * w; sb += ln1b[d] * w; }
          partL[(p * 32 + e) * 2] = sg; partL[(p * 32 + e) * 2 + 1] = sb; }
        __syncthreads();
        if (tid < 32) { float sg = 0.f, sb = 0.f; for (int p = 0; p < 16; ++p) { sg += partL[(p * 32 + tid) * 2]; sb += partL[(p * 32 + tid) * 2 + 1]; } gws[tid] = sg; bws[tid] = sb + b_router[tid]; }
        __syncthreads();
        const int r32 = lane & 31, hi5 = lane >> 5;
        for (int vw = bx; vw < 256; vw += G) {
            if (tid < 32) histL[tid] = 0;
            __syncthreads();
            const int tok0 = vw * 256 + wave * 32;
            const float* src = OUTP + (size_t)(tok0 + r32) * 1024 + 8 * hi5;
            const LAS unsigned char* ahp = GWH + r32 * GWROW + 16 * hi5; const LAS unsigned char* alp = GWL + r32 * GWROW + 16 * hi5;
            f32x16 acc0 = {}, acc1 = {}, acc2 = {};
            float s1 = 0.f, s2 = 0.f;
            f32x4 xa[4][2], xb[4][2];
#define P5_LOAD(buf, ks0) do { _Pragma("unroll") for (int q_ = 0; q_ < 4; ++q_) { buf[q_][0] = *(const f32x4*)(src + 16 * ((ks0) + q_)); buf[q_][1] = *(const f32x4*)(src + 16 * ((ks0) + q_) + 4); } } while (0)
#define P5_COMP(buf, ks0) do { _Pragma("unroll") for (int q_ = 0; q_ < 4; ++q_) { const f32x4 u0_ = buf[q_][0], u1_ = buf[q_][1]; \
                s1 += (u0_[0] + u0_[1]) + (u0_[2] + u0_[3]) + (u1_[0] + u1_[1]) + (u1_[2] + u1_[3]); \
                s2 += (u0_[0] * u0_[0] + u0_[1] * u0_[1]) + (u0_[2] * u0_[2] + u0_[3] * u0_[3]) + (u1_[0] * u1_[0] + u1_[1] * u1_[1]) + (u1_[2] * u1_[2] + u1_[3] * u1_[3]); \
                u32x4 wh_, wl_; wh_.x = pk2(u0_[0], u0_[1]); wh_.y = pk2(u0_[2], u0_[3]); wh_.z = pk2(u1_[0], u1_[1]); wh_.w = pk2(u1_[2], u1_[3]); \
                wl_.x = pk2(u0_[0] - bflo(wh_.x), u0_[1] - bfhi(wh_.x)); wl_.y = pk2(u0_[2] - bflo(wh_.y), u0_[3] - bfhi(wh_.y)); \
                wl_.z = pk2(u1_[0] - bflo(wh_.z), u1_[1] - bfhi(wh_.z)); wl_.w = pk2(u1_[2] - bflo(wh_.w), u1_[3] - bfhi(wh_.w)); \
                const bf16x8 bh_ = __builtin_bit_cast(bf16x8, wh_), bl_ = __builtin_bit_cast(bf16x8, wl_); \
                const bf16x8 ah_ = *(const LAS bf16x8*)(ahp + 32 * ((ks0) + q_)), al_ = *(const LAS bf16x8*)(alp + 32 * ((ks0) + q_)); \
                acc0 = __builtin_amdgcn_mfma_f32_32x32x16_bf16(ah_, bh_, acc0, 0, 0, 0); acc1 = __builtin_amdgcn_mfma_f32_32x32x16_bf16(ah_, bl_, acc1, 0, 0, 0); \
                acc2 = __builtin_amdgcn_mfma_f32_32x32x16_bf16(al_, bh_, acc2, 0, 0, 0); } } while (0)
            P5_LOAD(xa, 0);
            for (int it = 0; it < 8; ++it) {
                P5_LOAD(xb, 8 * it + 4);
                P5_COMP(xa, 8 * it);
                if (it < 7) P5_LOAD(xa, 8 * it + 8);
                P5_COMP(xb, 8 * it + 4);
            }
#undef P5_LOAD
#undef P5_COMP
            s1 += __shfl_xor(s1, 32); s2 += __shfl_xor(s2, 32);
            const float mean = s1 * (1.f / 1024.f), var = __builtin_fmaxf(s2 * (1.f / 1024.f) - mean * mean, 0.f), rstd = 1.0f / sqrtf(var + LN_EPS);
            float v[16];
#pragma unroll
            for (int i = 0; i < 16; ++i) v[i] = rstd * ((acc0[i] + acc1[i] + acc2[i]) - mean * gws[crow(i, hi5)]) + bws[crow(i, hi5)];
            float cv[8]; int ce[8];
#pragma unroll
            for (int kk = 0; kk < 4; ++kk) {
                float bv = v[0]; int bi = 0;
#pragma unroll
                for (int i = 1; i < 16; ++i) if (v[i] > bv) { bv = v[i]; bi = i; }
                cv[kk] = bv; ce[kk] = crow(bi, hi5);
#pragma unroll
                for (int i = 0; i < 16; ++i) v[i] = (i == bi) ? -INFINITY : v[i];
            }
#pragma unroll
            for (int kk = 0; kk < 4; ++kk) { cv[4 + kk] = __shfl_xor(cv[kk], 32); ce[4 + kk] = __shfl_xor(ce[kk], 32); }
            float tv[4]; int te[4];
#pragma unroll
            for (int kk = 0; kk < 4; ++kk) {
                float bv = cv[0]; int be = ce[0], bi = 0;
#pragma unroll
                for (int i = 1; i < 8; ++i) if (cv[i] > bv || (cv[i] == bv && ce[i] < be)) { bv = cv[i]; be = ce[i]; bi = i; }
                tv[kk] = bv; te[kk] = be;
#pragma unroll
                for (int i = 0; i < 8; ++i) cv[i] = (i == bi) ? -INFINITY : cv[i];
            }
            { const float e1 = __expf(tv[1] - tv[0]), e2 = __expf(tv[2] - tv[0]), e3 = __expf(tv[3] - tv[0]); const float inv = 1.0f / (1.0f + e1 + e2 + e3);
              if (hi5 == 0) { const size_t tk = (size_t)(tok0 + r32) * 4;
                  *(int4*)(TOPE + tk) = make_int4(te[0], te[1], te[2], te[3]); *(f32x4*)(TOPW + tk) = (f32x4){inv, e1 * inv, e2 * inv, e3 * inv};
                  atomicAdd((int*)(histL + te[0]), 1); atomicAdd((int*)(histL + te[1]), 1); atomicAdd((int*)(histL + te[2]), 1); atomicAdd((int*)(histL + te[3]), 1); } }
            f32x4 gg[4], bb[4];
#pragma unroll
            for (int j = 0; j < 4; ++j) { gg[j] = *(const f32x4*)(ln1g + 4 * lane + 256 * j); bb[j] = *(const f32x4*)(ln1b + 4 * lane + 256 * j); }
#pragma unroll 4
            for (int i = 0; i < 32; ++i) {
                const float mi = __uint_as_float(__builtin_amdgcn_readlane(__float_as_uint(mean), i)), ri = __uint_as_float(__builtin_amdgcn_readlane(__float_as_uint(rstd), i));
                const float* pp = OUTP + (size_t)(tok0 + i) * 1024 + 4 * lane; bf16_t* hp = H1 + (size_t)(tok0 + i) * 1024 + 4 * lane;
#pragma unroll
                for (int j = 0; j < 4; ++j) { const f32x4 xv = (*(const f32x4*)(pp + 256 * j) - mi) * ri * gg[j] + bb[j]; u32x2 w; w.x = pk2(xv[0], xv[1]); w.y = pk2(xv[2], xv[3]); *(u32x2*)(hp + 256 * j) = w;
                    *(unsigned*)(H1F8 + (size_t)(tok0 + i) * 1024 + 4 * lane + 256 * j) = pk4_fp8(xv[0], xv[1], xv[2], xv[3]); }
            }
            __syncthreads();
            if (tid < 32) HIST[vw * 32 + tid] = histL[tid];
            __syncthreads();
        }
    } }
#endif
    SEAM(5);

    if (IN(6)) { REP_LOOP(6) { REP_SYNC(); const int tid = opaque_tid(), lane = tid & 63, wave = __builtin_amdgcn_readfirstlane(tid >> 6), gw = bx * 8 + wave; (void)lane; (void)wave; (void)gw;

        LAS int* part = (LAS int*)(lds + SCR_OFF);
        LAS int* cntL = part + 512; LAS int* befL = cntL + 32; LAS int* tstL = befL + 32; LAS int* baseL = tstL + 40; LAS int* curL = baseL + 32;
        for (int vw = bx; vw < 256; vw += G) {
            constexpr int WH = 256 / NHALF, GP = WH / 16;
            const int hf = vw / WH, wl = vw % WH;
            { const int e = tid & 31, p = tid >> 5; int s = 0;
              for (int i = 0; i < GP; ++i) s += HIST[(WH * hf + GP * p + i) * 32 + e];
              part[p * 32 + e] = s; }
            __syncthreads();
            if (tid < 32) { int tot = 0, bef = 0; const int pw = wl / GP, iw = wl % GP;
                for (int p = 0; p < 16; ++p) { const int v = part[p * 32 + tid]; tot += v; if (p < pw) bef += v; }
                for (int i = 0; i < iw; ++i) bef += HIST[(WH * hf + GP * pw + i) * 32 + tid];
                cntL[tid] = tot; befL[tid] = bef; curL[tid] = 0; }
            __syncthreads();
            if (tid == 0) { int run = 0; for (int e = 0; e < 32; ++e) { tstL[e] = run; run += (cntL[e] + 255) >> 8; } tstL[32] = run; }
            __syncthreads();
            if (tid < 32) baseL[tid] = tstL[tid] * 256 + befL[tid];
            __syncthreads();
            int* rt = ROWTOK + (size_t)hf * HROWS; int* rd = ROWDST + (size_t)hf * HROWS;
            for (int idx = tid; idx < 1024; idx += 512) {
                const int tok = vw * 256 + (idx >> 2), kk = idx & 3, e = TOPE[(size_t)tok * 4 + kk];
                const int pos = baseL[e] + atomicAdd((int*)(curL + e), 1);
                rt[pos] = tok; rd[pos] = (tok - hf * HALF_T) * 4 + kk;
            }
            if (wl < 32) { const int e = wl, r0 = tstL[e] * 256 + cntL[e], r1 = tstL[e + 1] * 256;
                for (int r = r0 + tid; r < r1; r += 512) { rt[r] = hf * HALF_T; rd[r] = -1; } }
            if (wl == 32) { int* te = TILEE + hf * 2048; const int nt = tstL[32];
                for (int t = tid; t < nt; t += 512) { int e = 0; for (int q = 1; q < 32; ++q) if (t >= tstL[q]) e = q; te[t] = e; }
                if (tid == 0) te[2040] = nt; }
            __syncthreads();
        }
    }
    }
    SEAM(6);

#pragma unroll
    for (int hf = 0; hf < NHALF; ++hf) {
        const int p_gu = 7 + 2 * hf, p_dn = 8 + 2 * hf, p_cb = 9 + 2 * hf;
        const int* te = TILEE + hf * 2048; const int* rt = ROWTOK + (size_t)hf * HROWS; const int* rd = ROWDST + (size_t)hf * HROWS;
        if (IN(p_gu)) { REP_LOOP(p_gu) { REP_SYNC(); const int tid = opaque_tid();
            const int NT = te[2040];
            LAS int* teL = (LAS int*)(lds + SCR_OFF);
            for (int t = tid; t < NT; t += 512) teL[t] = te[t];
            __syncthreads();
            XCD_STAGGER(STAG7);
            pg8::MoeOrder S; S.init(teL, NT, 8, G, bx);
            EpiSwiglu E{b_gu, Hh};
#ifdef KLOOP_PROBE
            if (tid == 0) MISC[17] = (KLOOP_PROBE == p_gu);
#endif
            CLK_BEGIN(p_gu); pg8::gemm_phase(lds, (const bf16_t*)H1F8, (const bf16_t*)WGU, 512, S, pg8::AGather{rt}, E, pg8::NoHook{});
#ifdef KLOOP_PROBE
            if (tid == 0) MISC[17] = 0;
#endif
        } }
        SEAM(p_gu);
        if (IN(p_dn)) { REP_LOOP(p_dn) { REP_SYNC(); const int tid = opaque_tid();
            const int NT = te[2040];
            LAS int* teL = (LAS int*)(lds + SCR_OFF);
            for (int t = tid; t < NT; t += 512) teL[t] = te[t];
            __syncthreads();
            XCD_STAGGER(STAG8);
            pg8::MoeOrder S; S.init(teL, NT, 4, G, bx);
            EpiDown E{b_dn, rd, Y};
            pg8::gemm_phase(lds, (const bf16_t*)Hh, (const bf16_t*)WDN, 512, S, pg8::ADense{}, E, pg8::NoHook{});
        } }
        SEAM(p_dn);
        if (IN(p_cb)) { REP_LOOP(p_cb + 3) { REP_SYNC();
            f32x4 g2[4], b2[4];
            int lq = threadIdx.x & 63; asm volatile("" : "+v"(lq));
#define lane lq
#pragma unroll
            for (int j = 0; j < 2; ++j) { g2[2 * j] = *(const f32x4*)(ln2g + 8 * lane + 512 * j); g2[2 * j + 1] = *(const f32x4*)(ln2g + 8 * lane + 512 * j + 4);
                b2[2 * j] = *(const f32x4*)(ln2b + 8 * lane + 512 * j); b2[2 * j + 1] = *(const f32x4*)(ln2b + 8 * lane + 512 * j + 4); }
            f32x4 g1a[4], b1a[4];
#pragma unroll
            for (int j = 0; j < 2; ++j) { g1a[2 * j] = *(const f32x4*)(ln1g + 8 * lane + 512 * j) * ALPHA; g1a[2 * j + 1] = *(const f32x4*)(ln1g + 8 * lane + 512 * j + 4) * ALPHA;
                b1a[2 * j] = *(const f32x4*)(ln1b + 8 * lane + 512 * j) * ALPHA; b1a[2 * j + 1] = *(const f32x4*)(ln1b + 8 * lane + 512 * j + 4) * ALPHA; }
            for (int tl = gw; tl < HALF_T; tl += NGW) {
                const int tok = hf * HALF_T + tl;
                const f32x4 wv = *(const f32x4*)(TOPW + (size_t)tok * 4);
                const f32x2 mr = *(const f32x2*)((const float*)(ws + WS_MR) + (size_t)tok * 2);
                f32x4 v[4]; float s = 0.f;
#pragma unroll
                for (int j = 0; j < 2; ++j) {
                    const int c = 8 * lane + 512 * j;
                    const u32x4 hh = *(const u32x4*)(H1 + (size_t)tok * 1024 + c);
                    f32x4 a = ((f32x4){bflo(hh.x), bfhi(hh.x), bflo(hh.y), bfhi(hh.y)} * mr[0] + mr[1]) * g1a[2 * j] + b1a[2 * j], b = ((f32x4){bflo(hh.z), bfhi(hh.z), bflo(hh.w), bfhi(hh.w)} * mr[0] + mr[1]) * g1a[2 * j + 1] + b1a[2 * j + 1];
#pragma unroll
#if Y_FP8
                    for (int kk = 0; kk < 4; ++kk) { const u32x2 yy = *(const u32x2*)((const unsigned char*)Y + ((size_t)tl * 4 + kk) * 1024 + c); const float w = wv[kk];
                        a += fp8x4_f32(yy.x) * w; b += fp8x4_f32(yy.y) * w; }
#else
                    for (int kk = 0; kk < 4; ++kk) { const u32x4 yy = *(const u32x4*)(Y + ((size_t)tl * 4 + kk) * 1024 + c); const float w = wv[kk];
                        a += (f32x4){bflo(yy.x), bfhi(yy.x), bflo(yy.y), bfhi(yy.y)} * w; b += (f32x4){bflo(yy.z), bfhi(yy.z), bflo(yy.w), bfhi(yy.w)} * w; }
#endif
                    v[2 * j] = a; v[2 * j + 1] = b; s += (a[0] + a[1]) + (a[2] + a[3]) + (b[0] + b[1]) + (b[2] + b[3]);
                }
                const float mean = wave_sum(s) * (1.f / 1024.f); float s2 = 0.f;
#pragma unroll
                for (int j = 0; j < 4; ++j) { v[j] = v[j] - mean; s2 += (v[j][0] * v[j][0] + v[j][1] * v[j][1]) + (v[j][2] * v[j][2] + v[j][3] * v[j][3]); }
                const float rstd = 1.0f / sqrtf(wave_sum(s2) * (1.f / 1024.f) + LN_EPS);
                float* op = OUTP + (size_t)tok * 1024 + 8 * lane;
#pragma unroll
                for (int j = 0; j < 2; ++j) { *(f32x4*)(op + 512 * j) = v[2 * j] * rstd * g2[2 * j] + b2[2 * j]; *(f32x4*)(op + 512 * j + 4) = v[2 * j + 1] * rstd * g2[2 * j + 1] + b2[2 * j + 1]; }
            }
#undef lane
        } }
    }
#if defined(KLOOP_PROBE) || defined(EPI_PROBE)
    if (bx == 0 && tid == 0) {
        const unsigned long long tend = __builtin_amdgcn_s_memrealtime() + (unsigned long long)MISC[16] * 16ull / 10ull;
        while (__builtin_amdgcn_s_memrealtime() < tend) __builtin_amdgcn_s_sleep(8);
    }
#endif
#ifdef CLKPROBE
    if (bx == 0 && tid == 0 && cp_r1 > cp_r0) {
        const unsigned long long mhz = (cp_t1 - cp_t0) * 100ull / (cp_r1 - cp_r0);
        const unsigned long long tend = __builtin_amdgcn_s_memrealtime() + mhz * 100ull;
        while (__builtin_amdgcn_s_memrealtime() < tend) __builtin_amdgcn_s_sleep(8);
    }
#endif
#undef IN
#undef SEAM
}

extern "C" void kernel_launch(void* const* d_in, const int* in_sizes, int n_in, void* d_out, int out_size, void* d_ws, size_t ws_size, hipStream_t stream) {
    static int grid = 0;
    if (grid == 0) {
        if (n_in != 16 || in_sizes[0] != T * D || out_size != T * D || ws_size < WS_END) { fprintf(stderr, "kernel_launch: unexpected shapes / workspace (%d inputs, ws %zu)\n", n_in, ws_size); grid = -1; return; }
        int dev = 0, cus = 0, per_cu = 0;
        if (hipGetDevice(&dev) != hipSuccess || hipDeviceGetAttribute(&cus, hipDeviceAttributeMultiprocessorCount, dev) != hipSuccess) { grid = -1; return; }
        if (hipFuncSetAttribute((const void*)mk_fwd, hipFuncAttributeMaxDynamicSharedMemorySize, LDS_BYTES) != hipSuccess) { fprintf(stderr, "kernel_launch: hipFuncSetAttribute failed\n"); grid = -1; return; }
        if (hipOccupancyMaxActiveBlocksPerMultiprocessor(&per_cu, (const void*)mk_fwd, 512, LDS_BYTES) != hipSuccess || per_cu < 1) { fprintf(stderr, "kernel_launch: occupancy query says %d\n", per_cu); }
        (void)hipGetLastError();
        grid = cus;
    }
    if (grid < 0) return;
    if (hipMemsetAsync((char*)d_ws + WS_CTL, 0, CTL_ZERO_BYTES, stream) != hipSuccess) return;
    Args a{};
    for (int i = 0; i < 16; ++i) a.in[i] = (const float*)d_in[i];
    a.out = (float*)d_out; a.ws = (unsigned char*)d_ws;
#if MK_ONE_LAUNCH && defined(PROBE_SPLIT)
    a.ph_lo = 0; a.ph_hi = PROBE_SPLIT + 1; a.li = 0;
#ifdef PROBE_VAR
    a.var = PROBE_VAR;
#endif
    hipLaunchKernelGGL(mk_fwd, dim3(grid), dim3(512), LDS_BYTES, stream, a);
    a.ph_lo = PROBE_SPLIT; a.ph_hi = NPHASE; a.li = 1; a.var = 0;
    hipLaunchKernelGGL(mk_fwd, dim3(grid), dim3(512), LDS_BYTES, stream, a);
#elif MK_ONE_LAUNCH
    a.ph_lo = 0; a.ph_hi = NPHASE;
    hipLaunchKernelGGL(mk_fwd, dim3(grid), dim3(512), LDS_BYTES, stream, a);
#else
    for (int p = 0; p < NPHASE; ++p) { a.ph_lo = p; a.ph_hi = p + 1; hipLaunchKernelGGL(mk_fwd, dim3(grid), dim3(512), LDS_BYTES, stream, a); }
#endif
}
```

```cpp
#include <hip/hip_runtime.h>
#include <cstdio>
#include <cstdint>

#ifndef MK_ONE_LAUNCH
#define MK_ONE_LAUNCH 1
#endif
#ifndef P5_SINGLE
#define OG_FP8 1
#define PRE16 1
#define P5_SINGLE 1
#endif
#ifndef QKV_FP8
#define QKV_FP8 1
#endif
#ifndef P3_FP8
#define P3_FP8 1
#endif
#ifndef G_FP8
#define G_FP8 1
#endif
#ifndef Y_FP8
#define Y_FP8 1
#endif
#ifndef P4_FP8
#define P4_FP8 1
#endif
#ifndef P1_FP8
#define P1_FP8 1
#endif

#define LAS __attribute__((address_space(3)))
#define GAS __attribute__((address_space(1)))
typedef unsigned short bf16_t;
typedef short bf16x8 __attribute__((ext_vector_type(8)));
typedef short s16x4 __attribute__((ext_vector_type(4)));
typedef float f32x4 __attribute__((ext_vector_type(4)));
typedef float f32x2 __attribute__((ext_vector_type(2)));
typedef float f32x16 __attribute__((ext_vector_type(16)));
typedef unsigned u32x4 __attribute__((ext_vector_type(4)));
typedef unsigned u32x2 __attribute__((ext_vector_type(2)));
typedef __bf16 bf16x2_t __attribute__((ext_vector_type(2)));
typedef int v4i32_t __attribute__((ext_vector_type(4)));
typedef int v8i32_t __attribute__((ext_vector_type(8)));

constexpr int SEQ = 2048, NB = 32, T = NB * SEQ, D = 1024, INW = 5888, NE = 32, TOPK = 4;
constexpr float LN_EPS = 1e-5f;
constexpr float ALPHA = 1.189207115002721f;
constexpr float LOG2E = 1.4426950408889634f;
constexpr float QSCALE = 0.125f * LOG2E;
constexpr float W8_SCALE = 32.0f, W8_INV = 1.0f / 32.0f, MG_SCALE = 16.0f, MG_INV = 1.0f / 16.0f, OA_SCALE = 16.0f, OA_INV = 1.0f / 16.0f;
constexpr float ROPE_TAB_SCALE = (P1_FP8 && QKV_FP8) ? W8_INV : 1.0f;
#ifndef NHALF
#define NHALF 1
#endif
constexpr int HALF_T = T / NHALF;
constexpr int HROWS = HALF_T * TOPK + NE * 256;
constexpr int HTILES = HROWS / 256;

constexpr size_t MiB = 1u << 20;
constexpr size_t WS_CTL = 0, CTL_ZERO_BYTES = 64 * 1024;
constexpr size_t WS_COS = 1 * MiB;
constexpr size_t WS_WIN = 2 * MiB;
constexpr size_t WS_WAB = 14 * MiB;
constexpr size_t WS_WOUT = 17 * MiB;
constexpr size_t WS_TOPE = 19 * MiB, WS_TOPW = 20 * MiB, WS_HIST = 21 * MiB;
constexpr size_t WS_ROWTOK = 22 * MiB, WS_ROWDST = 24 * MiB, WS_TILEE = 26 * MiB;
constexpr size_t WS_WGU = 32 * MiB;
constexpr size_t WS_WDN = 96 * MiB;
constexpr size_t WS_H1F8 = 352 * MiB;
constexpr size_t WS_OAB = 224 * MiB;
constexpr size_t WS_XB = 224 * MiB;
constexpr size_t WS_H1 = 224 * MiB;
constexpr size_t WS_G = 384 * MiB;
constexpr size_t WS_KB = 640 * MiB;
constexpr size_t WS_VAT = 736 * MiB;
constexpr size_t WS_VBT = 768 * MiB;
constexpr size_t WS_OG = 864 * MiB;
constexpr size_t WS_STATS = 964 * MiB;
constexpr size_t WS_LSE = 960 * MiB;
constexpr size_t WS_MERGED = 640 * MiB;
constexpr size_t WS_H = 416 * MiB;
constexpr size_t WS_Y = 680 * MiB;
constexpr size_t WS_MR = 973 * MiB;
constexpr size_t WS_END = 1024 * MiB;
static_assert(WS_H1F8 + (size_t)T * 1024 <= WS_H && WS_H + (size_t)HROWS * 1024 <= WS_Y && WS_Y + ((size_t)HALF_T * 4 + 1) * 1024 * 2 <= WS_END + (size_t)HALF_T * 4 * 1024, "ws map");
static_assert(WS_Y + ((size_t)HALF_T * 4 + 1) * 1024 <= WS_END && (size_t)NHALF * HROWS * 4 <= 2 * MiB && HTILES * 4 + 256 <= 8192, "ws / LDS tables");
static_assert(WS_LSE + (size_t)T * 12 * 4 <= WS_END && WS_OG + (size_t)T * 768 * 2 <= WS_LSE && WS_VBT + (size_t)T * 768 * 2 <= WS_OG, "ws map");
constexpr size_t DO_QA = 0, DO_QB = 128 * MiB, DO_KA = 224 * MiB;

constexpr int CW_TMO = 0, CW_CODE = 1, CW_BAR = 4096;

constexpr int RING_BYTES = 131072;
constexpr int LDSCTL_OFF = 135168, MISC_OFF = LDSCTL_OFF + 320, SCR_OFF = LDSCTL_OFF + 1024;
constexpr int LDS_BYTES = 151552;

#define RLX_AGENT __ATOMIC_RELAXED, __HIP_MEMORY_SCOPE_AGENT
#define LDS_WAIT() asm volatile("s_waitcnt lgkmcnt(0)" ::: "memory")
#define VM_WAIT() asm volatile("s_waitcnt vmcnt(0)" ::: "memory")
__device__ __forceinline__ unsigned pk2(float lo, float hi) { f32x2 v = {lo, hi}; bf16x2_t b = __builtin_convertvector(v, bf16x2_t); return __builtin_bit_cast(unsigned, b); }
__device__ __forceinline__ unsigned pk4_fp8(float a, float b, float c, float d) { int w = __builtin_amdgcn_cvt_pk_fp8_f32(a, b, 0, false); w = __builtin_amdgcn_cvt_pk_fp8_f32(c, d, w, true); return (unsigned)w; }
__device__ __forceinline__ f32x4 fp8x4_f32(unsigned w) { const f32x2 lo = __builtin_amdgcn_cvt_pk_f32_fp8((int)w, false), hi = __builtin_amdgcn_cvt_pk_f32_fp8((int)w, true); return (f32x4){lo[0], lo[1], hi[0], hi[1]}; }
__device__ __forceinline__ float bflo(unsigned w) { return __uint_as_float(w << 16); }
__device__ __forceinline__ float bfhi(unsigned w) { return __uint_as_float(w & 0xffff0000u); }
__device__ __forceinline__ float fast_sigmoid(float z) { return __builtin_amdgcn_rcpf(1.0f + __builtin_amdgcn_exp2f(-z * LOG2E)); }
__device__ __forceinline__ float sigmoid_sc(float z, float sc) { return __builtin_amdgcn_rcpf(1.0f + __builtin_amdgcn_exp2f(z * (-sc * LOG2E))); }
__device__ __forceinline__ float wave_sum(float v) {
#pragma unroll
    for (int o = 1; o < 64; o <<= 1) v += __shfl_xor(v, o);
    return v;
}

#define XB_TMO      128
#define XB_XCNT(j)  (256  + 64 * (j))
#define XB_XSUB(j)  (1280 + 64 * (j))
#define XB_XGEN(j)  (2304 + 64 * (j))
#define XB_TOP      3328
#define XB_TOPGEN   3392
#define XCD_BAR_WORDS 3456
#define XB_SPIN_CAP (1u << 18)
__device__ __forceinline__ unsigned xb_ld(unsigned* p)              { return __hip_atomic_load(p, __ATOMIC_RELAXED, __HIP_MEMORY_SCOPE_AGENT); }
__device__ __forceinline__ unsigned xb_add(unsigned* p, unsigned v) { return __hip_atomic_fetch_add(p, v, __ATOMIC_RELAXED, __HIP_MEMORY_SCOPE_AGENT); }
__device__ __forceinline__ unsigned xb_xcc_id() { return (unsigned)__builtin_amdgcn_s_getreg((3 << 11) | 20) & 0xFu; }
#define XB_SPIN(cond, bar) do { unsigned _sp = 0; while (cond) { __builtin_amdgcn_s_sleep(1); \
    if ((++_sp & 255u) == 0u) { if (xb_ld(&(bar)[XB_TMO])) break; if (_sp > XB_SPIN_CAP) { atomicAdd(&(bar)[XB_TMO], 1u); break; } } } } while (0)
struct XcdBarrier { unsigned* bar; unsigned x; volatile LAS unsigned* st; };
__device__ __forceinline__ XcdBarrier xcd_barrier_post(unsigned* bar, volatile LAS unsigned* st) {
    XcdBarrier b; b.bar = bar; b.x = xb_xcc_id(); b.st = st;
    if (threadIdx.x == 0) (void)xb_add(&bar[XB_XCNT(b.x)], 1u);
    return b;
}
__device__ __forceinline__ void xcd_barrier_complete(unsigned* bar, unsigned x, unsigned& nloc, unsigned& nx) {
    const unsigned G = gridDim.x * gridDim.y * gridDim.z;
    unsigned sum, cnt, mine, sp = 0u;
    for (;;) {
        sum = 0u; cnt = 0u; mine = 0u;
#pragma unroll
        for (unsigned j = 0; j < 16; ++j) { const unsigned c = xb_ld(&bar[XB_XCNT(j)]); sum += c; cnt += (c > 0u) ? 1u : 0u; mine = (j == x) ? c : mine; }
        if (sum == G) break;
        __builtin_amdgcn_s_sleep(1);
        if ((++sp & 255u) == 0u) { if (xb_ld(&bar[XB_TMO])) break; if (sp > XB_SPIN_CAP) { atomicAdd(&bar[XB_TMO], 1u); break; } }
    }
    nloc = mine > 0u ? mine : 1u; nx = cnt > 0u ? cnt : 1u;
}
__device__ __forceinline__ void xcd_barrier(const XcdBarrier& b) {
    asm volatile("s_waitcnt vmcnt(0)" ::: "memory");
    __syncthreads();
    if (threadIdx.x == 0) {
        unsigned* bar = b.bar;
        __builtin_amdgcn_s_waitcnt(0);
        unsigned nloc = b.st[0], nx = b.st[1];
        if (nloc == 0u) { xcd_barrier_complete(bar, b.x, nloc, nx); b.st[0] = nloc; b.st[1] = nx; }
        const unsigned old = xb_add(&bar[XB_XSUB(b.x)], 1u);
        const unsigned gen = old / nloc;
        if (old + 1u == (gen + 1u) * nloc) {
            __builtin_amdgcn_fence(__ATOMIC_RELEASE, "agent");
            asm volatile("s_waitcnt vmcnt(0)" ::: "memory");
            const unsigned og = xb_add(&bar[XB_TOP], 1u);
            const unsigned tg = og / nx;
            if (og + 1u == (tg + 1u) * nx) xb_add(&bar[XB_TOPGEN], 1u);
            else XB_SPIN(xb_ld(&bar[XB_TOPGEN]) == tg, bar);
            __builtin_amdgcn_fence(__ATOMIC_ACQUIRE, "agent");
            xb_add(&bar[XB_XGEN(b.x)], 1u);
            asm volatile("s_waitcnt vmcnt(0)" ::: "memory");
        } else {
            XB_SPIN(xb_ld(&bar[XB_XGEN(b.x)]) == gen, bar);
            __builtin_amdgcn_fence(__ATOMIC_ACQUIRE, "agent");
            asm volatile("s_waitcnt vmcnt(0)" ::: "memory");
        }
    }
    __syncthreads();
}

namespace pg8 {
constexpr int BM = 256, BK = 64, HALF = 128, HTB = HALF * BK * 2, STAGE_BYTES = 8 * HTB, NXCD = 8;
__host__ __device__ __forceinline__ int lds_byte(int r, int c) { const int st = (r >> 4) * 2 + (c >> 5), rr = r & 15, cc = c & 31, ob = rr * 64 + cc * 2; return st * 1024 + (ob ^ (((ob >> 9) & 1) << 5)); }
__host__ __device__ __forceinline__ void stage_rc(int b, int& R, int& C) { const int st = b / 1024, sb = b % 1024, swz = sb ^ (((sb >> 9) & 1) << 5); R = (st >> 1) * 16 + swz / 64; C = (st & 1) * 32 + (swz % 64) / 2; }
__host__ __device__ __forceinline__ int perm32(int rho) { const int n = rho >> 4, i = rho & 15; return 8 * (i >> 2) + 4 * n + (i & 3); }

struct Unit { int pm, pn; };

template <int NN, int WGM_>
struct StaticOrderT {
    int nM, nwg, G, c;
    __device__ void init(int M, int  , int G_, int c_, int = WGM_) { nM = M / BM; nwg = nM * NN; G = G_; c = c_; }
    __device__ bool next(int i, Unit& u) const {
        const long L = (long)i * G + c; if (L >= nwg) return false;
        int wgid = (int)L; { const int q = nwg / NXCD, r = nwg % NXCD, xcd = wgid % NXCD, off = wgid / NXCD; wgid = (xcd < r ? xcd * (q + 1) : r * (q + 1) + (xcd - r) * q) + off; }
        constexpr int nig = WGM_ * NN; const int gid = wgid / nig, fm = gid * WGM_, rem = wgid - gid * nig, gsz = (nM - fm) < WGM_ ? (nM - fm) : WGM_;
        if (gsz == WGM_) { u.pm = fm + rem % WGM_; u.pn = rem / WGM_; } else { u.pm = fm + rem % gsz; u.pn = rem / gsz; }
        return true;
    }
    static constexpr bool PUBLISH = false;
};
template <int NJ>
struct MoeOrderT {
    const LAS int* tile_e; int W, r, t0, t1;
    __device__ void init(const LAS int* te, int NT, int  , int G, int c) {
        tile_e = te;
        if (G % 8 == 0) { const int x = c % 8; r = c / 8; W = G / 8; t0 = (int)((long)NT * x / 8); t1 = (int)((long)NT * (x + 1) / 8); }
        else { r = c; W = G; t0 = 0; t1 = NT; }
    }
    __device__ bool next(int i, Unit& u) const {
        const int idx = i * W + r, ntl = t1 - t0; if (idx >= ntl * NJ) return false;
        constexpr int GT = 32 / NJ, per = GT * NJ; const int grp = idx / per, rem = idx - grp * per, gsz = (ntl - grp * GT) < GT ? (ntl - grp * GT) : GT;
        int tile, j; if (gsz == GT) { tile = t0 + grp * GT + rem % GT; j = rem / GT; } else { tile = t0 + grp * GT + rem % gsz; j = rem / gsz; }
        u.pm = tile; u.pn = tile_e[tile] * NJ + j; return true;
    }
};
constexpr int TOKL_OFF = 135168 + 1024 + 8192;
struct ADense {
    __device__ __forceinline__ void prefetch(const Unit&, LAS unsigned char*, int, int, int) const {}
    __device__ __forceinline__ void rows(const Unit& u, LAS unsigned char*, int, const int (&R)[2], unsigned (&vr)[2][2]) const {
#pragma unroll
        for (int h = 0; h < 2; ++h)
#pragma unroll
            for (int i = 0; i < 2; ++i) vr[h][i] = (unsigned)(u.pm * BM + h * HALF + R[i]);
    }
};
struct AGather {
    const int* tok;
    __device__ __forceinline__ void prefetch(const Unit& u, LAS unsigned char* ldsb, int par, int wid, int lane) const {
        if (wid < 4) __builtin_amdgcn_global_load_lds((const unsigned*)(tok + u.pm * BM + wid * 64 + lane), (LAS unsigned*)(ldsb + TOKL_OFF + par * 1024 + wid * 256), 4, 0, 0);
    }
    __device__ __forceinline__ void rows(const Unit&, LAS unsigned char* ldsb, int par, const int (&R)[2], unsigned (&vr)[2][2]) const {
        const LAS unsigned* t = (const LAS unsigned*)(ldsb + TOKL_OFF + par * 1024);
#pragma unroll
        for (int h = 0; h < 2; ++h)
#pragma unroll
            for (int i = 0; i < 2; ++i) vr[h][i] = t[h * HALF + R[i]];
    }
};
struct NoHook { static constexpr int T = -1; __device__ __forceinline__ void operator()(f32x4 (&)[2][2][4][2], const Unit&, int, int, int, int) const {} };

template <class Epi, class Sched, class AMap, class Hook>
__device__ __forceinline__ void gemm_phase(LAS unsigned char* lds, const bf16_t* A, const bf16_t* Bt, const int K, const Sched& S, const AMap& AM, const Epi& E, const Hook& HK) {
    int tid = threadIdx.x; asm volatile("" : "+v"(tid));
    const int wid = __builtin_amdgcn_readfirstlane(tid >> 6), lane = tid & 63, wr = wid >> 2, wc = wid & 3, fr = lane & 15, fq = lane >> 4;
    const int nt = K / BK;
    int Rr[2], Cc[2]; unsigned voffB[2];
#pragma unroll
    for (int i = 0; i < 2; ++i) { stage_rc(tid * 16 + i * 8192, Rr[i], Cc[i]); const int rho = Epi::PERM ? perm32(Rr[i] & 31) : (Rr[i] & 31);
        const int Rb = (Epi::COLMAP == 2) ? 64 * (Rr[i] >> 5) + rho : (Rr[i] & ~31) + rho; voffB[i] = (unsigned)(Rb * K + Cc[i]) * 2u; }
    const size_t bhalf = (Epi::COLMAP == 2) ? (size_t)32 * K * 2 : (size_t)HALF * K * 2;
    const size_t kstep = (size_t)(BK * 2);
    const size_t hstep = (size_t)HALF * K * 2;
    const size_t tstep = 2 * hstep;
    const unsigned ldsw = (unsigned)wid * 1024u;
    constexpr bool F8 = Epi::FP8; constexpr int KSTR = F8 ? 16 : 1024;
    const int fcol = F8 ? 32 * (fq >> 1) + 16 * (fq & 1) : fq * 8;
    const int aoff = lds_byte(wr * 64 + fr, fcol), boff = lds_byte(wc * 32 + fr, fcol);
#define PG8_SA(b, h) (((b) * 2 + (h)) * HTB)
#define PG8_SB(b, h) ((4 + (b) * 2 + (h)) * HTB)
#define PG8_STAGE(bufoff, gbase, voff) do { _Pragma("unroll") for (int _i = 0; _i < 2; ++_i) \
        __builtin_amdgcn_global_load_lds((const unsigned*)((const char*)(gbase) + (voff)[_i]), (LAS unsigned*)(lds + (bufoff) + ldsw + _i * 8192), 16, 0, 0); } while (0)
#define PG8_LD2(base_) __builtin_shufflevector(*(const LAS v4i32_t*)(base_), *(const LAS v4i32_t*)((base_) + KSTR), 0, 1, 2, 3, 4, 5, 6, 7)
#define PG8_LDA(dst, b, h) do { _Pragma("unroll") for (int m = 0; m < 4; ++m) dst[m] = PG8_LD2(lds + PG8_SA(b, h) + aoff + m * 2048); } while (0)
#define PG8_LDB(dst, b, h) do { _Pragma("unroll") for (int n = 0; n < 2; ++n) dst[n] = PG8_LD2(lds + PG8_SB(b, h) + boff + n * 2048); } while (0)
#define PG8_HALF(x, k) __builtin_bit_cast(bf16x8, __builtin_shufflevector(x, x, 4 * (k), 4 * (k) + 1, 4 * (k) + 2, 4 * (k) + 3))
#define PG8_MMA(ai, bj, At, Bt_) do { __builtin_amdgcn_s_setprio(1); _Pragma("unroll") for (int m = 0; m < 4; ++m) _Pragma("unroll") for (int n = 0; n < 2; ++n) { \
        if constexpr (F8) acc[ai][bj][m][n] = __builtin_amdgcn_mfma_scale_f32_16x16x128_f8f6f4(Bt_[n], At[m], acc[ai][bj][m][n], 0, 0, 0, 0, 0, 0);     \
        else { acc[ai][bj][m][n] = __builtin_amdgcn_mfma_f32_16x16x32_bf16(PG8_HALF(Bt_[n], 0), PG8_HALF(At[m], 0), acc[ai][bj][m][n], 0, 0, 0); \
               acc[ai][bj][m][n] = __builtin_amdgcn_mfma_f32_16x16x32_bf16(PG8_HALF(Bt_[n], 1), PG8_HALF(At[m], 1), acc[ai][bj][m][n], 0, 0, 0); } } \
        __builtin_amdgcn_s_setprio(0); } while (0)
#define PG8_WAIT_V(n) asm volatile("s_waitcnt vmcnt(" #n ")" ::: "memory")
#define PG8_WAIT_L(n) asm volatile("s_waitcnt lgkmcnt(" #n ")" ::: "memory")
#define PG8_BAR __builtin_amdgcn_s_barrier()
#define PG8_SCHED __builtin_amdgcn_sched_barrier(0)
    Unit cur, nxt, nn; int ui = 0;
    if (!S.next(0, cur)) return;
    bool has_next = S.next(1, nxt);
    f32x4 acc[2][2][4][2];
#pragma unroll
    for (int a = 0; a < 2; ++a)
#pragma unroll
        for (int b = 0; b < 2; ++b)
#pragma unroll
            for (int m = 0; m < 4; ++m)
#pragma unroll
                for (int n = 0; n < 2; ++n) acc[a][b][m][n] = (f32x4){0.f, 0.f, 0.f, 0.f};
    v8i32_t At[4], B0[2], B1[2];
    unsigned vC[2][2];
    AM.prefetch(cur, lds, 0, wid, lane);
    if (has_next) AM.prefetch(nxt, lds, 1, wid, lane);
    asm volatile("s_waitcnt vmcnt(0)" ::: "memory"); __builtin_amdgcn_s_barrier(); asm volatile("" ::: "memory");
    AM.rows(cur, lds, 0, Rr, vC);
#pragma unroll
    for (int h = 0; h < 2; ++h)
#pragma unroll
        for (int i = 0; i < 2; ++i) vC[h][i] = (vC[h][i] * (unsigned)K + (unsigned)Cc[i]) * 2u;
    const char* const Ab = (const char*)A;
    const char* cB = (const char*)Bt + (size_t)cur.pn * tstep;
    PG8_STAGE(PG8_SB(0, 0), cB, voffB); PG8_STAGE(PG8_SB(0, 1), cB + bhalf, voffB); PG8_STAGE(PG8_SA(0, 0), Ab, vC[0]); PG8_STAGE(PG8_SA(0, 1), Ab, vC[1]);
    if (wr == 1) PG8_BAR;
    PG8_WAIT_V(2); PG8_BAR;
    PG8_STAGE(PG8_SB(1, 0), cB + kstep, voffB); PG8_STAGE(PG8_SA(1, 0), Ab + kstep, vC[0]); PG8_STAGE(PG8_SB(1, 1), cB + bhalf + kstep, voffB);
    PG8_WAIT_V(0); PG8_BAR;
    for (;;) {
        const bool has_nn = has_next ? S.next(ui + 2, nn) : false;
        if (has_nn) AM.prefetch(nn, lds, ui & 1, wid, lane);
        const char* nB = has_next ? (const char*)Bt + (size_t)nxt.pn * tstep : cB;
#ifdef KLOOP_PROBE
        const unsigned long long kp_t0 = __builtin_amdgcn_s_memtime();
#endif
#define PG8_TRIP(WV) do {   \
            const bool last = (t == nt - 2); \
            if (Hook::T >= 0) { if (t == Hook::T) HK(acc, cur, wr, wc, fr, fq); } \
            const char* a1 = Ab + (size_t)(t + 1) * kstep; \
            const char* a2 = last ? Ab : Ab + (size_t)(t + 2) * kstep; const char* b2 = last ? nB : cB + (size_t)(t + 2) * kstep; \
            const char* a3 = a2 + kstep; const char* b3 = b2 + kstep; \
              \
            PG8_LDB(B0, 0, 0); PG8_LDB(B1, 0, 1); PG8_SCHED; PG8_LDA(At, 0, 0); PG8_STAGE(PG8_SA(1, 1), a1, vC[1]); \
            if (last && has_next) {                         \
                int tq = tid; asm volatile("" : "+v"(tq));           \
                int R2[2], C2[2]; _Pragma("unroll") for (int i = 0; i < 2; ++i) stage_rc(tq * 16 + i * 8192, R2[i], C2[i]); \
                AM.rows(nxt, lds, (ui + 1) & 1, R2, vC); \
                _Pragma("unroll") for (int h = 0; h < 2; ++h) _Pragma("unroll") for (int i = 0; i < 2; ++i) vC[h][i] = (vC[h][i] * (unsigned)K + (unsigned)C2[i]) * 2u; \
            } \
            if (nowait == 0) PG8_WAIT_V(8); \
            PG8_WAIT_L(0); PG8_BAR; PG8_MMA(0, 0, At, B0); PG8_MMA(0, 1, At, B1); PG8_BAR; PG8_SCHED; \
              \
            PG8_LDA(At, 0, 1); PG8_STAGE(PG8_SB(0, 0), b2, voffB); PG8_STAGE(PG8_SB(0, 1), b2 + bhalf, voffB); PG8_STAGE(PG8_SA(0, 0), a2, vC[0]); \
            if (nowait == 0) PG8_WAIT_V(8); \
            asm volatile("s_mov_b32 %0, 0" : "=s"(nowait)); \
            PG8_WAIT_L(0); PG8_BAR; PG8_MMA(1, 0, At, B0); PG8_MMA(1, 1, At, B1); PG8_BAR; PG8_SCHED; \
              \
            PG8_LDB(B0, 1, 0); PG8_LDB(B1, 1, 1); PG8_SCHED; PG8_LDA(At, 1, 0); PG8_STAGE(PG8_SA(0, 1), a2, vC[1]); \
            PG8_WAIT_V(8); PG8_WAIT_L(0); PG8_BAR; PG8_MMA(0, 0, At, B0); PG8_MMA(0, 1, At, B1); PG8_BAR; PG8_SCHED; \
              \
            PG8_LDA(At, 1, 1); PG8_STAGE(PG8_SB(1, 0), b3, voffB); PG8_STAGE(PG8_SB(1, 1), b3 + bhalf, voffB); PG8_STAGE(PG8_SA(1, 0), a3, vC[0]); \
            PG8_WAIT_V(8); PG8_WAIT_L(0); PG8_BAR; PG8_MMA(1, 0, At, B0); PG8_MMA(1, 1, At, B1); PG8_BAR; PG8_SCHED; \
        } while (0)
        int nowait; asm volatile("s_mov_b32 %0, 1" : "=s"(nowait));
#pragma unroll 1
        for (int t = 0; t < nt; t += 2) { PG8_TRIP(8); }
#undef PG8_TRIP
#ifdef KLOOP_PROBE
        if (blockIdx.x == 0 && tid == 0) { volatile LAS unsigned* kp = (volatile LAS unsigned*)(lds + 135168 + 320 + 64); if (kp[1]) kp[0] += (unsigned)((__builtin_amdgcn_s_memtime() - kp_t0) >> 4); }
#endif
        if (wr == 0) PG8_BAR;
        PG8_WAIT_V(0);
#ifdef EPI_PROBE
        const unsigned long long ep_t0 = __builtin_amdgcn_s_memtime();
#endif
        E(acc, cur, wr, wc, fr, fq);
#ifdef EPI_PROBE
        if (blockIdx.x == 0 && tid == 0) { volatile LAS unsigned* kp = (volatile LAS unsigned*)(lds + 135168 + 320 + 64); if (kp[1]) kp[0] += (unsigned)((__builtin_amdgcn_s_memtime() - ep_t0) >> 4); }
#endif
        if (!has_next) break;
#pragma unroll
        for (int a = 0; a < 2; ++a)
#pragma unroll
            for (int b = 0; b < 2; ++b)
#pragma unroll
                for (int m = 0; m < 4; ++m)
#pragma unroll
                    for (int n = 0; n < 2; ++n) acc[a][b][m][n] = (f32x4){0.f, 0.f, 0.f, 0.f};
        cur = nxt; nxt = nn; has_next = has_nn; cB = nB; ++ui;
        if (wr == 1) PG8_BAR;
    }
    PG8_WAIT_V(0);
    PG8_BAR;
#undef PG8_SA
#undef PG8_SB
#undef PG8_STAGE
#undef PG8_LDA
#undef PG8_LDB
#undef PG8_MMA
#undef PG8_HALF
#undef PG8_LD2
#undef PG8_WAIT_V
#undef PG8_WAIT_L
#undef PG8_BAR
#undef PG8_SCHED
}
}
using pg8::Unit;

#if G_FP8
typedef u32x2 gate8_t;
constexpr int GATE_B = 1;
__device__ __forceinline__ void gate_unpack(const gate8_t g, f32x4& lo, f32x4& hi) { lo = fp8x4_f32(g.x); hi = fp8x4_f32(g.y); }
#else
typedef u32x4 gate8_t;
constexpr int GATE_B = 2;
__device__ __forceinline__ void gate_unpack(const gate8_t g, f32x4& lo, f32x4& hi) { lo = (f32x4){bflo(g.x), bfhi(g.x), bflo(g.y), bfhi(g.y)}; hi = (f32x4){bflo(g.z), bfhi(g.z), bflo(g.w), bfhi(g.w)}; }
#endif
#define GATE_LD(G_, row_, col_) (*(const gate8_t*)((const unsigned char*)(G_) + ((size_t)(row_) * 2048 + (col_)) * GATE_B))
#if G_FP8
__device__ __forceinline__ int gate_pair_ofs(int fq) { return (fq & 1) ? 24 + 8 * fq : 8 * fq; }
#define GFRAG_OFS(row16_, span_, fq_, fr_) ((((size_t)(row16_) * 32 + (span_)) * 1024) + (size_t)(gate_pair_ofs(fq_) >> 4) * 256 + (size_t)(fr_) * 16)
__device__ __forceinline__ void gate_ld_pair(const unsigned char* p, u32x4& L) { L = *(const u32x4*)p; }
__device__ __forceinline__ void gate_unswap(const u32x4 L, gate8_t& g0, gate8_t& g1) {
    const auto sx = __builtin_amdgcn_permlane16_swap(L.x, L.z, false, false), sy = __builtin_amdgcn_permlane16_swap(L.y, L.w, false, false);
    g0.x = sx[0]; g0.y = sy[0]; g1.x = sx[1]; g1.y = sy[1];
}
#endif
__device__ __forceinline__ unsigned dpp_ror8(unsigned v) { return (unsigned)__builtin_amdgcn_update_dpp(0, (int)v, 0x128, 0xf, 0xf, true); }
__device__ __forceinline__ u32x4 dpp_ror8(u32x4 v) { u32x4 r; r.x = dpp_ror8(v.x); r.y = dpp_ror8(v.y); r.z = dpp_ror8(v.z); r.w = dpp_ror8(v.w); return r; }
__device__ __forceinline__ void xchg_rows(const u32x4 v0, const u32x4 v1, int fr, u32x4& w_lo, u32x4& w_hi) {
    const bool up = fr >= 8; const u32x4 snd = up ? v0 : v1, rcv = dpp_ror8(snd);
    w_lo = up ? rcv : v0; w_hi = up ? v1 : rcv;
}
__device__ __forceinline__ int pair16_ofs(int fq) { return (fq & 1) ? 24 + 8 * fq : 8 * fq; }
__device__ __forceinline__ void store_pair16(unsigned char* p, const u32x2 a8, const u32x2 b8) {
    const auto sx = __builtin_amdgcn_permlane16_swap(a8.x, b8.x, false, false), sy = __builtin_amdgcn_permlane16_swap(a8.y, b8.y, false, false);
    u32x4 w; w.x = sx[0]; w.y = sy[0]; w.z = sx[1]; w.w = sy[1]; *(u32x4*)p = w;
}
struct EpiInProj {
    static constexpr bool PERM = true, FP8 = (P1_FP8 != 0); static constexpr int COLMAP = 2, NSTORES = 16;
    bf16_t *QA, *KA, *VA, *QB, *KB, *VB, *G; const unsigned* csT; int var;
    __device__ __forceinline__ void operator()(const f32x4 (&acc)[2][2][4][2], const Unit& u, int wr, int wc, int fr, int fq) const {
        const int pn = u.pn, rb0 = (var == 3 ? (u.pm & 3) : u.pm) * 256 + wr * 64;
        asm volatile("" : "+v"(fq), "+v"(fr));
        const int chunk = fq + 4 * (fr >> 3), rl = fr & 7;
        constexpr float WS_ = FP8 ? W8_INV : 1.0f;
        bf16_t* base; int ld, colt; float sc = WS_; int kind;
        constexpr float QS_ = QKV_FP8 ? 1.0f : QSCALE;
        if (pn < 4) { base = QA; ld = 1024; colt = pn * 256; sc = QS_ * WS_; kind = 0; }
        else if (pn == 4) { base = KA; ld = 256; colt = 0; kind = 0; }
        else if (pn == 5) { base = VA; ld = 256; colt = 0; kind = 1; }
        else if (pn < 9) { base = QB; ld = 768; colt = (pn - 6) * 256; sc = QS_ * WS_; kind = 0; }
        else if (pn < 12) { base = KB; ld = 768; colt = (pn - 9) * 256; kind = 0; }
        else if (pn < 15) { base = VB; ld = 768; colt = (pn - 12) * 256; kind = 1; }
        else { base = G; ld = 2048; colt = (pn - 15) * 256; kind = 2; }
        bf16_t* seg = base + colt + 64 * wc + 8 * chunk;
        if (kind == 0) {
            u32x4 cs[2][4][2];
#pragma unroll
            for (int ai = 0; ai < 2; ++ai)
#pragma unroll
                for (int m = 0; m < 4; ++m) { const int pos = (rb0 + ai * 128 + m * 16 + fr) & (SEQ - 1); const unsigned* tp = csT + (((pos >> 4) * 4 + fq) * 16 + (pos & 15)) * 4;
                    cs[ai][m][0] = *(const u32x4*)tp; cs[ai][m][1] = *(const u32x4*)(tp + SEQ * 16); }
            asm volatile("" ::: "memory");
#pragma unroll
            for (int ai = 0; ai < 2; ++ai)
#pragma unroll
                for (int m = 0; m < 4; ++m) {
                    const u32x4 t0 = cs[ai][m][0], t1 = cs[ai][m][1];
                    const f32x4 c0 = {bflo(t0.x), bflo(t0.y), bflo(t0.z), bflo(t0.w)}, s0 = {bfhi(t0.x), bfhi(t0.y), bfhi(t0.z), bfhi(t0.w)};
                    const f32x4 c1 = {bflo(t1.x), bflo(t1.y), bflo(t1.z), bflo(t1.w)}, s1 = {bfhi(t1.x), bfhi(t1.y), bfhi(t1.z), bfhi(t1.w)};
                    const f32x4 x10 = acc[ai][0][m][0], x11 = acc[ai][0][m][1], x20 = acc[ai][1][m][0], x21 = acc[ai][1][m][1];
#if P1_FP8 && QKV_FP8
                    const f32x4 o10 = x10 * c0 - x20 * s0, o11 = x11 * c1 - x21 * s1;
                    const f32x4 o20 = x20 * c0 + x10 * s0, o21 = x21 * c1 + x11 * s1;
#else
                    const f32x4 o10 = (x10 * c0 - x20 * s0) * sc, o11 = (x11 * c1 - x21 * s1) * sc;
                    const f32x4 o20 = (x20 * c0 + x10 * s0) * sc, o21 = (x21 * c1 + x11 * s1) * sc;
#endif
#if QKV_FP8
                    { unsigned char* rp8 = (unsigned char*)base + (size_t)(rb0 + ai * 128 + m * 16 + fr) * ld + colt + 64 * wc + pair16_ofs(fq); u32x2 a8, b8;
                      a8.x = pk4_fp8(o10[0], o10[1], o10[2], o10[3]); a8.y = pk4_fp8(o11[0], o11[1], o11[2], o11[3]); b8.x = pk4_fp8(o20[0], o20[1], o20[2], o20[3]); b8.y = pk4_fp8(o21[0], o21[1], o21[2], o21[3]);
                      store_pair16(rp8, a8, b8); }
#else
                    u32x4 v0, v1, wl, wh;
                    v0.x = pk2(o10[0], o10[1]); v0.y = pk2(o10[2], o10[3]); v0.z = pk2(o11[0], o11[1]); v0.w = pk2(o11[2], o11[3]);
                    v1.x = pk2(o20[0], o20[1]); v1.y = pk2(o20[2], o20[3]); v1.z = pk2(o21[0], o21[1]); v1.w = pk2(o21[2], o21[3]);
                    xchg_rows(v0, v1, fr, wl, wh);
                    bf16_t* rp = seg + (size_t)(rb0 + ai * 128 + m * 16 + rl) * ld;
                    if (var != 1) { *(u32x4*)rp = wl; *(u32x4*)(rp + (size_t)8 * ld) = wh; }
#endif
                }
        } else if (kind == 1 && QKV_FP8) {
            unsigned char* vp0 = (unsigned char*)base + colt + 64 * wc + pair16_ofs(fq);
#pragma unroll
            for (int ai = 0; ai < 2; ++ai)
#pragma unroll
                for (int m = 0; m < 4; ++m) {
                    unsigned char* vp = vp0 + (size_t)(rb0 + ai * 128 + m * 16 + fr) * ld;
                    u32x2 w8[2];
#pragma unroll
                    for (int bj = 0; bj < 2; ++bj) { const f32x4 a = acc[ai][bj][m][0] * WS_, b = acc[ai][bj][m][1] * WS_;
                        w8[bj].x = pk4_fp8(a[0], a[1], a[2], a[3]); w8[bj].y = pk4_fp8(b[0], b[1], b[2], b[3]); }
                    store_pair16(vp, w8[0], w8[1]);
                }
        } else if (kind == 2 && G_FP8) {
            unsigned char* gp0 = (unsigned char*)G + GFRAG_OFS(rb0 >> 4, (pn - 15) * 4 + wc, fq, fr);
#pragma unroll
            for (int ai = 0; ai < 2; ++ai)
#pragma unroll
                for (int m = 0; m < 4; ++m) {
                    unsigned char* gp = gp0 + (size_t)(ai * 8 + m) * 32 * 1024;
                    u32x2 w8[2];
#pragma unroll
                    for (int bj = 0; bj < 2; ++bj) { const f32x4 a = acc[ai][bj][m][0], b = acc[ai][bj][m][1];
                        w8[bj].x = pk4_fp8(sigmoid_sc(a[0], WS_), sigmoid_sc(a[1], WS_), sigmoid_sc(a[2], WS_), sigmoid_sc(a[3], WS_)); w8[bj].y = pk4_fp8(sigmoid_sc(b[0], WS_), sigmoid_sc(b[1], WS_), sigmoid_sc(b[2], WS_), sigmoid_sc(b[3], WS_)); }
                    store_pair16(gp, w8[0], w8[1]);
                }
        } else {
#pragma unroll
            for (int ai = 0; ai < 2; ++ai)
#pragma unroll
                for (int m = 0; m < 4; ++m) {
                    u32x4 v[2], wl, wh;
#pragma unroll
                    for (int bj = 0; bj < 2; ++bj) { f32x4 a = acc[ai][bj][m][0] * WS_, b = acc[ai][bj][m][1] * WS_;
                        if (kind == 2) { a = (f32x4){fast_sigmoid(a[0]), fast_sigmoid(a[1]), fast_sigmoid(a[2]), fast_sigmoid(a[3])}; b = (f32x4){fast_sigmoid(b[0]), fast_sigmoid(b[1]), fast_sigmoid(b[2]), fast_sigmoid(b[3])}; }
                        v[bj].x = pk2(a[0], a[1]); v[bj].y = pk2(a[2], a[3]); v[bj].z = pk2(b[0], b[1]); v[bj].w = pk2(b[2], b[3]); }
                    xchg_rows(v[0], v[1], fr, wl, wh);
                    bf16_t* rp = seg + (size_t)(rb0 + ai * 128 + m * 16 + rl) * ld;
                    if (var != 1) { *(u32x4*)rp = wl; *(u32x4*)(rp + (size_t)8 * ld) = wh; }
                }
        }
    }
};
struct HookGateRatio {
    static constexpr int T = P3_FP8 ? 8 : 16;
    const bf16_t* G;
    __device__ __forceinline__ void operator()(f32x4 (&acc)[2][2][4][2], const Unit& u, int wr, int wc, int fr, int fq) const {
        int loff = (wr * 64 + fr) * 2048 + wc * 64 + 8 * fq;
        asm volatile("" : "+v"(loff));
#if G_FP8
        int fq_o = fq, fr_o = fr; asm volatile("" : "+v"(fq_o), "+v"(fr_o));
        const unsigned char* gfrag = (const unsigned char*)G + GFRAG_OFS(u.pm * 16 + wr * 4, u.pn * 4 + wc, fq_o, fr_o);
#endif
        const unsigned char* gbase = (const unsigned char*)G + ((size_t)u.pm * 256 * 2048 + (size_t)u.pn * 256) * GATE_B;
#pragma unroll
        for (int ai = 0; ai < 2; ++ai) {
            gate8_t ga[4][2], gb[4][2];
#if G_FP8
            { u32x4 La[4], Lb[4];
#pragma unroll
              for (int m = 0; m < 4; ++m) { const unsigned char* gp = gfrag + (size_t)(ai * 8 + m) * 32 * 1024; gate_ld_pair(gp, La[m]); gate_ld_pair(gp + 16 * 1024, Lb[m]); }
              asm volatile("" ::: "memory");
#pragma unroll
              for (int m = 0; m < 4; ++m) { gate_unswap(La[m], ga[m][0], ga[m][1]); gate_unswap(Lb[m], gb[m][0], gb[m][1]); } }
#else
#pragma unroll
            for (int m = 0; m < 4; ++m)
#pragma unroll
                for (int bj = 0; bj < 2; ++bj) { const unsigned char* gp = gbase + (size_t)((ai * 128 + m * 16) * 2048 + bj * 32) * GATE_B + (unsigned)(loff * GATE_B); ga[m][bj] = *(const gate8_t*)gp; gb[m][bj] = *(const gate8_t*)(gp + 1024 * GATE_B); }
            asm volatile("" ::: "memory");
#endif
#pragma unroll
            for (int m = 0; m < 4; ++m)
#pragma unroll
                for (int bj = 0; bj < 2; ++bj) {
                    f32x4 a0, a1, b0, b1; gate_unpack(ga[m][bj], a0, a1); gate_unpack(gb[m][bj], b0, b1);
                    f32x4 r0, r1;
#pragma unroll
                    for (int q = 0; q < 4; ++q) { r0[q] = a0[q] * __builtin_amdgcn_rcpf(b0[q]); r1[q] = a1[q] * __builtin_amdgcn_rcpf(b1[q]); }
                    acc[ai][bj][m][0] *= r0; acc[ai][bj][m][1] *= r1;
                }
            asm volatile("" ::: "memory");
        }
    }
};
struct EpiMerged {
    static constexpr bool PERM = true, FP8 = (P3_FP8 != 0); static constexpr int COLMAP = 2, NSTORES = 16;
    const bf16_t* G; bf16_t* O;
    __device__ __forceinline__ void operator()(const f32x4 (&acc)[2][2][4][2], const Unit& u, int wr, int wc, int fr, int fq) const {
        const int rb0 = u.pm * 256 + wr * 64, col = u.pn * 256 + wc * 64 + 8 * fq;
        gate8_t gb[2][4][2];
#if G_FP8
        { u32x4 Lg[2][4];
#pragma unroll
          for (int ai = 0; ai < 2; ++ai)
#pragma unroll
            for (int m = 0; m < 4; ++m) gate_ld_pair((const unsigned char*)G + GFRAG_OFS((rb0 >> 4) + ai * 8 + m, 16 + u.pn * 4 + wc, fq, fr), Lg[ai][m]);
          asm volatile("" ::: "memory");
#pragma unroll
          for (int ai = 0; ai < 2; ++ai)
#pragma unroll
            for (int m = 0; m < 4; ++m) gate_unswap(Lg[ai][m], gb[ai][m][0], gb[ai][m][1]); }
#else
#pragma unroll
        for (int ai = 0; ai < 2; ++ai)
#pragma unroll
            for (int m = 0; m < 4; ++m)
#pragma unroll
                for (int bj = 0; bj < 2; ++bj) gb[ai][m][bj] = GATE_LD(G, rb0 + ai * 128 + m * 16 + fr, 1024 + col + bj * 32);
        asm volatile("" ::: "memory");
#endif
#pragma unroll
        for (int ai = 0; ai < 2; ++ai)
#pragma unroll
            for (int m = 0; m < 4; ++m) {
                f32x4 o[2][2];
#pragma unroll
                for (int bj = 0; bj < 2; ++bj) { f32x4 g0, g1; gate_unpack(gb[ai][m][bj], g0, g1); constexpr float SC_ = (FP8 ? W8_INV * OA_INV : 1.0f) * (P4_FP8 ? MG_SCALE : 1.0f); o[bj][0] = acc[ai][bj][m][0] * (g0 * SC_); o[bj][1] = acc[ai][bj][m][1] * (g1 * SC_); }
#if P4_FP8
                u32x2 w8[2];
#pragma unroll
                for (int bj = 0; bj < 2; ++bj) {
                    const f32x4 v0 = o[bj][0], v1 = o[bj][1];
                    w8[bj].x = pk4_fp8(v0[0], v0[1], v0[2], v0[3]); w8[bj].y = pk4_fp8(v1[0], v1[1], v1[2], v1[3]); }
                store_pair16((unsigned char*)O + (size_t)(rb0 + ai * 128 + m * 16 + fr) * 1024 + col - 8 * fq + pair16_ofs(fq), w8[0], w8[1]);
#else
                u32x4 v[2], wl, wh;
#pragma unroll
                for (int bj = 0; bj < 2; ++bj) { v[bj].x = pk2(o[bj][0][0], o[bj][0][1]); v[bj].y = pk2(o[bj][0][2], o[bj][0][3]); v[bj].z = pk2(o[bj][1][0], o[bj][1][1]); v[bj].w = pk2(o[bj][1][2], o[bj][1][3]); }
                xchg_rows(v[0], v[1], fr, wl, wh);
                bf16_t* rp = O + u.pn * 256 + wc * 64 + 8 * (fq + 4 * (fr >> 3)) + (size_t)(rb0 + ai * 128 + m * 16 + (fr & 7)) * 1024;
                *(u32x4*)rp = wl; *(u32x4*)(rp + 8 * 1024) = wh;
#endif
            }
    }
};
__device__ __forceinline__ float fq_sum(float v) {
    const auto a = __builtin_amdgcn_permlane16_swap(__float_as_uint(v), __float_as_uint(v), false, false); v = __uint_as_float(a[0]) + __uint_as_float(a[1]);
    const auto b = __builtin_amdgcn_permlane32_swap(__float_as_uint(v), __float_as_uint(v), false, false); return __uint_as_float(b[0]) + __uint_as_float(b[1]);
}
struct EpiPre {
    static constexpr bool PERM = false, FP8 = (P4_FP8 != 0); static constexpr int COLMAP = 2, NSTORES = 32;
    const float* X; float* O; float* ST; bf16_t* P16;
    __device__ __forceinline__ void operator()(f32x4 (&acc)[2][2][4][2], const Unit& u, int wr, int wc, int fr, int fq) const {
        const int rb0 = u.pm * 256 + wr * 64, col = u.pn * 256 + wc * 64 + 4 * fq;
        float* seg = O + u.pn * 256 + wc * 64 + 4 * (fq + 4 * (fr >> 3));
        f32x4 xv[4][2][2];
#define EPIPRE_LOAD(ai) do { _Pragma("unroll") for (int m = 0; m < 4; ++m) { const size_t off = (size_t)(rb0 + (ai) * 128 + m * 16 + fr) * 1024 + col; \
            _Pragma("unroll") for (int bj = 0; bj < 2; ++bj) _Pragma("unroll") for (int n = 0; n < 2; ++n) xv[m][bj][n] = __builtin_nontemporal_load((const f32x4*)(X + off + bj * 32 + n * 16)); } } while (0)
#define EPIPRE_FMA(ai) do { _Pragma("unroll") for (int m = 0; m < 4; ++m) _Pragma("unroll") for (int bj = 0; bj < 2; ++bj) _Pragma("unroll") for (int n = 0; n < 2; ++n) acc[ai][bj][m][n] = xv[m][bj][n] * ALPHA + acc[ai][bj][m][n] * (FP8 ? W8_INV * MG_INV : 1.0f); } while (0)
#if PRE16
        bf16_t* pseg = P16 + u.pn * 256 + wc * 64 + ((fq & 1) ? 16 + 4 * (fq - 1) : 4 * fq);
#define EPIPRE_STORE(ai) do { _Pragma("unroll") for (int m = 0; m < 4; ++m) { bf16_t* rp = pseg + (size_t)(rb0 + (ai) * 128 + m * 16 + fr) * 1024; \
            _Pragma("unroll") for (int bj = 0; bj < 2; ++bj) { const f32x4 a_ = acc[ai][bj][m][0], b_ = acc[ai][bj][m][1]; \
                const auto sx_ = __builtin_amdgcn_permlane16_swap(pk2(a_[0], a_[1]), pk2(b_[0], b_[1]), false, false); const auto sy_ = __builtin_amdgcn_permlane16_swap(pk2(a_[2], a_[3]), pk2(b_[2], b_[3]), false, false); \
                u32x4 w_; w_.x = sx_[0]; w_.y = sy_[0]; w_.z = sx_[1]; w_.w = sy_[1]; *(u32x4*)(rp + bj * 32) = w_; } } } while (0)
#else
#define EPIPRE_STORE(ai) do { _Pragma("unroll") for (int m = 0; m < 4; ++m) { float* rp = seg + (size_t)(rb0 + (ai) * 128 + m * 16 + (fr & 7)) * 1024; \
            _Pragma("unroll") for (int bj = 0; bj < 2; ++bj) { u32x4 wl, wh; xchg_rows(__builtin_bit_cast(u32x4, acc[ai][bj][m][0]), __builtin_bit_cast(u32x4, acc[ai][bj][m][1]), fr, wl, wh); \
                *(u32x4*)(rp + bj * 32) = wl; *(u32x4*)(rp + 8 * 1024 + bj * 32) = wh; } } } while (0)
#endif
#define EPIPRE_STATS(ai) do { if (P5_SINGLE) { _Pragma("unroll") for (int m = 0; m < 4; ++m) { float s1_ = 0.f, s2_ = 0.f; \
            _Pragma("unroll") for (int bj = 0; bj < 2; ++bj) _Pragma("unroll") for (int n = 0; n < 2; ++n) { const f32x4 v_ = acc[ai][bj][m][n]; s1_ += (v_[0] + v_[1]) + (v_[2] + v_[3]); s2_ += (v_[0] * v_[0] + v_[1] * v_[1]) + (v_[2] * v_[2] + v_[3] * v_[3]); } \
            s1_ = fq_sum(s1_); s2_ = fq_sum(s2_); \
            if (fq == 0) *(f32x2*)(ST + ((size_t)(rb0 + (ai) * 128 + m * 16 + fr) * 16 + u.pn * 4 + wc) * 2) = (f32x2){s1_, s2_}; } } } while (0)
        EPIPRE_LOAD(0); asm volatile("" ::: "memory");
        EPIPRE_FMA(0);
        EPIPRE_STATS(0);
        asm volatile("" : "+v"(acc[0][0][0][0]), "+v"(acc[0][0][1][0]), "+v"(acc[0][0][2][0]), "+v"(acc[0][0][3][0]) :: "memory");
        EPIPRE_LOAD(1); asm volatile("" ::: "memory");
        EPIPRE_STORE(0); asm volatile("" ::: "memory");
        EPIPRE_FMA(1);
        EPIPRE_STATS(1);
        EPIPRE_STORE(1);
#undef EPIPRE_STATS
#undef EPIPRE_LOAD
#undef EPIPRE_FMA
#undef EPIPRE_STORE
    }
};
struct EpiSwiglu {
    static constexpr bool PERM = true, FP8 = true; static constexpr int COLMAP = 1, NSTORES = 8;
    const float* bgu; unsigned char* H8;
    __device__ __forceinline__ void operator()(const f32x4 (&acc)[2][2][4][2], const Unit& u, int wr, int wc, int fr, int fq) const {
        const int e = u.pn >> 3, j = u.pn & 7, row0 = u.pm * 256 + wr * 64 + fr, col = j * 128 + wc * 32 + 8 * fq;
        const float* bp = bgu + (size_t)e * 2048 + col;
        constexpr float C_ = -1.702f * LOG2E, SG_ = W8_INV * C_, SU_ = W8_INV / C_, T7_ = 7.0f * C_, ULO_ = 8.0f / C_, UHI_ = -6.0f / C_;
        const f32x4 bg0 = *(const f32x4*)bp * C_, bg1 = *(const f32x4*)(bp + 4) * C_, bu0 = (*(const f32x4*)(bp + 1024) + 1.0f) * (1.0f / C_), bu1 = (*(const f32x4*)(bp + 1028) + 1.0f) * (1.0f / C_);
        unsigned char* hp = H8 + (size_t)(row0 + (fq & 1) * 16) * 1024 + col - 8 * (fq & 1);
#pragma unroll
        for (int ai = 0; ai < 2; ++ai)
#pragma unroll
            for (int mp = 0; mp < 2; ++mp) {
                u32x2 w[2];
#pragma unroll
                for (int mm = 0; mm < 2; ++mm) { const int m = 2 * mp + mm;
                    const f32x4 t0 = acc[ai][0][m][0] * SG_ + bg0, t1 = acc[ai][0][m][1] * SG_ + bg1;
                    const f32x4 u0 = acc[ai][1][m][0] * SU_ + bu0, u1 = acc[ai][1][m][1] * SU_ + bu1;
                    f32x4 o0, o1;
#pragma unroll
                    for (int q = 0; q < 4; ++q) {
                        const float ta = __builtin_fmaxf(t0[q], T7_), tb = __builtin_fmaxf(t1[q], T7_);
                        const float ra = __builtin_amdgcn_rcpf(1.0f + __builtin_amdgcn_exp2f(ta)), rb = __builtin_amdgcn_rcpf(1.0f + __builtin_amdgcn_exp2f(tb));
                        o0[q] = __builtin_amdgcn_fmed3f(u0[q], ULO_, UHI_) * ta * ra; o1[q] = __builtin_amdgcn_fmed3f(u1[q], ULO_, UHI_) * tb * rb;
                    }
                    w[mm].x = pk4_fp8(o0[0], o0[1], o0[2], o0[3]); w[mm].y = pk4_fp8(o1[0], o1[1], o1[2], o1[3]); }
                store_pair16(hp + (size_t)(ai * 128 + mp * 32) * 1024, w[0], w[1]);
            }
    }
};
struct EpiDown {
    static constexpr bool PERM = true, FP8 = true; static constexpr int COLMAP = 2, NSTORES = 16;
    const float* bd; const int* dst; bf16_t* Y;
    __device__ __forceinline__ void operator()(const f32x4 (&acc)[2][2][4][2], const Unit& u, int wr, int wc, int fr, int fq) const {
        const int e = u.pn >> 2, j = u.pn & 3, rb0 = u.pm * 256 + wr * 64, col = j * 256 + wc * 64 + 8 * fq;
        const float* bp = bd + (size_t)e * 1024 + col;
        f32x4 bv[2][2];
#pragma unroll
        for (int bj = 0; bj < 2; ++bj) { bv[bj][0] = *(const f32x4*)(bp + bj * 32); bv[bj][1] = *(const f32x4*)(bp + bj * 32 + 4); }
        int dd[2][4];
#pragma unroll
        for (int ai = 0; ai < 2; ++ai)
#pragma unroll
            for (int m = 0; m < 4; ++m) dd[ai][m] = dst[rb0 + ai * 128 + m * 16 + fr];
        asm volatile("" ::: "memory");
        bf16_t* seg = Y + j * 256 + wc * 64 + 8 * (fq + 4 * (fr >> 3));
#pragma unroll
        for (int ai = 0; ai < 2; ++ai)
#pragma unroll
            for (int m = 0; m < 4; ++m) {
                u32x4 v[2], wl, wh;
#pragma unroll
                for (int bj = 0; bj < 2; ++bj) { const f32x4 v0 = acc[ai][bj][m][0] * W8_INV + bv[bj][0], v1 = acc[ai][bj][m][1] * W8_INV + bv[bj][1];
                    v[bj].x = pk2(v0[0], v0[1]); v[bj].y = pk2(v0[2], v0[3]); v[bj].z = pk2(v1[0], v1[1]); v[bj].w = pk2(v1[2], v1[3]); }
#if Y_FP8
                (void)wl; (void)wh; (void)seg;
                { const int dme = dd[ai][m] >= 0 ? dd[ai][m] : HALF_T * 4;
                  unsigned char* rp8 = (unsigned char*)Y + (size_t)dme * 1024 + j * 256 + wc * 64 + pair16_ofs(fq); u32x2 w8[2];
#pragma unroll
                  for (int bj = 0; bj < 2; ++bj) { const f32x4 v0 = acc[ai][bj][m][0] * W8_INV + bv[bj][0], v1 = acc[ai][bj][m][1] * W8_INV + bv[bj][1];
                      w8[bj].x = pk4_fp8(v0[0], v0[1], v0[2], v0[3]); w8[bj].y = pk4_fp8(v1[0], v1[1], v1[2], v1[3]); }
                  store_pair16(rp8, w8[0], w8[1]); }
#else
                xchg_rows(v[0], v[1], fr, wl, wh);
                const int dme = dd[ai][m] >= 0 ? dd[ai][m] : HALF_T * 4, dpt = (int)dpp_ror8((unsigned)dme);
                const int d0 = fr < 8 ? dme : dpt, d1 = fr < 8 ? dpt : dme;
                *(u32x4*)(seg + (size_t)d0 * 1024) = wl; *(u32x4*)(seg + (size_t)d1 * 1024) = wh;
#endif
            }
    }
};

__device__ __forceinline__ int crow(int r, int hi) { return (r & 3) + 8 * (r >> 2) + 4 * hi; }
constexpr float AT_THR = 8.0f;
constexpr int AT_KROW = 144, AT_VROW = 128, AT_MAXT = 12;
constexpr int AT_KOFF = 0, AT_VOFF = AT_MAXT * 32 * AT_KROW;
static_assert(AT_VOFF + AT_MAXT * 32 * AT_VROW <= 131072, "attention LDS images fit the ring region");
#if QKV_FP8
typedef unsigned char qkv_t;
#else
typedef bf16_t qkv_t;
#endif
struct AttnUnit {
    const qkv_t* q; const qkv_t* k; const qkv_t* v; bf16_t* o; float* lse;
    const float* sink;
    int qld, kvld, old, lseld, dil, qt0, NQ, NH, nback, ofp8;
    int pair;
};
__device__ __forceinline__ int attn_ntask(const AttnUnit& u) { return u.pair ? 8 : u.NQ * u.NH; }
__device__ __forceinline__ int attn_task_qi(const AttnUnit& u, int t) { return u.pair ? (t >= 4 ? 7 - t : t) : t / u.NH; }
__device__ __forceinline__ int attn_task_sub(const AttnUnit& u, int t) { return u.pair ? (t >> 2) : 0; }
#define attn_task(u_, t_, qi_, hq_, sub_) do { qi_ = attn_task_qi(u_, t_); sub_ = attn_task_sub(u_, t_); hq_ = (u_).pair ? 0 : (t_) - qi_ * (u_).NH; } while (0)
constexpr int AT_NUNITS = 4096;
__device__ __forceinline__ AttnUnit attn_decode(int id, qkv_t* QA, qkv_t* KA, qkv_t* VA, qkv_t* QB, qkv_t* KB, qkv_t* VB, bf16_t* OAB, bf16_t* OG, float* LSE, const float* sinks) {
    AttnUnit u;
    u.pair = 0;
    if (id < 1024) { const int kvh = id & 3, qb = (id >> 2) & 7, b = id >> 5; const size_t t0 = (size_t)b * SEQ;
        u.q = QA + t0 * 1024 + kvh * 256; u.k = KA + t0 * 256 + kvh * 64; u.v = VA + t0 * 256 + kvh * 64; u.o = P3_FP8 ? (bf16_t*)((unsigned char*)OAB + t0 * 1280 + kvh * 256) : OAB + t0 * 1280 + kvh * 256; u.lse = nullptr; u.sink = sinks + kvh * 4;
        u.qld = 1024; u.kvld = 256; u.old = 1280; u.lseld = 0; u.dil = 1; u.qt0 = 8 * qb; u.NQ = 8; u.NH = 4; u.nback = 127; u.ofp8 = P3_FP8; return u; }
    id -= 1024; int head, res, b; u.ofp8 = (OG_FP8 && P3_FP8) ? 1 : 0;
    if (id < 1024) { head = id & 3; u.qt0 = 8 * ((id >> 2) & 7); b = id >> 5; res = 0; u.dil = 1; u.NQ = 8; }
    else if (id < 2048) { id -= 1024; head = 4 + (id & 3); res = (id >> 2) & 3; u.qt0 = 8 * ((id >> 4) & 1); b = id >> 5; u.dil = 4; u.NQ = 8; }
    else { id -= 2048; head = 8 + (id & 3); res = 2 * ((id >> 2) & 7); b = id >> 5; u.qt0 = 0; u.dil = 16; u.NQ = 4; u.pair = 1; }
    const size_t t0 = (size_t)b * SEQ + res;
    u.q = QB + t0 * 768 + head * 64; u.k = KB + t0 * 768 + head * 64; u.v = VB + t0 * 768 + head * 64; u.o = (OG_FP8 && P3_FP8) ? (bf16_t*)((unsigned char*)OG + t0 * 768 + head * 64) : OG + t0 * 768 + head * 64; u.lse = LSE + t0 * 12 + head; u.sink = nullptr;
    u.qld = 768; u.kvld = 768; u.old = 768; u.lseld = 12; u.NH = 1; u.nback = 128; return u;
}
#if QKV_FP8
constexpr int AT_NPRE = AT_MAXT / 2;
__device__ __forceinline__ void attn_prefetch(const AttnUnit& u, u32x4 (&pre)[AT_NPRE], int tid) {
    const int w0 = u.qt0 > 4 ? u.qt0 - 4 : 0, NK = u.pair ? 8 : u.qt0 + u.NQ - w0;
    const int part = tid & 7;
    const qkv_t* src = (part < 4 ? u.k : u.v) + (size_t)(32 * w0 + (tid >> 3)) * u.dil * u.kvld + (part & 3) * 16;
    const size_t step = (size_t)64 * u.dil * u.kvld;
#pragma unroll
    for (int j = 0; j < AT_NPRE; ++j) if (2 * j < NK) pre[j] = *(const u32x4*)(src + (u.pair ? (size_t)(j & 1) * step + (size_t)(j >> 1) * u.kvld : j * step));
}
__device__ __forceinline__ void fp8x16_to_bf16(const u32x4 w, u32x4& o0, u32x4& o1) {
    typedef __bf16 bf16p_t __attribute__((ext_vector_type(2)));
#define F8_BF2(word_, hi_) __builtin_bit_cast(unsigned, (bf16p_t)__builtin_amdgcn_cvt_scalef32_pk_bf16_fp8((word_), 1.0f, (hi_)))
    o0.x = F8_BF2(w.x, false); o0.y = F8_BF2(w.x, true); o0.z = F8_BF2(w.y, false); o0.w = F8_BF2(w.y, true);
    o1.x = F8_BF2(w.z, false); o1.y = F8_BF2(w.z, true); o1.z = F8_BF2(w.w, false); o1.w = F8_BF2(w.w, true);
#undef F8_BF2
}
__device__ __forceinline__ void attn_stage(const AttnUnit& u, const u32x4 (&pre)[AT_NPRE], LAS unsigned char* lds, int tid) {
    const int w0 = u.qt0 > 4 ? u.qt0 - 4 : 0, NK = u.pair ? 8 : u.qt0 + u.NQ - w0; (void)w0;
    const int part = tid & 7, row0 = tid >> 3;
#pragma unroll
    for (int j = 0; j < AT_NPRE; ++j) if (2 * j < NK) {
        const int row = row0 + 64 * j; u32x4 o0, o1; fp8x16_to_bf16(pre[j], o0, o1);
        LAS unsigned char* dst = part < 4 ? lds + AT_KOFF + row * AT_KROW + part * 32 : lds + AT_VOFF + row * AT_VROW + (((part - 4) * 32) ^ (((row >> 1) & 1) << 6));
        *(LAS u32x4*)dst = o0; *(LAS u32x4*)(dst + 16) = o1;
    }
}
#else
constexpr int AT_NPRE = AT_MAXT;
__device__ __forceinline__ void attn_prefetch(const AttnUnit& u, u32x4 (&pre)[AT_MAXT], int tid) {
    const int w0 = u.qt0 > 4 ? u.qt0 - 4 : 0, NK = u.qt0 + u.NQ - w0;
    const int part = tid & 15;
    const bf16_t* src = (part < 8 ? u.k : u.v) + (size_t)(32 * w0 + (tid >> 4)) * u.dil * u.kvld + (part & 7) * 8;
    const size_t step = (size_t)32 * u.dil * u.kvld;
#pragma unroll
    for (int j = 0; j < AT_MAXT; ++j) if (j < NK) pre[j] = *(const u32x4*)(src + j * step);
}
__device__ __forceinline__ void attn_stage(const AttnUnit& u, const u32x4 (&pre)[AT_MAXT], LAS unsigned char* lds, int tid) {
    const int w0 = u.qt0 > 4 ? u.qt0 - 4 : 0, NK = u.qt0 + u.NQ - w0;
    const int part = tid & 15, row0 = tid >> 4;
#pragma unroll
    for (int j = 0; j < AT_MAXT; ++j) if (j < NK) {
        const int row = row0 + 32 * j;
        if (part < 8) *(LAS u32x4*)(lds + AT_KOFF + row * AT_KROW + part * 16) = pre[j];
        else *(LAS u32x4*)(lds + AT_VOFF + row * AT_VROW + ((((part - 8) * 16)) ^ (((row >> 1) & 1) << 6))) = pre[j];
    }
}
#endif
typedef short v4i16_t __attribute__((ext_vector_type(4)));
__device__ __forceinline__ void attn_load_q_raw(const AttnUnit& u, int t, int lane, u32x2 (&raw)[4]) {
    int qi, hq, sub; attn_task(u, t, qi, hq, sub);
    const unsigned char* qp = (const unsigned char*)u.q + ((size_t)(32 * (u.qt0 + qi) + (lane & 31)) * u.dil + sub) * u.qld + hq * 64 + 32 * (lane >> 5);
    const u32x4 q0 = *(const u32x4*)qp, q1 = *(const u32x4*)(qp + 16);
    raw[0].x = q0.x; raw[0].y = q0.y; raw[1].x = q0.z; raw[1].y = q0.w; raw[2].x = q1.x; raw[2].y = q1.y; raw[3].x = q1.z; raw[3].y = q1.w;
}
__device__ __forceinline__ void attn_cvt_q(const u32x2 (&raw)[4], bf16x8 (&qf)[4]) {
#pragma unroll
    for (int ds = 0; ds < 4; ++ds) { const f32x4 a = fp8x4_f32(raw[ds].x) * QSCALE, b = fp8x4_f32(raw[ds].y) * QSCALE;
        u32x4 p; p.x = pk2(a[0], a[1]); p.y = pk2(a[2], a[3]); p.z = pk2(b[0], b[1]); p.w = pk2(b[2], b[3]); qf[ds] = __builtin_bit_cast(bf16x8, p); }
}
__device__ __forceinline__ void attn_load_q(const AttnUnit& u, int t, int lane, bf16x8 (&qf)[4]) {
    const int qi = t / u.NH, hq = t - qi * u.NH;
    const qkv_t* qp = u.q + (size_t)(32 * (u.qt0 + qi) + (lane & 31)) * u.dil * u.qld + hq * 64 + 8 * (lane >> 5);
#if QKV_FP8
    u32x2 raw[4];
    attn_load_q_raw(u, t, lane, raw); attn_cvt_q(raw, qf); (void)qp;
#else
#pragma unroll
    for (int ds = 0; ds < 4; ++ds) qf[ds] = *(const bf16x8*)(qp + 16 * ds);
#endif
}
__device__ __forceinline__ void attn_compute(const AttnUnit& u, const AttnUnit& nu, bool has_nu, LAS unsigned char* lds, int wave, int lane, bf16x8 (&qf)[4]) {
    const int r = lane & 31, hi = lane >> 5, w0 = u.qt0 > 4 ? u.qt0 - 4 : 0;
    const int ntask = attn_ntask(u);
    const int q4 = (lane & 15) >> 2, p4 = lane & 3, blk = (lane >> 4) & 1;
    const int vlane = (4 * hi + q4) * AT_VROW + 32 * blk + 8 * p4, vsw = ((q4 >> 1) & 1) << 6;
    f32x16 biasD, biasF;
    { const int rr = r - 4 * hi, thr = rr - (u.nback - 128);
#pragma unroll
      for (int i = 0; i < 16; ++i) { biasD[i] = crow(i, 0) > rr ? -INFINITY : 0.f; biasF[i] = crow(i, 0) < thr ? -INFINITY : 0.f; } }
    for (int t = wave; t < ntask; t += 8) {
        int qi, hq, sub; attn_task(u, t, qi, hq, sub);
        const int qt = u.qt0 + qi, c0 = 32 * qt;
        const bool has_sink = u.sink != nullptr;
        float m = has_sink ? u.sink[hq] * LOG2E : -1e30f;
        f32x16 O0 = {}, O1 = {};
        f32x16 L; { const float l0 = has_sink ? 1.f : 0.f;
#pragma unroll
          for (int i = 0; i < 16; ++i) L[i] = l0; }
        const bf16x8 ones8 = __builtin_bit_cast(bf16x8, (u32x4){0x3F803F80u, 0x3F803F80u, 0x3F803F80u, 0x3F803F80u});
        u32x2 rawn[4]; const bool nx_here = t + 8 < ntask, nx_unit = !nx_here && has_nu && wave < attn_ntask(nu);
        if (nx_here) attn_load_q_raw(u, t + 8, lane, rawn); else if (nx_unit) attn_load_q_raw(nu, wave, lane, rawn);
        const int kt0 = qt > 4 ? qt - 4 : 0, qpos = c0 + r;
        for (int kt = kt0; kt <= qt; ++kt) {
            const int ti = kt - w0 + 4 * sub;
            const LAS unsigned char* kp = lds + AT_KOFF + (ti * 32 + r) * AT_KROW + 64 * hi;
            bf16x8 kf[4];
#pragma unroll
            for (int ds = 0; ds < 4; ++ds) kf[ds] = *(const LAS bf16x8*)(kp + 16 * ds);
            const LAS unsigned char* vp = lds + AT_VOFF + ti * 32 * AT_VROW + vlane;
            s16x4 va[2][2][2];
#pragma unroll
            for (int dt = 0; dt < 2; ++dt)
#pragma unroll
                for (int sx = 0; sx < 2; ++sx)
#pragma unroll
                    for (int tx = 0; tx < 2; ++tx)
                        va[dt][sx][tx] = __builtin_bit_cast(s16x4, __builtin_amdgcn_ds_read_tr16_b64_v4i16((LAS v4i16_t*)(vp + (16 * sx + 8 * tx) * AT_VROW + ((64 * dt) ^ vsw))));
            f32x16 x;
            if (kt == qt) x = __builtin_amdgcn_mfma_f32_32x32x16_bf16(kf[0], qf[0], biasD, 0, 0, 0);
            else if (kt == qt - 4) x = __builtin_amdgcn_mfma_f32_32x32x16_bf16(kf[0], qf[0], biasF, 0, 0, 0);
            else { const f32x16 z = {}; x = __builtin_amdgcn_mfma_f32_32x32x16_bf16(kf[0], qf[0], z, 0, 0, 0); }
#pragma unroll
            for (int ds = 1; ds < 4; ++ds) x = __builtin_amdgcn_mfma_f32_32x32x16_bf16(kf[ds], qf[ds], x, 0, 0, 0);
            float mx = x[0];
#pragma unroll
            for (int i = 1; i < 16; ++i) mx = __builtin_fmaxf(mx, x[i]);
            { const auto sw = __builtin_amdgcn_permlane32_swap(__float_as_uint(mx), __float_as_uint(mx), false, false);
              mx = __builtin_fmaxf(__uint_as_float(sw[0]), __uint_as_float(sw[1])); }
            if (__builtin_amdgcn_ballot_w64(mx > m + AT_THR) != 0ull) {
                const float mnew = __builtin_fmaxf(m, mx), alpha = __builtin_amdgcn_exp2f(m - mnew);
                m = mnew; L[0] *= alpha;
#pragma unroll
                for (int i = 0; i < 16; ++i) { O0[i] *= alpha; O1[i] *= alpha; }
            }
#pragma unroll
            for (int i = 0; i < 16; ++i) x[i] = __builtin_amdgcn_exp2f(x[i] - m);
            bf16x8 pf[2];
#pragma unroll
            for (int sx = 0; sx < 2; ++sx) { u32x4 p; p.x = pk2(x[8 * sx], x[8 * sx + 1]); p.y = pk2(x[8 * sx + 2], x[8 * sx + 3]); p.z = pk2(x[8 * sx + 4], x[8 * sx + 5]); p.w = pk2(x[8 * sx + 6], x[8 * sx + 7]); pf[sx] = __builtin_bit_cast(bf16x8, p); }
#pragma unroll
            for (int sx = 0; sx < 2; ++sx) {
                const bf16x8 v0 = __builtin_shufflevector(va[0][sx][0], va[0][sx][1], 0, 1, 2, 3, 4, 5, 6, 7), v1 = __builtin_shufflevector(va[1][sx][0], va[1][sx][1], 0, 1, 2, 3, 4, 5, 6, 7);
                O0 = __builtin_amdgcn_mfma_f32_32x32x16_bf16(v0, pf[sx], O0, 0, 0, 0);
                O1 = __builtin_amdgcn_mfma_f32_32x32x16_bf16(v1, pf[sx], O1, 0, 0, 0);
                L = __builtin_amdgcn_mfma_f32_32x32x16_bf16(ones8, pf[sx], L, 0, 0, 0);
            }
        }
        const float l = L[0];
        const float inv = 1.0f / l;
        const size_t oel = ((size_t)(c0 + r) * u.dil + sub) * u.old + hq * 64 + 16 * hi;
        if (u.ofp8) {
            unsigned char* op8 = (unsigned char*)u.o + oel; const float sc8 = inv * OA_SCALE;
            unsigned w0_[4], w1_[4];
#pragma unroll
            for (int g = 0; g < 4; ++g) { w0_[g] = pk4_fp8(O0[4 * g] * sc8, O0[4 * g + 1] * sc8, O0[4 * g + 2] * sc8, O0[4 * g + 3] * sc8); w1_[g] = pk4_fp8(O1[4 * g] * sc8, O1[4 * g + 1] * sc8, O1[4 * g + 2] * sc8, O1[4 * g + 3] * sc8); }
            const auto a02 = __builtin_amdgcn_permlane32_swap(w0_[0], w0_[2], false, false), a13 = __builtin_amdgcn_permlane32_swap(w0_[1], w0_[3], false, false);
            const auto b02 = __builtin_amdgcn_permlane32_swap(w1_[0], w1_[2], false, false), b13 = __builtin_amdgcn_permlane32_swap(w1_[1], w1_[3], false, false);
            u32x4 s0, s1; s0.x = a02[0]; s0.y = a02[1]; s0.z = a13[0]; s0.w = a13[1]; s1.x = b02[0]; s1.y = b02[1]; s1.z = b13[0]; s1.w = b13[1];
            *(u32x4*)op8 = s0; *(u32x4*)(op8 + 32) = s1;
        } else {
            bf16_t* op = u.o + oel;
            u32x2 w0_[4], w1_[4];
#pragma unroll
            for (int g = 0; g < 4; ++g) {
                w0_[g].x = pk2(O0[4 * g] * inv, O0[4 * g + 1] * inv); w0_[g].y = pk2(O0[4 * g + 2] * inv, O0[4 * g + 3] * inv);
                w1_[g].x = pk2(O1[4 * g] * inv, O1[4 * g + 1] * inv); w1_[g].y = pk2(O1[4 * g + 2] * inv, O1[4 * g + 3] * inv);
            }
#define AT_SWAP_STORE(w_, dst_) do { \
                const auto x02_ = __builtin_amdgcn_permlane32_swap(w_[0].x, w_[2].x, false, false), y02_ = __builtin_amdgcn_permlane32_swap(w_[0].y, w_[2].y, false, false); \
                const auto x13_ = __builtin_amdgcn_permlane32_swap(w_[1].x, w_[3].x, false, false), y13_ = __builtin_amdgcn_permlane32_swap(w_[1].y, w_[3].y, false, false); \
                u32x4 s0_, s1_; s0_.x = x02_[0]; s0_.y = y02_[0]; s0_.z = x02_[1]; s0_.w = y02_[1]; s1_.x = x13_[0]; s1_.y = y13_[0]; s1_.z = x13_[1]; s1_.w = y13_[1]; \
                *(u32x4*)(dst_) = s0_; *(u32x4*)((dst_) + 8) = s1_; } while (0)
            AT_SWAP_STORE(w0_, op); AT_SWAP_STORE(w1_, op + 32);
#undef AT_SWAP_STORE
        }
        if (u.lse && hi == 0) u.lse[((size_t)(c0 + r) * u.dil + sub) * u.lseld] = m + __builtin_amdgcn_logf(l);
        if (nx_here || nx_unit) attn_cvt_q(rawn, qf);
    }
    if (wave >= ntask && has_nu && wave < attn_ntask(nu)) attn_load_q(nu, wave, lane, qf);
}

struct Args { const float* in[16]; float* out; unsigned char* ws; int ph_lo, ph_hi, li, var; };
constexpr int NPHASE = 8 + 2 * NHALF;

__device__ __forceinline__ void p0_transpose_item(const float* W, int N, int k0, int n0, bf16_t* WT, size_t ldo, size_t orow0, size_t ocol0, LAS float* scr, int lane) {
#pragma unroll 8
    for (int i = 0; i < 32; ++i) { const int kk = 2 * i + (lane >> 5); scr[kk * 33 + (lane & 31)] = W[(size_t)(k0 + kk) * N + n0 + (lane & 31)]; }
    LDS_WAIT(); asm volatile("" ::: "memory");
    const int c = lane & 7;
#pragma unroll
    for (int j = 0; j < 4; ++j) { const int n = (lane >> 3) + 8 * j; const LAS float* s = scr + (8 * c) * 33 + n;
        u32x4 o; o.x = pk2(s[0 * 33], s[1 * 33]); o.y = pk2(s[2 * 33], s[3 * 33]); o.z = pk2(s[4 * 33], s[5 * 33]); o.w = pk2(s[6 * 33], s[7 * 33]);
        *(u32x4*)(WT + (orow0 + n) * ldo + ocol0 + 8 * c) = o; }
    LDS_WAIT(); asm volatile("" ::: "memory");
}

template <bool NTS = false>
__device__ __forceinline__ void p0_transpose_item_f8(const float* W, int N, int k0, int n0, unsigned char* WT, size_t ldo, size_t orow0, size_t ocol0, float scale, LAS float* scr, int lane) {
#pragma unroll 8
    for (int i = 0; i < 32; ++i) { const int kk = 2 * i + (lane >> 5); scr[kk * 33 + (lane & 31)] = __builtin_nontemporal_load(&W[(size_t)(k0 + kk) * N + n0 + (lane & 31)]); }
    LDS_WAIT(); asm volatile("" ::: "memory");
#pragma unroll
    for (int j = 0; j < 2; ++j) { const int id = lane + 64 * j, n = id >> 2, c = id & 3; const LAS float* sp = scr + (16 * c) * 33 + n;
        u32x4 o;
        o.x = pk4_fp8(sp[0 * 33] * scale, sp[1 * 33] * scale, sp[2 * 33] * scale, sp[3 * 33] * scale); o.y = pk4_fp8(sp[4 * 33] * scale, sp[5 * 33] * scale, sp[6 * 33] * scale, sp[7 * 33] * scale);
        o.z = pk4_fp8(sp[8 * 33] * scale, sp[9 * 33] * scale, sp[10 * 33] * scale, sp[11 * 33] * scale); o.w = pk4_fp8(sp[12 * 33] * scale, sp[13 * 33] * scale, sp[14 * 33] * scale, sp[15 * 33] * scale);
        if (NTS) __builtin_nontemporal_store(o, (u32x4*)(WT + (orow0 + n) * ldo + ocol0 + 16 * c)); else *(u32x4*)(WT + (orow0 + n) * ldo + ocol0 + 16 * c) = o; }
    LDS_WAIT(); asm volatile("" ::: "memory");
}

__device__ __forceinline__ int opaque_tid() { int t = threadIdx.x; asm volatile("" : "+v"(t)); return t; }
__global__ void __launch_bounds__(512, 2) mk_fwd(Args args) {
    extern __shared__ __attribute__((aligned(16))) unsigned char lds_raw[];
    LAS unsigned char* lds = (LAS unsigned char*)lds_raw;
    volatile LAS unsigned* MISC = (volatile LAS unsigned*)(lds + MISC_OFF);
    const int tid = threadIdx.x, lane = tid & 63, wave = __builtin_amdgcn_readfirstlane(tid >> 6);
    const int G = gridDim.x, bx = blockIdx.x;
    const int gw = bx * 8 + wave, NGW = G * 8;
    unsigned char* const ws = args.ws;
    unsigned* const ctl = (unsigned*)(ws + WS_CTL);
#define X_IN     (args.in[0])
#define w_in     (args.in[1])
#define sinks    (args.in[2])
#define w_ba     (args.in[3])
#define w_bb     (args.in[4])
#define w_out    (args.in[5])
#define ln1g     (args.in[6])
#define ln1b     (args.in[7])
#define w_router (args.in[8])
#define b_router (args.in[9])
#define w_gu     (args.in[10])
#define b_gu     (args.in[11])
#define w_dn     (args.in[12])
#define b_dn     (args.in[13])
#define ln2g     (args.in[14])
#define ln2b     (args.in[15])
#define OUTP     (args.out)
#define csT    ((unsigned*)(ws + WS_COS))
#define WIN    ((bf16_t*)(ws + WS_WIN))
#define WAB    ((bf16_t*)(ws + WS_WAB))
#define WOUT   ((bf16_t*)(ws + WS_WOUT))
#define WGU    ((unsigned char*)(ws + WS_WGU))
#define WDN    ((unsigned char*)(ws + WS_WDN))
#define H1F8   ((unsigned char*)(ws + WS_H1F8))
#define STATS  ((float*)(ws + WS_STATS))
#define TOPE   ((int*)(ws + WS_TOPE))
#define TOPW   ((float*)(ws + WS_TOPW))
#define HIST   ((int*)(ws + WS_HIST))
#define ROWTOK ((int*)(ws + WS_ROWTOK))
#define ROWDST ((int*)(ws + WS_ROWDST))
#define TILEE  ((int*)(ws + WS_TILEE))
#define OAB    ((bf16_t*)(ws + WS_OAB))
#define XB     ((bf16_t*)(ws + WS_XB))
#define H1     ((bf16_t*)(ws + WS_H1))
#define Gt     ((bf16_t*)(ws + WS_G))
#define KB     ((bf16_t*)(ws + WS_KB))
#define VAT    ((bf16_t*)(ws + WS_VAT))
#define VBT    ((bf16_t*)(ws + WS_VBT))
#define OG     ((bf16_t*)(ws + WS_OG))
#define LSE    ((float*)(ws + WS_LSE))
#define MERGED ((bf16_t*)(ws + WS_MERGED))
#define Hh     ((unsigned char*)(ws + WS_H))
#define Y      ((bf16_t*)(ws + WS_Y))
#define QA     ((bf16_t*)((unsigned char*)args.out + DO_QA))
#define QB     ((bf16_t*)((unsigned char*)args.out + DO_QB))
#define KA     ((bf16_t*)((unsigned char*)args.out + DO_KA))

    for (int u = tid; u < (LDS_BYTES - LDSCTL_OFF) / 4; u += 512) ((LAS unsigned*)(lds + LDSCTL_OFF))[u] = 0u;
    __syncthreads();
    XcdBarrier bar; bar.bar = ctl + CW_BAR + args.li * XCD_BAR_WORDS; bar.x = 0; bar.st = nullptr;
    if (MK_ONE_LAUNCH) bar = xcd_barrier_post(ctl + CW_BAR + args.li * XCD_BAR_WORDS, MISC + 8);
    const int lo = args.ph_lo, hi = args.ph_hi;
#ifndef PH_MASK
#define PH_MASK 0xFFFF
#endif
#define IN(k) (((PH_MASK >> (k)) & 1) && lo <= (k) && (k) < hi)
#define SEAM(k) do { if (IN(k) && IN((k) + 1)) xcd_barrier(bar); } while (0)
#ifndef REPEAT_MASK
#define REPEAT_MASK 0
#endif
#define REPN(k) ((((REPEAT_MASK) >> (k)) & 1) ? 2 : 1)
#define REP_LOOP(k) for (int rep_ = 0; rep_ < REPN(k); ++rep_)
#define REP_SYNC() do { if (rep_) xcd_barrier(bar); } while (0)

    if (IN(0)) { REP_LOOP(0) { REP_SYNC(); const int tid = opaque_tid(), lane = tid & 63, wave = __builtin_amdgcn_readfirstlane(tid >> 6), gw = bx * 8 + wave; (void)lane; (void)wave; (void)gw;

        for (int i = tid * G + bx; i < SEQ * 32; i += G * 512) {
            const int pos = i >> 5, f = i & 31;
            const double invf = exp2(-(double)f * (13.287712379549449 / 32.0));
            const double ang = (double)pos * invf;
            const double red = ang - 6.283185307179586476925 * rint(ang * 0.15915494309189533577);
            float sn, cs; __sincosf((float)red, &sn, &cs);
            csT[((f & 7) >> 2) * (SEQ * 16) + ((((pos >> 4) * 4 + (f >> 3)) * 16 + (pos & 15)) * 4) + (f & 3)] = pk2(cs * ROPE_TAB_SCALE, sn * ROPE_TAB_SCALE);
        }
        LAS float* scr = (LAS float*)(lds + wave * 16384);
        constexpr int I_IN = 16 * 184, I_BA = 16 * 32, I_BB = 4 * 32, I_OUT = 16 * 32, I_GU = 32 * 16 * 64, I_DN = 32 * 16 * 32;
        constexpr int NITEMS = I_IN + I_BA + I_BB + I_OUT + I_GU + I_DN;
        for (int it = gw; it < NITEMS; it += NGW) {
            int r = it;
            if (r < I_IN) { const int kb = r / 184, nb = r % 184, n0 = 32 * nb, tile = n0 >> 8, within = n0 & 255;
                (void)tile; (void)within;
#if P1_FP8
                p0_transpose_item_f8(w_in, INW, 64 * kb, n0, (unsigned char*)WIN, 1024, n0, 64 * kb, W8_SCALE, scr, lane); continue; } r -= I_IN;
#else
                p0_transpose_item(w_in, INW, 64 * kb, n0, WIN, 1024, n0, 64 * kb, scr, lane); continue; } r -= I_IN;
#endif
#if P3_FP8
            if (r < I_BA) { const int kb = r / 32, nb = r % 32; p0_transpose_item_f8(w_ba, 1024, 64 * kb, 32 * nb, (unsigned char*)WAB, 1280, 32 * nb, 64 * kb, W8_SCALE, scr, lane); continue; } r -= I_BA;
            if (r < I_BB) { const int kb = r / 32, nb = r % 32; p0_transpose_item_f8(w_bb, 1024, 64 * kb, 32 * nb, (unsigned char*)WAB, 1280, 32 * nb, 1024 + 64 * kb, W8_SCALE, scr, lane); continue; } r -= I_BB;
#else
            if (r < I_BA) { const int kb = r / 32, nb = r % 32; p0_transpose_item(w_ba, 1024, 64 * kb, 32 * nb, WAB, 1280, 32 * nb, 64 * kb, scr, lane); continue; } r -= I_BA;
            if (r < I_BB) { const int kb = r / 32, nb = r % 32; p0_transpose_item(w_bb, 1024, 64 * kb, 32 * nb, WAB, 1280, 32 * nb, 1024 + 64 * kb, scr, lane); continue; } r -= I_BB;
#endif
#if P4_FP8
            if (r < I_OUT) { const int kb = r / 32, nb = r % 32; p0_transpose_item_f8(w_out, 1024, 64 * kb, 32 * nb, (unsigned char*)WOUT, 1024, 32 * nb, 64 * kb, W8_SCALE, scr, lane); continue; } r -= I_OUT;
#else
            if (r < I_OUT) { const int kb = r / 32, nb = r % 32; p0_transpose_item(w_out, 1024, 64 * kb, 32 * nb, WOUT, 1024, 32 * nb, 64 * kb, scr, lane); continue; } r -= I_OUT;
#endif
            if (r < I_GU) { const int e = r / 1024, q = r % 1024, kb = q / 64, nb = q % 64, n0 = 32 * nb, np = n0 & 1023;
                const int orow = e * 2048 + (np >> 7) * 256 + (n0 >= 1024 ? 128 : 0) + (np & 127);
                p0_transpose_item_f8<true>(w_gu + (size_t)e * 1024 * 2048, 2048, 64 * kb, n0, WGU, 1024, orow, 64 * kb, W8_SCALE, scr, lane); continue; } r -= I_GU;
            { const int e = r / 512, q = r % 512, kb = q / 32, nb = q % 32;
                p0_transpose_item_f8<true>(w_dn + (size_t)e * 1024 * 1024, 1024, 64 * kb, 32 * nb, WDN, 1024, e * 1024 + 32 * nb, 64 * kb, W8_SCALE, scr, lane); }
        }
#if P1_FP8
        for (size_t i = (size_t)bx * 512 + tid; i < (size_t)T * D / 16; i += (size_t)G * 512) {
            const f32x4 a = __builtin_nontemporal_load((const f32x4*)(X_IN + i * 16)), b = __builtin_nontemporal_load((const f32x4*)(X_IN + i * 16 + 4)), c = __builtin_nontemporal_load((const f32x4*)(X_IN + i * 16 + 8)), d = __builtin_nontemporal_load((const f32x4*)(X_IN + i * 16 + 12));
            u32x4 w; w.x = pk4_fp8(a[0], a[1], a[2], a[3]); w.y = pk4_fp8(b[0], b[1], b[2], b[3]); w.z = pk4_fp8(c[0], c[1], c[2], c[3]); w.w = pk4_fp8(d[0], d[1], d[2], d[3]);
            *(u32x4*)((unsigned char*)XB + i * 16) = w;
        }
#else
        for (size_t i = (size_t)bx * 512 + tid; i < (size_t)T * D / 8; i += (size_t)G * 512) {
            const f32x4 a = *(const f32x4*)(X_IN + i * 8), b = *(const f32x4*)(X_IN + i * 8 + 4);
            u32x4 w; w.x = pk2(a[0], a[1]); w.y = pk2(a[2], a[3]); w.z = pk2(b[0], b[1]); w.w = pk2(b[2], b[3]);
            *(u32x4*)(XB + i * 8) = w;
        }
#endif
    }
    }
    SEAM(0);

#define XCD_STAGGER(ticks) do { if ((ticks) > 0) { if (tid == 0) { const unsigned long long te_ = __builtin_amdgcn_s_memrealtime() + (unsigned long long)((STAG_SEL) * (ticks)); \
        while (__builtin_amdgcn_s_memrealtime() < te_) __builtin_amdgcn_s_sleep(4); } __syncthreads(); } } while (0)
#ifndef STAG1
#define STAG1 0
#endif
#ifndef STAG4
#define STAG4 0
#endif
#ifndef STAG7
#define STAG7 0
#endif
#ifndef STAG8
#define STAG8 0
#endif
#ifndef STAG_SEL
#define STAG_SEL ((bx >> 3) & 1)
#endif
#ifdef CLKPROBE
    unsigned long long cp_t0 = 0, cp_r0 = 0, cp_t1 = 0, cp_r1 = 0;
#define CLK_BEGIN(k) do { if ((k) == CLKPROBE) { cp_t0 = __builtin_amdgcn_s_memtime(); cp_r0 = __builtin_amdgcn_s_memrealtime(); } } while (0)
#define CLK_END(k) do { if ((k) == CLKPROBE) { cp_t1 = __builtin_amdgcn_s_memtime(); cp_r1 = __builtin_amdgcn_s_memrealtime(); } } while (0)
#else
#define CLK_BEGIN(k) do {} while (0)
#define CLK_END(k) do {} while (0)
#endif
    if (IN(1)) { REP_LOOP(1) { REP_SYNC(); const int tid = opaque_tid(); (void)tid;
 CLK_BEGIN(1);
#if defined(KLOOP_PROBE) || defined(EPI_PROBE)
        if (tid == 0) MISC[17] = 1;
#endif
#ifndef P1_WGM
#define P1_WGM 8
#endif
        XCD_STAGGER(STAG1);
        pg8::StaticOrderT<INW / 256, P1_WGM> S; S.init(T, INW, G, bx, P1_WGM);
        EpiInProj E{QA, KA, VAT, QB, KB, VBT, Gt, csT, args.var};
        pg8::gemm_phase(lds, XB, WIN, P1_FP8 ? 512 : 1024, S, pg8::ADense{}, E, pg8::NoHook{}); CLK_END(1);
#ifdef KLOOP_PROBE
        if (tid == 0) MISC[17] = 0;
#endif
    }
    }
    SEAM(1);

    if (IN(2)) { REP_LOOP(2) { REP_SYNC(); const int tid = opaque_tid(), lane = tid & 63, wave = __builtin_amdgcn_readfirstlane(tid >> 6), gw = bx * 8 + wave; (void)lane; (void)wave; (void)gw;

        __builtin_amdgcn_s_waitcnt(0x0F70);
        u32x4 pre[AT_NPRE];
        AttnUnit cu = attn_decode(bx, (qkv_t*)QA, (qkv_t*)KA, (qkv_t*)VAT, (qkv_t*)QB, (qkv_t*)KB, (qkv_t*)VBT, OAB, OG, LSE, sinks);
        if (bx < AT_NUNITS) attn_prefetch(cu, pre, tid);
        bf16x8 qf[4];
        if (bx < AT_NUNITS && wave < attn_ntask(cu)) attn_load_q(cu, wave, lane, qf);
        for (int id = bx; id < AT_NUNITS; id += G) {
            attn_stage(cu, pre, lds, tid);
            LDS_WAIT(); __builtin_amdgcn_s_barrier(); asm volatile("" ::: "memory");
            const AttnUnit me = cu;
            const bool has_nu = id + G < AT_NUNITS;
            if (has_nu) { cu = attn_decode(id + G, (qkv_t*)QA, (qkv_t*)KA, (qkv_t*)VAT, (qkv_t*)QB, (qkv_t*)KB, (qkv_t*)VBT, OAB, OG, LSE, sinks); attn_prefetch(cu, pre, tid); }
            attn_compute(me, cu, has_nu, lds, wave, lane, qf);
            LDS_WAIT(); __builtin_amdgcn_s_barrier(); asm volatile("" ::: "memory");
        }
    } }
    SEAM(2);

    if (IN(3)) { REP_LOOP(3) { REP_SYNC(); const int tid = opaque_tid(), lane = tid & 63, wave = __builtin_amdgcn_readfirstlane(tid >> 6), gw = bx * 8 + wave; (void)lane; (void)wave; (void)gw;

        for (size_t i = (size_t)bx * 512 + tid; i < (size_t)T * 32; i += (size_t)G * 512) {
            const size_t tok = i >> 5; const int hh = (int)(i >> 3) & 3, ch = (int)i & 7;
            const float l0 = LSE[tok * 12 + hh], l1 = LSE[tok * 12 + 4 + hh], l2 = LSE[tok * 12 + 8 + hh];
            const float mx = __builtin_fmaxf(l0, __builtin_fmaxf(l1, l2));
            float w0 = __builtin_amdgcn_exp2f(l0 - mx), w1 = __builtin_amdgcn_exp2f(l1 - mx), w2 = __builtin_amdgcn_exp2f(l2 - mx);
            const float inv = 1.0f / (w0 + w1 + w2); w0 *= inv; w1 *= inv; w2 *= inv;
#if OG_FP8 && P3_FP8
            { const unsigned char* og = (const unsigned char*)OG + tok * 768 + hh * 64 + ch * 8;
              const u32x2 a = __builtin_nontemporal_load((const u32x2*)og), c = __builtin_nontemporal_load((const u32x2*)(og + 256)), d = __builtin_nontemporal_load((const u32x2*)(og + 512));
              const f32x4 lo = fp8x4_f32(a.x) * w0 + fp8x4_f32(c.x) * w1 + fp8x4_f32(d.x) * w2, hi = fp8x4_f32(a.y) * w0 + fp8x4_f32(c.y) * w1 + fp8x4_f32(d.y) * w2;
              u32x2 w8; w8.x = pk4_fp8(lo[0], lo[1], lo[2], lo[3]); w8.y = pk4_fp8(hi[0], hi[1], hi[2], hi[3]);
              *(u32x2*)((unsigned char*)OAB + tok * 1280 + 1024 + hh * 64 + ch * 8) = w8; continue; }
#endif
            const u32x4 a = *(const u32x4*)(OG + tok * 768 + hh * 64 + ch * 8), c = *(const u32x4*)(OG + tok * 768 + (4 + hh) * 64 + ch * 8), d = *(const u32x4*)(OG + tok * 768 + (8 + hh) * 64 + ch * 8);
            u32x4 w;
            w.x = pk2(w0 * bflo(a.x) + w1 * bflo(c.x) + w2 * bflo(d.x), w0 * bfhi(a.x) + w1 * bfhi(c.x) + w2 * bfhi(d.x));
            w.y = pk2(w0 * bflo(a.y) + w1 * bflo(c.y) + w2 * bflo(d.y), w0 * bfhi(a.y) + w1 * bfhi(c.y) + w2 * bfhi(d.y));
            w.z = pk2(w0 * bflo(a.z) + w1 * bflo(c.z) + w2 * bflo(d.z), w0 * bfhi(a.z) + w1 * bfhi(c.z) + w2 * bfhi(d.z));
            w.w = pk2(w0 * bflo(a.w) + w1 * bflo(c.w) + w2 * bflo(d.w), w0 * bfhi(a.w) + w1 * bfhi(c.w) + w2 * bfhi(d.w));
#if P3_FP8
            { f32x4 lo, hi; lo = (f32x4){bflo(w.x), bfhi(w.x), bflo(w.y), bfhi(w.y)} * OA_SCALE; hi = (f32x4){bflo(w.z), bfhi(w.z), bflo(w.w), bfhi(w.w)} * OA_SCALE;
              u32x2 w8; w8.x = pk4_fp8(lo[0], lo[1], lo[2], lo[3]); w8.y = pk4_fp8(hi[0], hi[1], hi[2], hi[3]);
              *(u32x2*)((unsigned char*)OAB + tok * 1280 + 1024 + hh * 64 + ch * 8) = w8; }
#else
            *(u32x4*)(OAB + tok * 1280 + 1024 + hh * 64 + ch * 8) = w;
#endif
        }
        xcd_barrier(bar);
        pg8::StaticOrderT<4, 8> S; S.init(T, 1024, G, bx);
        EpiMerged E{Gt, MERGED}; HookGateRatio HK{Gt};
        pg8::gemm_phase(lds, OAB, WAB, P3_FP8 ? 640 : 1280, S, pg8::ADense{}, E, HK);
    }
    }
    SEAM(3);

    if (IN(4)) { REP_LOOP(4) { REP_SYNC(); const int tid = opaque_tid(); (void)tid;

        XCD_STAGGER(STAG4);
        pg8::StaticOrderT<4, 8> S; S.init(T, 1024, G, bx);
        EpiPre E{X_IN, OUTP, STATS, H1};
        pg8::gemm_phase(lds, MERGED, WOUT, P4_FP8 ? 512 : 1024, S, pg8::ADense{}, E, pg8::NoHook{});
    }
    }
    SEAM(4);

#if P5_SINGLE
    if (IN(5)) { REP_LOOP(5) { REP_SYNC(); const int tid = opaque_tid(), lane = tid & 63, wave = __builtin_amdgcn_readfirstlane(tid >> 6), gw = bx * 8 + wave; (void)gw;
        constexpr int GWROW = 2064;
        LAS unsigned char* GWH = lds; LAS unsigned char* GWL = lds + 32 * GWROW;
        LAS int* histL = (LAS int*)(lds + SCR_OFF); LAS float* brL = (LAS float*)(histL + 32); LAS float* gL = brL + 32; LAS float* bL = gL + 1024;
        { float wv[64];
#pragma unroll
          for (int i = 0; i < 64; ++i) wv[i] = w_router[tid + 512 * i];
#pragma unroll
          for (int i = 0; i < 64; ++i) { const int idx = tid + 512 * i, d = idx >> 5, e = idx & 31;
            const float v = wv[i]; const unsigned hb = pk2(v, 0.f) & 0xffffu; const float vh = __uint_as_float(hb << 16); const unsigned lb = pk2(v - vh, 0.f) & 0xffffu;
            ((LAS bf16_t*)(GWH + e * GWROW))[d] = (bf16_t)hb; ((LAS bf16_t*)(GWL + e * GWROW))[d] = (bf16_t)lb; } }
        for (int d = tid; d < 1024; d += 512) { gL[d] = ln1g[d]; bL[d] = ln1b[d]; }
        if (tid < 32) brL[tid] = b_router[tid];
        __syncthreads();
        const int r32 = lane & 31, hi5 = lane >> 5;
        for (int vw = bx; vw < 256; vw += G) {
            if (tid < 32) histL[tid] = 0;
            __syncthreads();
            const int tok0 = vw * 256 + wave * 32;
            float mean, rstd;
            { const f32x4* sp = (const f32x4*)(STATS + (size_t)(tok0 + r32) * 32); float s1 = 0.f, s2 = 0.f;
#pragma unroll
              for (int i = 0; i < 8; ++i) { const f32x4 t = sp[i]; s1 += t[0] + t[2]; s2 += t[1] + t[3]; }
              mean = s1 * (1.f / 1024.f); const float var = __builtin_fmaxf(s2 * (1.f / 1024.f) - mean * mean, 0.f); rstd = 1.0f / sqrtf(var + LN_EPS); }
            const float cc = -mean * rstd;
            if (hi5 == 0) *(f32x2*)((float*)(ws + WS_MR) + (size_t)(tok0 + r32) * 2) = (f32x2){rstd, cc};
#define P5_EO(kq) (32 * ((kq) >> 1) + 8 * ((kq) & 1))
            const bf16_t* src = H1 + (size_t)(tok0 + r32) * 1024 + 16 * hi5;
            unsigned char* h8p = H1F8 + (size_t)(tok0 + r32) * 1024 + 16 * hi5;
            const LAS unsigned char* ahp = GWH + r32 * GWROW + 32 * hi5; const LAS unsigned char* alp = GWL + r32 * GWROW + 32 * hi5;
            const LAS float* glp = gL + 16 * hi5; const LAS float* blp = bL + 16 * hi5;
            f32x16 acc0 = {}, acc1 = {}, acc2 = {};
            u32x4 xa[4], xb[4];
#define P5_LOAD(buf, ks0) do { _Pragma("unroll") for (int q_ = 0; q_ < 4; ++q_) buf[q_] = *(const u32x4*)(src + P5_EO((ks0) + q_)); } while (0)
#define P5_COMP(buf, ks0) do { u32x2 w8p_ = {0u, 0u}; _Pragma("unroll") for (int q_ = 0; q_ < 4; ++q_) { const int eo_ = 16 * (ks0) + 32 * (q_ >> 1) + 8 * (q_ & 1); \
                const f32x4 g0_ = *(const LAS f32x4*)(glp + eo_), g1_ = *(const LAS f32x4*)(glp + eo_ + 4), b0_ = *(const LAS f32x4*)(blp + eo_), b1_ = *(const LAS f32x4*)(blp + eo_ + 4); \
                const f32x4 p0_ = {bflo(buf[q_].x), bfhi(buf[q_].x), bflo(buf[q_].y), bfhi(buf[q_].y)}, p1_ = {bflo(buf[q_].z), bfhi(buf[q_].z), bflo(buf[q_].w), bfhi(buf[q_].w)}; \
                const f32x4 u0_ = (p0_ * rstd + cc) * g0_ + b0_, u1_ = (p1_ * rstd + cc) * g1_ + b1_; \
                u32x4 wh_, wl_; wh_.x = pk2(u0_[0], u0_[1]); wh_.y = pk2(u0_[2], u0_[3]); wh_.z = pk2(u1_[0], u1_[1]); wh_.w = pk2(u1_[2], u1_[3]); \
                { u32x2 w8_; w8_.x = pk4_fp8(u0_[0], u0_[1], u0_[2], u0_[3]); w8_.y = pk4_fp8(u1_[0], u1_[1], u1_[2], u1_[3]); \
                  if (q_ & 1) { u32x4 w16_; w16_.x = w8p_.x; w16_.y = w8p_.y; w16_.z = w8_.x; w16_.w = w8_.y; *(u32x4*)(h8p + eo_ - 8) = w16_; } else w8p_ = w8_; } \
                wl_.x = pk2(u0_[0] - bflo(wh_.x), u0_[1] - bfhi(wh_.x)); wl_.y = pk2(u0_[2] - bflo(wh_.y), u0_[3] - bfhi(wh_.y)); \
                wl_.z = pk2(u1_[0] - bflo(wh_.z), u1_[1] - bfhi(wh_.z)); wl_.w = pk2(u1_[2] - bflo(wh_.w), u1_[3] - bfhi(wh_.w)); \
                const bf16x8 bh_ = __builtin_bit_cast(bf16x8, wh_), bl_ = __builtin_bit_cast(bf16x8, wl_); \
                const bf16x8 ah_ = *(const LAS bf16x8*)(ahp + 2 * eo_), al_ = *(const LAS bf16x8*)(alp + 2 * eo_); \
                acc0 = __builtin_amdgcn_mfma_f32_32x32x16_bf16(ah_, bh_, acc0, 0, 0, 0); acc1 = __builtin_amdgcn_mfma_f32_32x32x16_bf16(ah_, bl_, acc1, 0, 0, 0); \
                acc2 = __builtin_amdgcn_mfma_f32_32x32x16_bf16(al_, bh_, acc2, 0, 0, 0); } } while (0)
            P5_LOAD(xa, 0);
            for (int it = 0; it < 8; ++it) {
                P5_LOAD(xb, 8 * it + 4);
                P5_COMP(xa, 8 * it);
                if (it < 7) P5_LOAD(xa, 8 * it + 8);
                P5_COMP(xb, 8 * it + 4);
            }
#undef P5_LOAD
#undef P5_COMP
#undef P5_EO
            float v[16];
#pragma unroll
            for (int i = 0; i < 16; ++i) v[i] = (acc0[i] + acc1[i] + acc2[i]) + brL[crow(i, hi5)];
            float cv[8]; int ce[8];
#pragma unroll
            for (int kk = 0; kk < 4; ++kk) {
                float bv = v[0]; int bi = 0;
#pragma unroll
                for (int i = 1; i < 16; ++i) if (v[i] > bv) { bv = v[i]; bi = i; }
                cv[kk] = bv; ce[kk] = crow(bi, hi5);
#pragma unroll
                for (int i = 0; i < 16; ++i) v[i] = (i == bi) ? -INFINITY : v[i];
            }
#pragma unroll
            for (int kk = 0; kk < 4; ++kk) { cv[4 + kk] = __shfl_xor(cv[kk], 32); ce[4 + kk] = __shfl_xor(ce[kk], 32); }
            float tv[4]; int te[4];
#pragma unroll
            for (int kk = 0; kk < 4; ++kk) {
                float bv = cv[0]; int be = ce[0], bi = 0;
#pragma unroll
                for (int i = 1; i < 8; ++i) if (cv[i] > bv || (cv[i] == bv && ce[i] < be)) { bv = cv[i]; be = ce[i]; bi = i; }
                tv[kk] = bv; te[kk] = be;
#pragma unroll
                for (int i = 0; i < 8; ++i) cv[i] = (i == bi) ? -INFINITY : cv[i];
            }
            { const float e1 = __expf(tv[1] - tv[0]), e2 = __expf(tv[2] - tv[0]), e3 = __expf(tv[3] - tv[0]); const float inv = 1.0f / (1.0f + e1 + e2 + e3);
              if (hi5 == 0) { const size_t tk = (size_t)(tok0 + r32) * 4;
                  *(int4*)(TOPE + tk) = make_int4(te[0], te[1], te[2], te[3]); *(f32x4*)(TOPW + tk) = (f32x4){inv, e1 * inv, e2 * inv, e3 * inv};
                  atomicAdd((int*)(histL + te[0]), 1); atomicAdd((int*)(histL + te[1]), 1); atomicAdd((int*)(histL + te[2]), 1); atomicAdd((int*)(histL + te[3]), 1); } }
            __syncthreads();
            if (tid < 32) HIST[vw * 32 + tid] = histL[tid];
            __syncthreads();
        }
    } }
#else
    if (IN(5)) { REP_LOOP(5) { REP_SYNC(); const int tid = opaque_tid(), lane = tid & 63, wave = __builtin_amdgcn_readfirstlane(tid >> 6), gw = bx * 8 + wave; (void)lane; (void)wave; (void)gw;

        constexpr int GWROW = 2064;
        LAS unsigned char* GWH = lds; LAS unsigned char* GWL = lds + 32 * GWROW;
        LAS float* gws = (LAS float*)(lds + SCR_OFF); LAS float* bws = gws + 32; LAS int* histL = (LAS int*)(bws + 32); LAS float* partL = (LAS float*)(histL + 32);
        for (int idx = tid; idx < 32 * 1024; idx += 512) { const int d = idx >> 5, e = idx & 31;
            const float v = w_router[idx] * ln1g[d]; const unsigned hb = pk2(v, 0.f) & 0xffffu; const float vh = __uint_as_float(hb << 16); const unsigned lb = pk2(v - vh, 0.f) & 0xffffu;
            ((LAS bf16_t*)(GWH + e * GWROW))[d] = (bf16_t)hb; ((LAS bf16_t*)(GWL + e * GWROW))[d] = (bf16_t)lb; }
        { const int e = tid & 31, p = tid >> 5; float sg = 0.f, sb = 0.f;
          for (int d = 64 * p; d < 64 * p + 64; ++d) { const float w = w_router[d * 32 + e]; sg += ln1g[d] * w; sb += ln1b[d] * w; }
          partL[(p * 32 + e) * 2] = sg; partL[(p * 32 + e) * 2 + 1] = sb; }
        __syncthreads();
        if (tid < 32) { float sg = 0.f, sb = 0.f; for (int p = 0; p < 16; ++p) { sg += partL[(p * 32 + tid) * 2]; sb += partL[(p * 32 + tid) * 2 + 1]; } gws[tid] = sg; bws[tid] = sb + b_router[tid]; }
        __syncthreads();
        const int r32 = lane & 31, hi5 = lane >> 5;
        for (int vw = bx; vw < 256; vw += G) {
            if (tid < 32) histL[tid] = 0;
            __syncthreads();
            const int tok0 = vw * 256 + wave * 32;
            const float* src = OUTP + (size_t)(tok0 + r32) * 1024 + 8 * hi5;
            const LAS unsigned char* ahp = GWH + r32 * GWROW + 16 * hi5; const LAS unsigned char* alp = GWL + r32 * GWROW + 16 * hi5;
            f32x16 acc0 = {}, acc1 = {}, acc2 = {};
            float s1 = 0.f, s2 = 0.f;
            f32x4 xa[4][2], xb[4][2];
#define P5_LOAD(buf, ks0) do { _Pragma("unroll") for (int q_ = 0; q_ < 4; ++q_) { buf[q_][0] = *(const f32x4*)(src + 16 * ((ks0) + q_)); buf[q_][1] = *(const f32x4*)(src + 16 * ((ks0) + q_) + 4); } } while (0)
#define P5_COMP(buf, ks0) do { _Pragma("unroll") for (int q_ = 0; q_ < 4; ++q_) { const f32x4 u0_ = buf[q_][0], u1_ = buf[q_][1]; \
                s1 += (u0_[0] + u0_[1]) + (u0_[2] + u0_[3]) + (u1_[0] + u1_[1]) + (u1_[2] + u1_[3]); \
                s2 += (u0_[0] * u0_[0] + u0_[1] * u0_[1]) + (u0_[2] * u0_[2] + u0_[3] * u0_[3]) + (u1_[0] * u1_[0] + u1_[1] * u1_[1]) + (u1_[2] * u1_[2] + u1_[3] * u1_[3]); \
                u32x4 wh_, wl_; wh_.x = pk2(u0_[0], u0_[1]); wh_.y = pk2(u0_[2], u0_[3]); wh_.z = pk2(u1_[0], u1_[1]); wh_.w = pk2(u1_[2], u1_[3]); \
                wl_.x = pk2(u0_[0] - bflo(wh_.x), u0_[1] - bfhi(wh_.x)); wl_.y = pk2(u0_[2] - bflo(wh_.y), u0_[3] - bfhi(wh_.y)); \
                wl_.z = pk2(u1_[0] - bflo(wh_.z), u1_[1] - bfhi(wh_.z)); wl_.w = pk2(u1_[2] - bflo(wh_.w), u1_[3] - bfhi(wh_.w)); \
                const bf16x8 bh_ = __builtin_bit_cast(bf16x8, wh_), bl_ = __builtin_bit_cast(bf16x8, wl_); \
                const bf16x8 ah_ = *(const LAS bf16x8*)(ahp + 32 * ((ks0) + q_)), al_ = *(const LAS bf16x8*)(alp + 32 * ((ks0) + q_)); \
                acc0 = __builtin_amdgcn_mfma_f32_32x32x16_bf16(ah_, bh_, acc0, 0, 0, 0); acc1 = __builtin_amdgcn_mfma_f32_32x32x16_bf16(ah_, bl_, acc1, 0, 0, 0); \
                acc2 = __builtin_amdgcn_mfma_f32_32x32x16_bf16(al_, bh_, acc2, 0, 0, 0); } } while (0)
            P5_LOAD(xa, 0);
            for (int it = 0; it < 8; ++it) {
                P5_LOAD(xb, 8 * it + 4);
                P5_COMP(xa, 8 * it);
                if (it < 7) P5_LOAD(xa, 8 * it + 8);
                P5_COMP(xb, 8 * it + 4);
            }
#undef P5_LOAD
#undef P5_COMP
            s1 += __shfl_xor(s1, 32); s2 += __shfl_xor(s2, 32);
            const float mean = s1 * (1.f / 1024.f), var = __builtin_fmaxf(s2 * (1.f / 1024.f) - mean * mean, 0.f), rstd = 1.0f / sqrtf(var + LN_EPS);
            float v[16];
#pragma unroll
            for (int i = 0; i < 16; ++i) v[i] = rstd * ((acc0[i] + acc1[i] + acc2[i]) - mean * gws[crow(i, hi5)]) + bws[crow(i, hi5)];
            float cv[8]; int ce[8];
#pragma unroll
            for (int kk = 0; kk < 4; ++kk) {
                float bv = v[0]; int bi = 0;
#pragma unroll
                for (int i = 1; i < 16; ++i) if (v[i] > bv) { bv = v[i]; bi = i; }
                cv[kk] = bv; ce[kk] = crow(bi, hi5);
#pragma unroll
                for (int i = 0; i < 16; ++i) v[i] = (i == bi) ? -INFINITY : v[i];
            }
#pragma unroll
            for (int kk = 0; kk < 4; ++kk) { cv[4 + kk] = __shfl_xor(cv[kk], 32); ce[4 + kk] = __shfl_xor(ce[kk], 32); }
            float tv[4]; int te[4];
#pragma unroll
            for (int kk = 0; kk < 4; ++kk) {
                float bv = cv[0]; int be = ce[0], bi = 0;
#pragma unroll
                for (int i = 1; i < 8; ++i) if (cv[i] > bv || (cv[i] == bv && ce[i] < be)) { bv = cv[i]; be = ce[i]; bi = i; }
                tv[kk] = bv; te[kk] = be;
#pragma unroll
                for (int i = 0; i < 8; ++i) cv[i] = (i == bi) ? -INFINITY : cv[i];
            }
            { const float e1 = __expf(tv[1] - tv[0]), e2 = __expf(tv[2] - tv[0]), e3 = __expf(tv[3] - tv[0]); const float inv = 1.0f / (1.0f + e1 + e2 + e3);
              if (hi5 == 0) { const size_t tk = (size_t)(tok0 + r32) * 4;
                  *(int4*)(TOPE + tk) = make_int4(te[0], te[1], te[2], te[3]); *(f32x4*)(TOPW + tk) = (f32x4){inv, e1 * inv, e2 * inv, e3 * inv};
                  atomicAdd((int*)(histL + te[0]), 1); atomicAdd((int*)(histL + te[1]), 1); atomicAdd((int*)(histL + te[2]), 1); atomicAdd((int*)(histL + te[3]), 1); } }
            f32x4 gg[4], bb[4];
#pragma unroll
            for (int j = 0; j < 4; ++j) { gg[j] = *(const f32x4*)(ln1g + 4 * lane + 256 * j); bb[j] = *(const f32x4*)(ln1b + 4 * lane + 256 * j); }
#pragma unroll 4
            for (int i = 0; i < 32; ++i) {
                const float mi = __uint_as_float(__builtin_amdgcn_readlane(__float_as_uint(mean), i)), ri = __uint_as_float(__builtin_amdgcn_readlane(__float_as_uint(rstd), i));
                const float* pp = OUTP + (size_t)(tok0 + i) * 1024 + 4 * lane; bf16_t* hp = H1 + (size_t)(tok0 + i) * 1024 + 4 * lane;
#pragma unroll
                for (int j = 0; j < 4; ++j) { const f32x4 xv = (*(const f32x4*)(pp + 256 * j) - mi) * ri * gg[j] + bb[j]; u32x2 w; w.x = pk2(xv[0], xv[1]); w.y = pk2(xv[2], xv[3]); *(u32x2*)(hp + 256 * j) = w;
                    *(unsigned*)(H1F8 + (size_t)(tok0 + i) * 1024 + 4 * lane + 256 * j) = pk4_fp8(xv[0], xv[1], xv[2], xv[3]); }
            }
            __syncthreads();
            if (tid < 32) HIST[vw * 32 + tid] = histL[tid];
            __syncthreads();
        }
    } }
#endif
    SEAM(5);

    if (IN(6)) { REP_LOOP(6) { REP_SYNC(); const int tid = opaque_tid(), lane = tid & 63, wave = __builtin_amdgcn_readfirstlane(tid >> 6), gw = bx * 8 + wave; (void)lane; (void)wave; (void)gw;

        LAS int* part = (LAS int*)(lds + SCR_OFF);
        LAS int* cntL = part + 512; LAS int* befL = cntL + 32; LAS int* tstL = befL + 32; LAS int* baseL = tstL + 40; LAS int* curL = baseL + 32;
        for (int vw = bx; vw < 256; vw += G) {
            constexpr int WH = 256 / NHALF, GP = WH / 16;
            const int hf = vw / WH, wl = vw % WH;
            { const int e = tid & 31, p = tid >> 5; int s = 0;
              for (int i = 0; i < GP; ++i) s += HIST[(WH * hf + GP * p + i) * 32 + e];
              part[p * 32 + e] = s; }
            __syncthreads();
            if (tid < 32) { int tot = 0, bef = 0; const int pw = wl / GP, iw = wl % GP;
                for (int p = 0; p < 16; ++p) { const int v = part[p * 32 + tid]; tot += v; if (p < pw) bef += v; }
                for (int i = 0; i < iw; ++i) bef += HIST[(WH * hf + GP * pw + i) * 32 + tid];
                cntL[tid] = tot; befL[tid] = bef; curL[tid] = 0; }
            __syncthreads();
            if (tid == 0) { int run = 0; for (int e = 0; e < 32; ++e) { tstL[e] = run; run += (cntL[e] + 255) >> 8; } tstL[32] = run; }
            __syncthreads();
            if (tid < 32) baseL[tid] = tstL[tid] * 256 + befL[tid];
            __syncthreads();
            int* rt = ROWTOK + (size_t)hf * HROWS; int* rd = ROWDST + (size_t)hf * HROWS;
            for (int idx = tid; idx < 1024; idx += 512) {
                const int tok = vw * 256 + (idx >> 2), kk = idx & 3, e = TOPE[(size_t)tok * 4 + kk];
                const int pos = baseL[e] + atomicAdd((int*)(curL + e), 1);
                rt[pos] = tok; rd[pos] = (tok - hf * HALF_T) * 4 + kk;
            }
            if (wl < 32) { const int e = wl, r0 = tstL[e] * 256 + cntL[e], r1 = tstL[e + 1] * 256;
                for (int r = r0 + tid; r < r1; r += 512) { rt[r] = hf * HALF_T; rd[r] = -1; } }
            if (wl == 32) { int* te = TILEE + hf * 2048; const int nt = tstL[32];
                for (int t = tid; t < nt; t += 512) { int e = 0; for (int q = 1; q < 32; ++q) if (t >= tstL[q]) e = q; te[t] = e; }
                if (tid == 0) te[2040] = nt; }
            __syncthreads();
        }
    }
    }
    SEAM(6);

#pragma unroll
    for (int hf = 0; hf < NHALF; ++hf) {
        const int p_gu = 7 + 2 * hf, p_dn = 8 + 2 * hf, p_cb = 9 + 2 * hf;
        const int* te = TILEE + hf * 2048; const int* rt = ROWTOK + (size_t)hf * HROWS; const int* rd = ROWDST + (size_t)hf * HROWS;
        if (IN(p_gu)) { REP_LOOP(p_gu) { REP_SYNC(); const int tid = opaque_tid();
            const int NT = te[2040];
            LAS int* teL = (LAS int*)(lds + SCR_OFF);
            for (int t = tid; t < NT; t += 512) teL[t] = te[t];
            __syncthreads();
            XCD_STAGGER(STAG7);
            pg8::MoeOrderT<8> S; S.init(teL, NT, 8, G, bx);
            EpiSwiglu E{b_gu, Hh};
#ifdef KLOOP_PROBE
            if (tid == 0) MISC[17] = (KLOOP_PROBE == p_gu);
#endif
            CLK_BEGIN(p_gu); pg8::gemm_phase(lds, (const bf16_t*)H1F8, (const bf16_t*)WGU, 512, S, pg8::AGather{rt}, E, pg8::NoHook{});
#ifdef KLOOP_PROBE
            if (tid == 0) MISC[17] = 0;
#endif
        } }
        SEAM(p_gu);
        if (IN(p_dn)) { REP_LOOP(p_dn) { REP_SYNC(); const int tid = opaque_tid();
            const int NT = te[2040];
            LAS int* teL = (LAS int*)(lds + SCR_OFF);
            for (int t = tid; t < NT; t += 512) teL[t] = te[t];
            __syncthreads();
            XCD_STAGGER(STAG8);
            pg8::MoeOrderT<4> S; S.init(teL, NT, 4, G, bx);
            EpiDown E{b_dn, rd, Y};
            pg8::gemm_phase(lds, (const bf16_t*)Hh, (const bf16_t*)WDN, 512, S, pg8::ADense{}, E, pg8::NoHook{});
        } }
        SEAM(p_dn);
        if (IN(p_cb)) { REP_LOOP(p_cb + 3) { REP_SYNC();
            f32x4 g2[4], b2[4];
            int lq = threadIdx.x & 63; asm volatile("" : "+v"(lq));
#define lane lq
#pragma unroll
            for (int j = 0; j < 2; ++j) { g2[2 * j] = *(const f32x4*)(ln2g + 8 * lane + 512 * j); g2[2 * j + 1] = *(const f32x4*)(ln2g + 8 * lane + 512 * j + 4);
                b2[2 * j] = *(const f32x4*)(ln2b + 8 * lane + 512 * j); b2[2 * j + 1] = *(const f32x4*)(ln2b + 8 * lane + 512 * j + 4); }
            f32x4 g1a[4], b1a[4];
#pragma unroll
            for (int j = 0; j < 2; ++j) { g1a[2 * j] = *(const f32x4*)(ln1g + 8 * lane + 512 * j) * ALPHA; g1a[2 * j + 1] = *(const f32x4*)(ln1g + 8 * lane + 512 * j + 4) * ALPHA;
                b1a[2 * j] = *(const f32x4*)(ln1b + 8 * lane + 512 * j) * ALPHA; b1a[2 * j + 1] = *(const f32x4*)(ln1b + 8 * lane + 512 * j + 4) * ALPHA; }
            for (int tl = gw; tl < HALF_T; tl += NGW) {
                const int tok = hf * HALF_T + tl;
                const f32x4 wv = *(const f32x4*)(TOPW + (size_t)tok * 4);
                const f32x2 mr = *(const f32x2*)((const float*)(ws + WS_MR) + (size_t)tok * 2);
                f32x4 v[4]; float s = 0.f;
#pragma unroll
                for (int j = 0; j < 2; ++j) {
                    const int c = 8 * lane + 512 * j;
                    const u32x4 hh = __builtin_nontemporal_load((const u32x4*)(H1 + (size_t)tok * 1024 + c));
                    f32x4 a = ((f32x4){bflo(hh.x), bfhi(hh.x), bflo(hh.y), bfhi(hh.y)} * mr[0] + mr[1]) * g1a[2 * j] + b1a[2 * j], b = ((f32x4){bflo(hh.z), bfhi(hh.z), bflo(hh.w), bfhi(hh.w)} * mr[0] + mr[1]) * g1a[2 * j + 1] + b1a[2 * j + 1];
#pragma unroll
#if Y_FP8
                    for (int kk = 0; kk < 4; ++kk) { const u32x2 yy = __builtin_nontemporal_load((const u32x2*)((const unsigned char*)Y + ((size_t)tl * 4 + kk) * 1024 + c)); const float w = wv[kk];
                        a += fp8x4_f32(yy.x) * w; b += fp8x4_f32(yy.y) * w; }
#else
                    for (int kk = 0; kk < 4; ++kk) { const u32x4 yy = *(const u32x4*)(Y + ((size_t)tl * 4 + kk) * 1024 + c); const float w = wv[kk];
                        a += (f32x4){bflo(yy.x), bfhi(yy.x), bflo(yy.y), bfhi(yy.y)} * w; b += (f32x4){bflo(yy.z), bfhi(yy.z), bflo(yy.w), bfhi(yy.w)} * w; }
#endif
                    v[2 * j] = a; v[2 * j + 1] = b; s += (a[0] + a[1]) + (a[2] + a[3]) + (b[0] + b[1]) + (b[2] + b[3]);
                }
                const float mean = wave_sum(s) * (1.f / 1024.f); float s2 = 0.f;
#pragma unroll
                for (int j = 0; j < 4; ++j) { v[j] = v[j] - mean; s2 += (v[j][0] * v[j][0] + v[j][1] * v[j][1]) + (v[j][2] * v[j][2] + v[j][3] * v[j][3]); }
                const float rstd = 1.0f / sqrtf(wave_sum(s2) * (1.f / 1024.f) + LN_EPS);
                float* op = OUTP + (size_t)tok * 1024 + 8 * lane;
#pragma unroll
                for (int j = 0; j < 2; ++j) { __builtin_nontemporal_store(v[2 * j] * rstd * g2[2 * j] + b2[2 * j], (f32x4*)(op + 512 * j)); __builtin_nontemporal_store(v[2 * j + 1] * rstd * g2[2 * j + 1] + b2[2 * j + 1], (f32x4*)(op + 512 * j + 4)); }
            }
#undef lane
        } }
    }
#if defined(KLOOP_PROBE) || defined(EPI_PROBE)
    if (bx == 0 && tid == 0) {
        const unsigned long long tend = __builtin_amdgcn_s_memrealtime() + (unsigned long long)MISC[16] * 16ull / 10ull;
        while (__builtin_amdgcn_s_memrealtime() < tend) __builtin_amdgcn_s_sleep(8);
    }
#endif
#ifdef CLKPROBE
    if (bx == 0 && tid == 0 && cp_r1 > cp_r0) {
        const unsigned long long mhz = (cp_t1 - cp_t0) * 100ull / (cp_r1 - cp_r0);
        const unsigned long long tend = __builtin_amdgcn_s_memrealtime() + mhz * 100ull;
        while (__builtin_amdgcn_s_memrealtime() < tend) __builtin_amdgcn_s_sleep(8);
    }
#endif
#undef IN
#undef SEAM
}

extern "C" void kernel_launch(void* const* d_in, const int* in_sizes, int n_in, void* d_out, int out_size, void* d_ws, size_t ws_size, hipStream_t stream) {
    static int grid = 0;
    if (grid == 0) {
        if (n_in != 16 || in_sizes[0] != T * D || out_size != T * D || ws_size < WS_END) { fprintf(stderr, "kernel_launch: unexpected shapes / workspace (%d inputs, ws %zu)\n", n_in, ws_size); grid = -1; return; }
        int dev = 0, cus = 0, per_cu = 0;
        if (hipGetDevice(&dev) != hipSuccess || hipDeviceGetAttribute(&cus, hipDeviceAttributeMultiprocessorCount, dev) != hipSuccess) { grid = -1; return; }
        if (hipFuncSetAttribute((const void*)mk_fwd, hipFuncAttributeMaxDynamicSharedMemorySize, LDS_BYTES) != hipSuccess) { fprintf(stderr, "kernel_launch: hipFuncSetAttribute failed\n"); grid = -1; return; }
        if (hipOccupancyMaxActiveBlocksPerMultiprocessor(&per_cu, (const void*)mk_fwd, 512, LDS_BYTES) != hipSuccess || per_cu < 1) { fprintf(stderr, "kernel_launch: occupancy query says %d\n", per_cu); }
        (void)hipGetLastError();
        grid = cus;
    }
    if (grid < 0) return;
    if (hipMemsetAsync((char*)d_ws + WS_CTL, 0, CTL_ZERO_BYTES, stream) != hipSuccess) return;
    Args a{};
    for (int i = 0; i < 16; ++i) a.in[i] = (const float*)d_in[i];
    a.out = (float*)d_out; a.ws = (unsigned char*)d_ws;
#if MK_ONE_LAUNCH && defined(PROBE_SPLIT)
    a.ph_lo = 0; a.ph_hi = PROBE_SPLIT + 1; a.li = 0;
#ifdef PROBE_VAR
    a.var = PROBE_VAR;
#endif
    hipLaunchKernelGGL(mk_fwd, dim3(grid), dim3(512), LDS_BYTES, stream, a);
    a.ph_lo = PROBE_SPLIT; a.ph_hi = NPHASE; a.li = 1; a.var = 0;
    hipLaunchKernelGGL(mk_fwd, dim3(grid), dim3(512), LDS_BYTES, stream, a);
#elif MK_ONE_LAUNCH
    a.ph_lo = 0; a.ph_hi = NPHASE;
    hipLaunchKernelGGL(mk_fwd, dim3(grid), dim3(512), LDS_BYTES, stream, a);
#else
    for (int p = 0; p < NPHASE; ++p) { a.ph_lo = p; a.ph_hi = p + 1; hipLaunchKernelGGL(mk_fwd, dim3(grid), dim3(512), LDS_BYTES, stream, a); }
#endif
}
```
